# Optimizing an MI355X kernel written in HIP

```python
import jax
import jax.numpy as jnp
from jax import lax
import numpy as np

D_MODEL = 2048
BATCH = 1
SEQ = 8192
DEPTH = 4

GRID_W = 64
CTX_LEN = 256
EPS = 1e-6
D_FF = 5632
N_MOD = 9
D_GROUP = D_MODEL // 4
D_MIX = 4 * D_GROUP
LRU_W = D_GROUP
LRU_HEADS = 8
LRU_HD = LRU_W // LRU_HEADS
LRU_CONV = 4
LRU_C = 8.0
ATT_HD = 128
ATT_QH = D_GROUP // ATT_HD
ATT_KVH = 2
ATT_G = ATT_QH // ATT_KVH
ATT_BLOCK = 128
ROPE_THETA = 10000.0
GLA_HEADS = 4
GLA_DK = 64
GLA_DV = D_GROUP // GLA_HEADS
GLA_RANK = 16
GLA_TAU = 16.0
GLA_CHUNK = 64
FNET_GROUPS = 4
FNET_W = D_GROUP

SPLIT_SIZES = (LRU_W, LRU_W,
               ATT_QH * ATT_HD, ATT_KVH * ATT_HD, ATT_KVH * ATT_HD,
               GLA_HEADS * GLA_DK, GLA_HEADS * GLA_DK, GLA_HEADS * GLA_DV, GLA_HEADS * GLA_DV, 2 * GLA_RANK,
               FNET_W)
D_IN = sum(SPLIT_SIZES)
SPLIT_POINTS = [sum(SPLIT_SIZES[:i + 1]) for i in range(len(SPLIT_SIZES) - 1)]

kernel_name = 'hybrid_parallel_groups_dit_prefix'


def rmsnorm(x, g):
    xf = x.astype(jnp.float32)
    y = xf * lax.rsqrt(jnp.mean(jnp.square(xf), axis=-1, keepdims=True) + EPS)
    return (y * g.astype(jnp.float32)).astype(x.dtype)


def head_rms(t, g):
    return t * lax.rsqrt(jnp.mean(t * t, axis=-1, keepdims=True) + EPS) * g.astype(jnp.float32)


def modulate(h, shift, scale):
    return h * (1 + scale) + shift


def swiglu(h, w13, w2):
    gate, up = jnp.split(h @ w13, 2, axis=-1)
    return (jax.nn.silu(gate) * up) @ w2


def _flip(t):
    return jnp.flip(t, axis=1)


def _ident(t):
    return t


def dwconv_centred(u, w, b):
    T = u.shape[1]
    lo = LRU_CONV // 2
    up = jnp.pad(u, ((0, 0), (lo, LRU_CONV - 1 - lo), (0, 0)))
    return b + sum(w[j] * up[:, j:j + T] for j in range(LRU_CONV))


def _lin_comb(l, r):
    a_l, b_l = l
    a_r, b_r = r
    return a_l * a_r, a_r * b_l + b_r


def scan_forward(a, b, h0):
    b = b.at[:, 0].add(a[:, 0] * h0)
    _, h = lax.associative_scan(_lin_comb, (a, b), axis=1)
    return h


def rglru_coeffs(u, w_gate, b_gate, lam):
    B, T, _ = u.shape
    uh = u.reshape(B, T, LRU_HEADS, LRU_HD)
    gates = jnp.einsum('bthi,ghij->gbthj', uh, w_gate.astype(jnp.float32)).reshape(2, B, T, LRU_W)
    gates = gates + b_gate.astype(jnp.float32)[:, None, None, :]
    r = jax.nn.sigmoid(gates[0])
    i = jax.nn.sigmoid(gates[1])
    log_a = -LRU_C * r * jax.nn.softplus(-lam.astype(jnp.float32))
    a = jnp.exp(log_a)
    return a, jnp.sqrt(-jnp.expm1(2.0 * log_a)) * (i * u)


def lru_mixer(xc, gc, xl, gl, conv_w, conv_b, w_gate, b_gate, lam, need_ctx):
    f32 = jnp.float32
    uc = dwconv_centred(xc, conv_w, conv_b).astype(f32)
    ul = dwconv_centred(xl, conv_w, conv_b).astype(f32)
    hc_dirs, hl_dirs = [], []
    for d in range(2):
        fl = _flip if d else _ident
        ac, bc = rglru_coeffs(fl(uc), w_gate[d], b_gate[d], lam[d])
        hc = scan_forward(ac, bc, jnp.zeros_like(uc[:, 0]))
        al, bl = rglru_coeffs(fl(ul), w_gate[d], b_gate[d], lam[d])
        hl = scan_forward(al, bl, hc[:, -1])
        hc_dirs.append(fl(hc))
        hl_dirs.append(fl(hl))
    yl = ((hl_dirs[0] + hl_dirs[1]) * jax.nn.gelu(gl.astype(f32))).astype(xl.dtype)
    yc = ((hc_dirs[0] + hc_dirs[1]) * jax.nn.gelu(gc.astype(f32))).astype(xc.dtype) if need_ctx else None
    return yl, yc


def rope_axis(t, pos):
    n = t.shape[-1]
    half = n // 2
    freqs = ROPE_THETA ** (-jnp.arange(half, dtype=jnp.float32) / half)
    ang = pos.astype(jnp.float32)[:, None] * freqs
    cos = jnp.cos(ang)[:, None, :]
    sin = jnp.sin(ang)[:, None, :]
    t1, t2 = t[..., :half], t[..., half:]
    return jnp.concatenate([t1 * cos - t2 * sin, t1 * sin + t2 * cos], axis=-1)


def rope_2d(t, rows, cols):
    half = t.shape[-1] // 2
    return jnp.concatenate([rope_axis(t[..., :half], rows), rope_axis(t[..., half:], cols)], axis=-1)


def gqa_attend(q, k, v):
    s = jnp.einsum('bqkgd,bskd->bkgqs', q, k) * (ATT_HD ** -0.5)
    p = jax.nn.softmax(s, axis=-1)
    return jnp.einsum('bkgqs,bskd->bqkgd', p, v)


def attn_mixer(qc, kc, vc, ql, kl, vl, qk_g, rows, cols, need_ctx):
    f32 = jnp.float32
    B, S, _ = ql.shape
    Tc = qc.shape[1]

    def heads(t, h):
        return t.astype(f32).reshape(t.shape[0], t.shape[1], h, ATT_HD)

    kc_ = head_rms(heads(kc, ATT_KVH), qk_g[1])
    vc_ = heads(vc, ATT_KVH)
    ql_ = rope_2d(head_rms(heads(ql, ATT_QH), qk_g[0]), rows, cols)
    kl_ = rope_2d(head_rms(heads(kl, ATT_KVH), qk_g[1]), rows, cols)
    k_all = jnp.concatenate([kl_, kc_], axis=1)
    v_all = jnp.concatenate([heads(vl, ATT_KVH), vc_], axis=1)
    nb = S // ATT_BLOCK
    qb = ql_.reshape(B, nb, ATT_BLOCK, ATT_KVH, ATT_G, ATT_HD).swapaxes(0, 1)
    ol = lax.map(lambda qblk: gqa_attend(qblk, k_all, v_all), qb)
    yl = ol.swapaxes(0, 1).reshape(B, S, ATT_QH * ATT_HD).astype(ql.dtype)
    yc = None
    if need_ctx:
        qc_ = head_rms(heads(qc, ATT_QH), qk_g[0]).reshape(B, Tc, ATT_KVH, ATT_G, ATT_HD)
        yc = gqa_attend(qc_, kc_, vc_).reshape(B, Tc, ATT_QH * ATT_HD).astype(qc.dtype)
    return yl, yc


def gla_chunked(q, k, v, log_a, s0):
    B, T, H, DK = q.shape
    C = GLA_CHUNK
    N = T // C

    def rs(t):
        return t.reshape(B, N, C, H, t.shape[-1])

    q, k, v, log_a = rs(q), rs(k), rs(v), rs(log_a)
    bcum = jnp.cumsum(log_a, axis=2)
    blast = bcum[:, :, -1:]
    q_t = q * jnp.exp(bcum)
    k_in = k * jnp.exp(-bcum)
    k_out = k * jnp.exp(blast - bcum)
    mask = jnp.tril(jnp.ones((C, C), dtype=bool))
    att = jnp.where(mask, jnp.einsum('bnthd,bnshd->bnhts', q_t, k_in), 0.0)
    o_intra = jnp.einsum('bnhts,bnshv->bnthv', att, v)
    d_state = jnp.einsum('bnshd,bnshv->bnhdv', k_out, v)
    decay = jnp.exp(blast[:, :, 0])

    def step(s, inp):
        dec, ds = inp
        return dec[..., None] * s + ds, s

    s_final, s_prev = lax.scan(step, s0, (decay.swapaxes(0, 1), d_state.swapaxes(0, 1)))
    o_inter = jnp.einsum('bnthd,bnhdv->bnthv', q_t, s_prev.swapaxes(0, 1))
    return (o_intra + o_inter).reshape(B, T, H, -1), s_final


def gla_prep(q, k, v, g, lr, gate_w, gate_b):
    f32 = jnp.float32
    B, T, _ = q.shape

    def hk(t):
        return t.astype(f32).reshape(B, T, GLA_HEADS, -1)

    log_a = [hk(jax.nn.log_sigmoid(lr[..., d * GLA_RANK:(d + 1) * GLA_RANK].astype(f32) @ gate_w[d].astype(f32)
                                   + gate_b[d].astype(f32)) / GLA_TAU) for d in range(2)]
    return hk(q) * (GLA_DK ** -0.5), hk(k), hk(v), log_a, hk(g)


def gla_out(o, g, out_g, dtype):
    B, T = o.shape[0], o.shape[1]
    return (head_rms(o, out_g) * jax.nn.silu(g)).reshape(B, T, GLA_HEADS * GLA_DV).astype(dtype)


def gla_mixer(ctx_parts, lat_parts, gate_w, gate_b, out_g, need_ctx):
    qc, kc, vc, lac, gc = gla_prep(*ctx_parts, gate_w, gate_b)
    ql, kl, vl, lal, gl = gla_prep(*lat_parts, gate_w, gate_b)
    s0 = jnp.zeros((ql.shape[0], GLA_HEADS, GLA_DK, GLA_DV), jnp.float32)
    oc_dirs, ol_dirs = [], []
    for d in range(2):
        fl = _flip if d else _ident
        oc, sc = gla_chunked(fl(qc), fl(kc), fl(vc), fl(lac[d]), s0)
        ol, _ = gla_chunked(fl(ql), fl(kl), fl(vl), fl(lal[d]), sc)
        oc_dirs.append(fl(oc))
        ol_dirs.append(fl(ol))
    yl = gla_out(ol_dirs[0] + ol_dirs[1], gl, out_g, lat_parts[0].dtype)
    yc = gla_out(oc_dirs[0] + oc_dirs[1], gc, out_g, ctx_parts[0].dtype) if need_ctx else None
    return yl, yc


def fourier_mixer(u):
    B, T, _ = u.shape
    uf = u.astype(jnp.float32).reshape(B, T, FNET_GROUPS, FNET_W // FNET_GROUPS)
    y = jnp.fft.fft2(uf, axes=(1, 3), norm='ortho').real
    return y.reshape(B, T, FNET_W).astype(u.dtype)


def trunk_layer(xl, xc, mod_l, mod_c, norm_g, ffn_w13, ffn_w2, w_in, w_out,
                lru_conv_w, lru_conv_b, lru_gate_w, lru_gate_b, lru_lambda,
                qk_g, gla_gate_w, gla_gate_b, gla_out_g, rows, cols, need_ctx):
    def sub_in(x, m, j):
        return modulate(rmsnorm(x, norm_g[j]), m[..., 3 * j, :], m[..., 3 * j + 1, :])

    xl = xl + 0.5 * mod_l[..., 2, :] * swiglu(sub_in(xl, mod_l, 0), ffn_w13[0], ffn_w2[0])
    xc = xc + 0.5 * mod_c[..., 2, :] * swiglu(sub_in(xc, mod_c, 0), ffn_w13[0], ffn_w2[0])
    pl = jnp.split(sub_in(xl, mod_l, 1) @ w_in, SPLIT_POINTS, axis=-1)
    pc = jnp.split(sub_in(xc, mod_c, 1) @ w_in, SPLIT_POINTS, axis=-1)
    ya_l, ya_c = lru_mixer(pc[0], pc[1], pl[0], pl[1], lru_conv_w, lru_conv_b,
                           lru_gate_w, lru_gate_b, lru_lambda, need_ctx)
    yb_l, yb_c = attn_mixer(pc[2], pc[3], pc[4], pl[2], pl[3], pl[4], qk_g, rows, cols, need_ctx)
    yc_l, yc_c = gla_mixer(pc[5:10], pl[5:10], gla_gate_w, gla_gate_b, gla_out_g, need_ctx)
    yd_l = fourier_mixer(pl[10])
    mix_l = jnp.concatenate([ya_l, yb_l, yc_l, yd_l], axis=-1) @ w_out
    xl = xl + mod_l[..., 5, :] * mix_l
    xl = xl + 0.5 * mod_l[..., 8, :] * swiglu(sub_in(xl, mod_l, 2), ffn_w13[1], ffn_w2[1])
    if need_ctx:
        yd_c = fourier_mixer(pc[10])
        mix_c = jnp.concatenate([ya_c, yb_c, yc_c, yd_c], axis=-1) @ w_out
        xc = xc + mod_c[..., 5, :] * mix_c
        xc = xc + 0.5 * mod_c[..., 8, :] * swiglu(sub_in(xc, mod_c, 2), ffn_w13[1], ffn_w2[1])
    return xl, xc


def setup_inputs(seed: int = 0) -> dict:
    key = jax.random.key(seed)
    ks = jax.random.split(key, 21)
    f32 = jnp.float32

    def nrm(k, shape, scale):
        return jax.random.normal(k, shape, f32) * scale

    L, D = DEPTH, D_MODEL
    a0 = jax.random.uniform(ks[16], (L, 2, LRU_W), f32, 0.9, 0.999)
    p0 = a0 ** (1.0 / LRU_C)
    return {
        'x': nrm(ks[0], (BATCH, SEQ, D), 1.0),
        'c': nrm(ks[1], (BATCH, D), 1.0),
        'ctx': nrm(ks[2], (BATCH, CTX_LEN, D), 1.0),
        'c_ctx': nrm(ks[3], (D,), 1.0),
        'mod_w': nrm(ks[4], (L, D, N_MOD * D), 0.5 * D ** -0.5),
        'mod_b': nrm(ks[5], (L, N_MOD * D), 0.02),
        'norm_g': 1.0 + nrm(ks[6], (L, 3, D), 0.05),
        'final_g': 1.0 + nrm(ks[7], (D,), 0.05),
        'ffn_w13': nrm(ks[8], (L, 2, D, 2 * D_FF), D ** -0.5),
        'ffn_w2': nrm(ks[9], (L, 2, D_FF, D), D_FF ** -0.5),
        'w_in': nrm(ks[10], (L, D, D_IN), D ** -0.5),
        'w_out': nrm(ks[11], (L, D_MIX, D), D_MIX ** -0.5),
        'lru_conv_w': nrm(ks[12], (L, LRU_CONV, LRU_W), LRU_CONV ** -0.5),
        'lru_conv_b': nrm(ks[13], (L, LRU_W), 0.02),
        'lru_gate_w': nrm(ks[14], (L, 2, 2, LRU_HEADS, LRU_HD, LRU_HD), LRU_HD ** -0.5),
        'lru_gate_b': nrm(ks[15], (L, 2, 2, LRU_W), 0.02),
        'lru_lambda': jnp.log(p0) - jnp.log1p(-p0),
        'attn_qk_g': 1.0 + nrm(ks[17], (L, 2, ATT_HD), 0.05),
        'gla_gate_w': nrm(ks[18], (L, 2, GLA_RANK, GLA_HEADS * GLA_DK), GLA_RANK ** -0.5),
        'gla_gate_b': nrm(ks[19], (L, 2, GLA_HEADS * GLA_DK), 0.1),
        'gla_out_g': 1.0 + nrm(ks[20], (L, GLA_DV), 0.05),
    }


def reference(x, c, ctx, c_ctx, mod_w, mod_b, norm_g, final_g, ffn_w13, ffn_w2, w_in, w_out,
              lru_conv_w, lru_conv_b, lru_gate_w, lru_gate_b, lru_lambda, attn_qk_g,
              gla_gate_w, gla_gate_b, gla_out_g):
    B, S, D = x.shape
    ROWS = S // GRID_W
    rows = jnp.repeat(jnp.arange(ROWS, dtype=jnp.int32), GRID_W)
    cols = jnp.tile(jnp.arange(GRID_W, dtype=jnp.int32), ROWS)
    sc = jax.nn.silu(c)
    scc = jax.nn.silu(c_ctx)
    xl, xc = x, ctx
    for i in range(DEPTH):
        mod_l = (sc @ mod_w[i] + mod_b[i]).reshape(B, 1, N_MOD, D)
        mod_c = (scc @ mod_w[i] + mod_b[i]).reshape(N_MOD, D)
        xl, xc = trunk_layer(xl, xc, mod_l, mod_c, norm_g[i], ffn_w13[i], ffn_w2[i], w_in[i], w_out[i],
                             lru_conv_w[i], lru_conv_b[i], lru_gate_w[i], lru_gate_b[i], lru_lambda[i],
                             attn_qk_g[i], gla_gate_w[i], gla_gate_b[i], gla_out_g[i],
                             rows, cols, i < DEPTH - 1)
    return rmsnorm(xl, final_g)
```

```cpp
#include <hip/hip_runtime.h>
#include <cstdio>
#include <cstdint>

#ifndef MK_ONE_LAUNCH
#define MK_ONE_LAUNCH 0
#endif

constexpr int DM = 2048, TL = 8192, TCX = 256, MR = TL + TCX, FF = 5632, NLAY = 4, DIN = 4128, NCHUNK = MR / 64;
constexpr int PLD = 3584;
constexpr int PC_LX = 0, PC_LG = 512, PC_Q = 1024, PC_K = 1536, PC_V = 1792, PC_GQ = 2048, PC_GK = 2304, PC_GV = 2560, PC_GG = 3072;
constexpr float EPS = 1e-6f;

constexpr size_t al256(size_t x) { return (x + 255) / 256 * 256; }
constexpr size_t WS_CTL = 0, CTL_ZERO_BYTES = 1u << 20;
constexpr size_t WS_MODV = WS_CTL + CTL_ZERO_BYTES;
constexpr size_t WS_W13T = al256(WS_MODV + (size_t)NLAY * 2 * 9 * DM * 4);
constexpr size_t WS_W2T  = al256(WS_W13T + (size_t)8 * 2 * FF * DM * 2);
constexpr size_t WS_WINT = al256(WS_W2T + (size_t)8 * DM * FF * 2);
constexpr size_t WS_WLRT = al256(WS_WINT + (size_t)4 * 4096 * DM * 2);
constexpr size_t WS_WOUTT = al256(WS_WLRT + (size_t)4 * 32 * DM * 2);
constexpr size_t WS_ADFT = al256(WS_WOUTT + (size_t)4 * DM * DM * 2);
constexpr size_t WS_ADFTC = al256(WS_ADFT + (size_t)TL * 2 * TL * 2);
constexpr size_t WS_ADFT1 = al256(WS_ADFTC + (size_t)TCX * 2 * TCX * 2);
constexpr size_t WS_ROPE = al256(WS_ADFT1 + (size_t)1024 * 512 * 2);
constexpr size_t WS_X = al256(WS_ROPE + (size_t)2 * 128 * 32 * 4);
constexpr size_t WS_XN = al256(WS_X + (size_t)MR * DM * 4);
constexpr size_t WS_H = al256(WS_XN + (size_t)MR * DM * 2);
constexpr size_t WS_P = al256(WS_H + (size_t)MR * FF * 2);
constexpr size_t WS_UF = al256(WS_P + (size_t)MR * PLD * 4);
constexpr size_t WS_LR = al256(WS_UF + (size_t)MR * 512 * 2);
constexpr size_t WS_QB = al256(WS_LR + (size_t)MR * 32 * 4);
constexpr size_t WS_KB = al256(WS_QB + (size_t)MR * 512 * 2);
constexpr size_t WS_VB = al256(WS_KB + (size_t)MR * 256 * 2);
constexpr size_t WS_OP = al256(WS_VB + (size_t)MR * 256 * 2);
constexpr size_t WS_ML = al256(WS_OP + (size_t)2 * MR * 512 * 4);
constexpr size_t WS_HL = al256(WS_ML + (size_t)2 * MR * 4 * 2 * 4);
constexpr size_t WS_AC = al256(WS_HL + (size_t)2 * MR * 512 * 4);
constexpr size_t WS_ATOT = al256(WS_AC + (size_t)2 * MR * 512 * 4);
constexpr size_t WS_HEND = al256(WS_ATOT + (size_t)2 * NCHUNK * 512 * 4);
constexpr size_t WS_CIN = al256(WS_HEND + (size_t)2 * NCHUNK * 512 * 4);
constexpr size_t WS_BC = al256(WS_CIN + (size_t)2 * NCHUNK * 512 * 4);
constexpr size_t WS_DS = al256(WS_BC + (size_t)2 * MR * 256 * 4);
constexpr size_t WS_SP = al256(WS_DS + (size_t)NCHUNK * 4 * 2 * 64 * 128 * 4);
constexpr size_t WS_DEC = al256(WS_SP + (size_t)NCHUNK * 4 * 2 * 64 * 128 * 4);
constexpr size_t WS_ZT = al256(WS_DEC + (size_t)NCHUNK * 4 * 2 * 64 * 4);
constexpr size_t WS_ZTC = al256(WS_ZT + (size_t)512 * 16384 * 2);
constexpr size_t WS_YF = al256(WS_ZTC + (size_t)512 * 512 * 2);
constexpr size_t WS_MIX = al256(WS_YF + (size_t)4 * MR * 512 * 4);
constexpr size_t WS_END = al256(WS_MIX + (size_t)MR * DM * 2);

constexpr int CW_TMO = 0, CW_CODE = 1, CW_BAR = 4096;

constexpr int RING_OFF = 0, RING_BYTES = 131072;
constexpr int LDSCTL_OFF = RING_BYTES, MISC_OFF = LDSCTL_OFF + 320;
constexpr int LDS_BYTES = 147456;
constexpr int NWAVES = 8;

#define GAS __attribute__((address_space(1)))
#define LAS __attribute__((address_space(3)))
typedef unsigned short bf16;
typedef float f32x4 __attribute__((ext_vector_type(4)));
typedef float f32x2 __attribute__((ext_vector_type(2)));
typedef unsigned u32x4 __attribute__((ext_vector_type(4)));
typedef unsigned u32x2 __attribute__((ext_vector_type(2)));
typedef GAS unsigned gu32;
#define RLX_AGENT __ATOMIC_RELAXED, __HIP_MEMORY_SCOPE_AGENT
#define LDS_WAIT() asm volatile("s_waitcnt lgkmcnt(0)" ::: "memory")
#define VM_WAIT() asm volatile("s_waitcnt vmcnt(0)" ::: "memory")
__device__ __forceinline__ unsigned f2bf(float f) { unsigned u = __builtin_bit_cast(unsigned, f); return (u + 0x7fffu + ((u >> 16) & 1u)) >> 16; }
__device__ __forceinline__ unsigned pk2(float lo, float hi) { return f2bf(lo) | (f2bf(hi) << 16); }
__device__ __forceinline__ float wave_sum(float v) {
#pragma unroll
    for (int o = 1; o < 64; o <<= 1) v += __shfl_xor(v, o);
    return v;
}
__device__ __forceinline__ float sigmoidf_(float x) { return 1.0f / (1.0f + __expf(-x)); }
__device__ __forceinline__ float siluf_(float x) { return x / (1.0f + __expf(-x)); }
__device__ __forceinline__ float gelu_tanh_(float x) { const float u = 0.7978845608028654f * (x + 0.044715f * x * x * x); return 0.5f * x * (1.0f + tanhf(u)); }

namespace pg8 {
#define PG8_LAS __attribute__((address_space(3)))
typedef unsigned short bf16_t;
typedef short bf16x8 __attribute__((ext_vector_type(8)));
typedef float f32x4 __attribute__((ext_vector_type(4)));
typedef unsigned u32x4 __attribute__((ext_vector_type(4)));
constexpr int BM = 256, BK = 64, HALF = 128, HTB = HALF * BK * 2  , STAGE_BYTES = 8 * HTB, NXCD = 8, WGM = 8;

__host__ __device__ __forceinline__ int lds_byte(int r, int c) { const int st = (r >> 4) * 2 + (c >> 5), rr = r & 15, cc = c & 31, ob = rr * 64 + cc * 2; return st * 1024 + (ob ^ (((ob >> 9) & 1) << 5)); }
__host__ __device__ __forceinline__ void stage_rc(int b, int& R, int& C) { const int st = b / 1024, sb = b % 1024, swz = sb ^ (((sb >> 9) & 1) << 5); R = (st >> 1) * 16 + swz / 64; C = (st & 1) * 32 + (swz % 64) / 2; }
__host__ __device__ __forceinline__ int perm32(int rho) { const int n = rho >> 4, i = rho & 15; return 8 * (i >> 2) + 4 * n + (i & 3); }

struct Unit { int pm, pn, kt0, nt; };
struct Gemm { const bf16_t* A; const bf16_t* Bt; int K; };

struct StaticOrder {
    int nM, nN, nwg, G, c, nt;
    __host__ __device__ void init(int M, int N, int nt_, int G_, int c_) { nM = M / BM; nN = N / BM; nwg = nM * nN; G = G_; c = c_; nt = nt_; }
    __host__ __device__ bool next(int i, Unit& u) const {
        const long L = (long)i * G + c; if (L >= nwg) return false;
        int wgid = (int)L; { const int q = nwg / NXCD, r = nwg % NXCD, xcd = wgid % NXCD, off = wgid / NXCD; wgid = (xcd < r ? xcd * (q + 1) : r * (q + 1) + (xcd - r) * q) + off; }
        const int nig = WGM * nN, gid = wgid / nig, fm = gid * WGM, gsz = (nM - fm) < WGM ? (nM - fm) : WGM;
        u.pm = fm + ((wgid % nig) % gsz); u.pn = (wgid % nig) / gsz; u.kt0 = 0; u.nt = nt; return true;
    }
    __device__ __forceinline__ void a_ready(const Unit&) const {}
    __device__ __forceinline__ void done(const Unit&) const {}
};
struct SplitOrder {
    int nM, nN, nS, total, G, c, nt;
    __host__ __device__ void init(int M, int N, int nS_, int nt_, int G_, int c_) { nM = M / BM; nN = N / BM; nS = nS_; total = nM * nN * nS; G = G_; c = c_; nt = nt_; }
    __host__ __device__ bool next(int i, Unit& u) const {
        const long L = (long)i * G + c; if (L >= total) return false;
        const int l = (int)L; u.pm = l % nM; const int r = l / nM; u.pn = r % nN; u.kt0 = (r / nN) * nt; u.nt = nt; return true;
    }
    __device__ __forceinline__ void a_ready(const Unit&) const {}
    __device__ __forceinline__ void done(const Unit&) const {}
};

__device__ __forceinline__ unsigned cvt_pk_bf16(float lo, float hi) { unsigned r; asm volatile("v_cvt_pk_bf16_f32 %0, %1, %2" : "=v"(r) : "v"(lo), "v"(hi)); return r; }


struct EpiSwiGLU {
    static constexpr bool PERM = true, AFTER_DRAIN = false;
    bf16_t* H; int ldh;
    __device__ __forceinline__ void operator()(const f32x4 (&acc)[2][2][4][2], const Unit& u, int wr, int wc, int fr, int fq) const {
        const int row0 = u.pm * BM + wr * 64 + fr, col0 = u.pn * HALF + wc * 32 + 8 * fq;
#pragma unroll
        for (int ai = 0; ai < 2; ++ai)
#pragma unroll
            for (int m = 0; m < 4; ++m) { bf16_t* rowp = H + (size_t)(row0 + ai * HALF + m * 16) * ldh + col0;
                float o[8];
#pragma unroll
                for (int n = 0; n < 2; ++n)
#pragma unroll
                    for (int i = 0; i < 4; ++i) { const float gt = acc[ai][0][m][n][i], up = acc[ai][1][m][n][i]; o[4 * n + i] = gt * __builtin_amdgcn_rcpf(1.0f + __expf(-gt)) * up; }
                u32x4 w; w.x = cvt_pk_bf16(o[0], o[1]); w.y = cvt_pk_bf16(o[2], o[3]); w.z = cvt_pk_bf16(o[4], o[5]); w.w = cvt_pk_bf16(o[6], o[7]);
                *(u32x4*)rowp = w; }
    }
};
struct EpiResid {
    static constexpr bool PERM = false, AFTER_DRAIN = false;
    float* X; int ldx; const float* gl; int gc_delta; float coef; int ctx_pm;
    __device__ __forceinline__ void operator()(const f32x4 (&acc)[2][2][4][2], const Unit& u, int wr, int wc, int fr, int fq) const {
        const int row0 = u.pm * BM + wr * 64 + fr, col0 = u.pn * BM + wc * 32 + 4 * fq;
        const float* gate = gl + ((u.pm == ctx_pm) ? gc_delta : 0);
        f32x4 gv[2][2];
#pragma unroll
        for (int bj = 0; bj < 2; ++bj)
#pragma unroll
            for (int n = 0; n < 2; ++n) gv[bj][n] = *(const f32x4*)(gate + col0 + bj * HALF + n * 16) * coef;
#pragma unroll
        for (int ai = 0; ai < 2; ++ai)
#pragma unroll
            for (int m = 0; m < 4; ++m) { float* rowp = X + (size_t)(row0 + ai * HALF + m * 16) * ldx + col0;
#pragma unroll
                for (int bj = 0; bj < 2; ++bj)
#pragma unroll
                    for (int n = 0; n < 2; ++n) { f32x4* p = (f32x4*)(rowp + bj * HALF + n * 16); *p = *p + gv[bj][n] * acc[ai][bj][m][n]; }
                if (m & 1) asm volatile("" ::: "memory"); }
    }
};
struct EpiP {
    static constexpr bool PERM = false, AFTER_DRAIN = false;
    float* P; int ldp; bf16_t* UF;
    __device__ __forceinline__ void operator()(const f32x4 (&acc)[2][2][4][2], const Unit& u, int wr, int wc, int fr, int fq) const {
        const int row0 = u.pm * BM + wr * 64 + fr;
        if (u.pn < 14) {
            const int col0 = u.pn * BM + wc * 32 + 4 * fq;
#pragma unroll
            for (int ai = 0; ai < 2; ++ai)
#pragma unroll
                for (int m = 0; m < 4; ++m) { float* rowp = P + (size_t)(row0 + ai * HALF + m * 16) * ldp + col0;
#pragma unroll
                    for (int bj = 0; bj < 2; ++bj)
#pragma unroll
                        for (int n = 0; n < 2; ++n) *(f32x4*)(rowp + bj * HALF + n * 16) = acc[ai][bj][m][n]; }
        } else {
            const int col0 = (u.pn - 14) * BM + wc * 32 + 4 * fq;
#pragma unroll
            for (int ai = 0; ai < 2; ++ai)
#pragma unroll
                for (int m = 0; m < 4; ++m) { bf16_t* rowp = UF + (size_t)(row0 + ai * HALF + m * 16) * 512 + col0;
#pragma unroll
                    for (int bj = 0; bj < 2; ++bj)
#pragma unroll
                        for (int n = 0; n < 2; ++n) { const f32x4 v = acc[ai][bj][m][n]; u32x2 w; w.x = cvt_pk_bf16(v[0], v[1]); w.y = cvt_pk_bf16(v[2], v[3]); *(u32x2*)(rowp + bj * HALF + n * 16) = w; } }
        }
    }
};
struct EpiZT {
    static constexpr bool PERM = true, AFTER_DRAIN = false;
    bf16_t* ZT; long ztc_delta;
    __device__ __forceinline__ void operator()(const f32x4 (&acc)[2][2][4][2], const Unit& u, int wr, int wc, int fr, int fq) const {
        const int row0 = u.pm * BM + wr * 64 + fr; const bool ctx = (u.pn == 32);
        const int col0 = (ctx ? 0 : u.pn * BM) + wc * 32 + 8 * fq;
#pragma unroll
        for (int ai = 0; ai < 2; ++ai)
#pragma unroll
            for (int m = 0; m < 4; ++m) { const int r = row0 + ai * HALF + m * 16, cs = r >> 9, j = r & 511;
                bf16_t* rowp = ZT + (ctx ? (ztc_delta + (long)j * 512 + cs * 256) : ((long)j * 16384 + cs * 8192)) + col0;
#pragma unroll
                for (int bj = 0; bj < 2; ++bj) { const f32x4 v0 = acc[ai][bj][m][0], v1 = acc[ai][bj][m][1];
                    u32x4 w; w.x = cvt_pk_bf16(v0[0], v0[1]); w.y = cvt_pk_bf16(v0[2], v0[3]); w.z = cvt_pk_bf16(v1[0], v1[1]); w.w = cvt_pk_bf16(v1[2], v1[3]);
                    *(u32x4*)(rowp + bj * HALF) = w; } }
    }
};
struct EpiYF {
    static constexpr bool PERM = false, AFTER_DRAIN = false;
    float* YF; int row_off; size_t part_stride;
    __device__ __forceinline__ void operator()(const f32x4 (&acc)[2][2][4][2], const Unit& u, int wr, int wc, int fr, int fq) const {
        const int row0 = row_off + u.pm * BM + wr * 64 + fr, col0 = u.pn * BM + wc * 32 + 4 * fq;
        float* base = YF + (size_t)(u.kt0 / u.nt) * part_stride;
#pragma unroll
        for (int ai = 0; ai < 2; ++ai)
#pragma unroll
            for (int m = 0; m < 4; ++m) { float* rowp = base + (size_t)(row0 + ai * HALF + m * 16) * 512 + col0;
#pragma unroll
                for (int bj = 0; bj < 2; ++bj)
#pragma unroll
                    for (int n = 0; n < 2; ++n) *(f32x4*)(rowp + bj * HALF + n * 16) = acc[ai][bj][m][n]; }
    }
};

template <class Epi, class Sched, bool ALIGN_EPI = false, bool SP2 = false>
__device__ __forceinline__ void gemm_phase(PG8_LAS unsigned char* lds, const Gemm g, const Sched& S, const Epi& E) {
    int tid_ = threadIdx.x; asm volatile("" : "+v"(tid_));
    const int tid = tid_, wid = __builtin_amdgcn_readfirstlane(tid >> 6), lane = tid & 63, wr = wid >> 2, wc = wid & 3, fr = lane & 15, fq = lane >> 4;
    const int K = g.K;
    unsigned voffA[2], voffB[2];
#pragma unroll
    for (int i = 0; i < 2; ++i) { int R, C; stage_rc(tid * 16 + i * 8192, R, C); const int Rb = Epi::PERM ? ((R & ~31) + perm32(R & 31)) : R;
        voffA[i] = (unsigned)(R * K + C) * 2u; voffB[i] = (unsigned)(Rb * K + C) * 2u; }
    const size_t kstep = (size_t)(BK * 2);
    const size_t hstep = (size_t)HALF * K * 2;
    const size_t tstep = 2 * hstep;
    const unsigned ldsw = (unsigned)wid * 1024u;
    const int aoff = lds_byte(wr * 64 + fr, fq * 8), boff = lds_byte(wc * 32 + fr, fq * 8);
#define PG8_SA(b, h) (((b) * 2 + (h)) * HTB)
#define PG8_SB(b, h) ((4 + (b) * 2 + (h)) * HTB)
#define PG8_STAGE(bufoff, gbase, voff) do { _Pragma("unroll") for (int _i = 0; _i < 2; ++_i) \
        __builtin_amdgcn_global_load_lds((const unsigned*)((const char*)(gbase) + (voff)[_i]), (PG8_LAS unsigned*)(lds + (bufoff) + ldsw + _i * 8192), 16, 0, 0); } while (0)
#define PG8_LDA(dst, b, h) do { _Pragma("unroll") for (int m = 0; m < 4; ++m) _Pragma("unroll") for (int k = 0; k < 2; ++k) dst[m][k] = *(const PG8_LAS bf16x8*)(lds + PG8_SA(b, h) + aoff + m * 2048 + k * 1024); } while (0)
#define PG8_LDB(dst, b, h) do { _Pragma("unroll") for (int n = 0; n < 2; ++n) _Pragma("unroll") for (int k = 0; k < 2; ++k) dst[n][k] = *(const PG8_LAS bf16x8*)(lds + PG8_SB(b, h) + boff + n * 2048 + k * 1024); } while (0)
#define PG8_MMA(ai, bj, At, Bt) do { __builtin_amdgcn_s_setprio(1); _Pragma("unroll") for (int m = 0; m < 4; ++m) _Pragma("unroll") for (int n = 0; n < 2; ++n) _Pragma("unroll") for (int k = 0; k < 2; ++k) \
        acc[ai][bj][m][n] = __builtin_amdgcn_mfma_f32_16x16x32_bf16(Bt[n][k], At[m][k], acc[ai][bj][m][n], 0, 0, 0); __builtin_amdgcn_s_setprio(0); } while (0)
#define PG8_WAIT_V(n) asm volatile("s_waitcnt vmcnt(" #n ")" ::: "memory")
#define PG8_WAIT_L(n) asm volatile("s_waitcnt lgkmcnt(" #n ")" ::: "memory")
#define PG8_BAR __builtin_amdgcn_s_barrier()
#define PG8_SCHED __builtin_amdgcn_sched_barrier(0)
    Unit cur, nxt; int ui = 0;
    if (!S.next(0, cur)) return;
    f32x4 acc[2][2][4][2];
#pragma unroll
    for (int a = 0; a < 2; ++a)
#pragma unroll
        for (int b = 0; b < 2; ++b)
#pragma unroll
            for (int m = 0; m < 4; ++m)
#pragma unroll
                for (int n = 0; n < 2; ++n) acc[a][b][m][n] = (f32x4){0.f, 0.f, 0.f, 0.f};
    bf16x8 At[4][2], B0[2][2], B1[2][2];
    const char* cA = (const char*)g.A + (size_t)cur.pm * tstep + (size_t)cur.kt0 * kstep; const char* cB = (const char*)g.Bt + (size_t)cur.pn * tstep + (size_t)cur.kt0 * kstep;
    S.a_ready(cur);
    if constexpr (SP2) {
        PG8_STAGE(PG8_SB(0, 0), cB, voffB); PG8_STAGE(PG8_SB(0, 1), cB + hstep, voffB); PG8_STAGE(PG8_SA(0, 0), cA, voffA); PG8_STAGE(PG8_SA(0, 1), cA + hstep, voffA);
        if (wr == 1) PG8_BAR;
        PG8_WAIT_V(2); PG8_BAR;
        PG8_STAGE(PG8_SB(1, 0), cB + kstep, voffB); PG8_STAGE(PG8_SA(1, 0), cA + kstep, voffA); PG8_STAGE(PG8_SB(1, 1), cB + hstep + kstep, voffB);
        PG8_WAIT_V(6); PG8_BAR;
    } else {
        PG8_STAGE(PG8_SB(0, 0), cB, voffB); PG8_STAGE(PG8_SA(0, 0), cA, voffA); PG8_STAGE(PG8_SB(0, 1), cB + hstep, voffB); PG8_STAGE(PG8_SA(0, 1), cA + hstep, voffA);
        if (wr == 1) PG8_BAR;
        PG8_WAIT_V(4); PG8_BAR;
        PG8_STAGE(PG8_SB(1, 0), cB + kstep, voffB); PG8_STAGE(PG8_SA(1, 0), cA + kstep, voffA); PG8_STAGE(PG8_SB(1, 1), cB + hstep + kstep, voffB);
        PG8_WAIT_V(6); PG8_BAR;
    }
    for (;;) {
        const bool has_next = S.next(ui + 1, nxt);
        const char* nA = has_next ? (const char*)g.A + (size_t)nxt.pm * tstep + (size_t)nxt.kt0 * kstep : cA; const char* nB = has_next ? (const char*)g.Bt + (size_t)nxt.pn * tstep + (size_t)nxt.kt0 * kstep : cB;
        const int nt = cur.nt;
        for (int t = 0; t < nt; t += 2) {
            const bool last = (t == nt - 2);
            const char* a1 = cA + (size_t)(t + 1) * kstep;
            const char* a2 = last ? nA : cA + (size_t)(t + 2) * kstep; const char* b2 = last ? nB : cB + (size_t)(t + 2) * kstep;
            const char* a3 = a2 + kstep; const char* b3 = b2 + kstep;
            if (last && has_next) S.a_ready(nxt);
            if constexpr (SP2) {
            PG8_LDB(B0, 0, 0); PG8_LDB(B1, 0, 1); PG8_SCHED; PG8_LDA(At, 0, 0); PG8_STAGE(PG8_SA(1, 1), a1 + hstep, voffA);
            PG8_WAIT_V(8); PG8_WAIT_L(0); PG8_BAR; PG8_MMA(0, 0, At, B0); PG8_MMA(0, 1, At, B1); PG8_BAR; PG8_SCHED;
            PG8_LDA(At, 0, 1); PG8_STAGE(PG8_SB(0, 0), b2, voffB); PG8_STAGE(PG8_SB(0, 1), b2 + hstep, voffB); PG8_STAGE(PG8_SA(0, 0), a2, voffA);
            PG8_WAIT_V(8); PG8_WAIT_L(0); PG8_BAR; PG8_MMA(1, 0, At, B0); PG8_MMA(1, 1, At, B1); PG8_BAR; PG8_SCHED;
            PG8_LDB(B0, 1, 0); PG8_LDB(B1, 1, 1); PG8_SCHED; PG8_LDA(At, 1, 0); PG8_STAGE(PG8_SA(0, 1), a2 + hstep, voffA);
            PG8_WAIT_V(8); PG8_WAIT_L(0); PG8_BAR; PG8_MMA(0, 0, At, B0); PG8_MMA(0, 1, At, B1); PG8_BAR; PG8_SCHED;
            PG8_LDA(At, 1, 1); PG8_STAGE(PG8_SB(1, 0), b3, voffB); PG8_STAGE(PG8_SB(1, 1), b3 + hstep, voffB); PG8_STAGE(PG8_SA(1, 0), a3, voffA);
            PG8_WAIT_V(8); PG8_WAIT_L(0); PG8_BAR; PG8_MMA(1, 0, At, B0); PG8_MMA(1, 1, At, B1); PG8_BAR; PG8_SCHED;
            } else {
            PG8_LDB(B0, 0, 0); PG8_SCHED; PG8_LDA(At, 0, 0); PG8_STAGE(PG8_SA(1, 1), a1 + hstep, voffA);
            PG8_WAIT_L(8); PG8_BAR; PG8_WAIT_L(0); PG8_MMA(0, 0, At, B0); PG8_BAR; PG8_SCHED;
            PG8_LDB(B1, 0, 1); PG8_STAGE(PG8_SB(0, 0), b2, voffB);
            PG8_BAR; PG8_WAIT_L(0); PG8_MMA(0, 1, At, B1); PG8_BAR;
            PG8_LDA(At, 0, 1); PG8_STAGE(PG8_SA(0, 0), a2, voffA);
            PG8_BAR; PG8_WAIT_L(0); PG8_MMA(1, 0, At, B0); PG8_BAR; PG8_SCHED;
            PG8_STAGE(PG8_SB(0, 1), b2 + hstep, voffB);
            PG8_WAIT_V(6); PG8_BAR; PG8_MMA(1, 1, At, B1); PG8_BAR;
            PG8_LDB(B0, 1, 0); PG8_SCHED; PG8_LDA(At, 1, 0); PG8_STAGE(PG8_SA(0, 1), a2 + hstep, voffA);
            PG8_WAIT_L(8); PG8_BAR; PG8_WAIT_L(0); PG8_MMA(0, 0, At, B0); PG8_BAR; PG8_SCHED;
            PG8_LDB(B1, 1, 1); PG8_STAGE(PG8_SB(1, 0), b3, voffB);
            PG8_BAR; PG8_WAIT_L(0); PG8_MMA(0, 1, At, B1); PG8_BAR;
            PG8_LDA(At, 1, 1); PG8_STAGE(PG8_SA(1, 0), a3, voffA);
            PG8_BAR; PG8_WAIT_L(0); PG8_MMA(1, 0, At, B0); PG8_BAR; PG8_SCHED;
            PG8_STAGE(PG8_SB(1, 1), b3 + hstep, voffB);
            PG8_WAIT_V(6); PG8_BAR; PG8_MMA(1, 1, At, B1); PG8_BAR;
            }
        }
        if constexpr (ALIGN_EPI) { if (wr == 0) PG8_BAR; }
        if constexpr (!Epi::AFTER_DRAIN) { E(acc, cur, wr, wc, fr, fq); S.done(cur); }
        if (!has_next) break;
#pragma unroll
        for (int a = 0; a < 2; ++a)
#pragma unroll
            for (int b = 0; b < 2; ++b)
#pragma unroll
                for (int m = 0; m < 4; ++m)
#pragma unroll
                    for (int n = 0; n < 2; ++n) acc[a][b][m][n] = (f32x4){0.f, 0.f, 0.f, 0.f};
        cur = nxt; cA = nA; cB = nB; ++ui;
        if constexpr (ALIGN_EPI) { if (wr == 1) PG8_BAR; }
    }
    PG8_WAIT_V(0);
    if constexpr (!ALIGN_EPI) { if (wr == 0) PG8_BAR; }
    PG8_BAR;
    if constexpr (Epi::AFTER_DRAIN) { E.fused(acc, cur, wr, wc, fr, fq, lds, wid, lane); S.done(cur); }
#undef PG8_SA
#undef PG8_SB
#undef PG8_STAGE
#undef PG8_LDA
#undef PG8_LDB
#undef PG8_MMA
#undef PG8_WAIT_V
#undef PG8_WAIT_L
#undef PG8_BAR
#undef PG8_SCHED
}
}
#define XB_TMO      128
#define XB_XCNT(j)  (256  + 64 * (j))
#define XB_XSUB(j)  (1280 + 64 * (j))
#define XB_XGEN(j)  (2304 + 64 * (j))
#define XB_TOP      3328
#define XB_TOPGEN   3392
#define XCD_BAR_WORDS 3456
#define XB_SPIN_CAP (1u << 18)

__device__ __forceinline__ unsigned xb_ld(unsigned* p)              { return __hip_atomic_load(p, __ATOMIC_RELAXED, __HIP_MEMORY_SCOPE_AGENT); }
__device__ __forceinline__ unsigned xb_add(unsigned* p, unsigned v) { return __hip_atomic_fetch_add(p, v, __ATOMIC_RELAXED, __HIP_MEMORY_SCOPE_AGENT); }
__device__ __forceinline__ unsigned xb_xcc_id() { return (unsigned)__builtin_amdgcn_s_getreg((3 << 11) | 20) & 0xFu; }
#define XB_SPIN(cond, bar) do { unsigned _sp = 0; while (cond) { __builtin_amdgcn_s_sleep(1); \
    if ((++_sp & 255u) == 0u) { if (xb_ld(&(bar)[XB_TMO])) break; if (_sp > XB_SPIN_CAP) { atomicAdd(&(bar)[XB_TMO], 1u); break; } } } } while (0)

struct XcdBarrier {
    unsigned* bar; unsigned x;
    volatile LAS unsigned* st;
};

__device__ __forceinline__ XcdBarrier xcd_barrier_post(unsigned* bar, volatile LAS unsigned* st) {
    XcdBarrier b; b.bar = bar; b.x = xb_xcc_id(); b.st = st;
    if (threadIdx.x == 0) (void)xb_add(&bar[XB_XCNT(b.x)], 1u);
    return b;
}
__device__ __forceinline__ void xcd_barrier_complete(unsigned* bar, unsigned x, unsigned& nloc, unsigned& nx) {
    const unsigned G = gridDim.x * gridDim.y * gridDim.z;
    unsigned sum, cnt, mine, sp = 0u;
    for (;;) {
        sum = 0u; cnt = 0u; mine = 0u;
#pragma unroll
        for (unsigned j = 0; j < 16; ++j) { const unsigned c = xb_ld(&bar[XB_XCNT(j)]); sum += c; cnt += (c > 0u) ? 1u : 0u; mine = (j == x) ? c : mine; }
        if (sum == G) break;
        __builtin_amdgcn_s_sleep(1);
        if ((++sp & 255u) == 0u) { if (xb_ld(&bar[XB_TMO])) break; if (sp > XB_SPIN_CAP) { atomicAdd(&bar[XB_TMO], 1u); break; } }
    }
    nloc = mine > 0u ? mine : 1u; nx = cnt > 0u ? cnt : 1u;
}

__device__ __forceinline__ void xcd_barrier(const XcdBarrier& b) {
    asm volatile("s_waitcnt vmcnt(0)" ::: "memory");
    __syncthreads();
    if (threadIdx.x == 0) {
        unsigned* bar = b.bar;
        __builtin_amdgcn_s_waitcnt(0);
        unsigned nloc = b.st[0], nx = b.st[1];
        if (nloc == 0u) { xcd_barrier_complete(bar, b.x, nloc, nx); b.st[0] = nloc; b.st[1] = nx; }
        const unsigned old = xb_add(&bar[XB_XSUB(b.x)], 1u);
        const unsigned gen = old / nloc;
        if (old + 1u == (gen + 1u) * nloc) {
            __builtin_amdgcn_fence(__ATOMIC_RELEASE, "agent");
            asm volatile("s_waitcnt vmcnt(0)" ::: "memory");
            const unsigned og = xb_add(&bar[XB_TOP], 1u);
            const unsigned tg = og / nx;
            if (og + 1u == (tg + 1u) * nx) xb_add(&bar[XB_TOPGEN], 1u);
            else XB_SPIN(xb_ld(&bar[XB_TOPGEN]) == tg, bar);
            __builtin_amdgcn_fence(__ATOMIC_ACQUIRE, "agent");
            xb_add(&bar[XB_XGEN(b.x)], 1u);
            asm volatile("s_waitcnt vmcnt(0)" ::: "memory");
        } else {
            XB_SPIN(xb_ld(&bar[XB_XGEN(b.x)]) == gen, bar);
            __builtin_amdgcn_fence(__ATOMIC_ACQUIRE, "agent");
            asm volatile("s_waitcnt vmcnt(0)" ::: "memory");
        }
    }
    __syncthreads();
}

namespace att {
typedef unsigned short bf16;
constexpr int D = 128, NW = 8, QBLK = 32, KVBLK = 64;
constexpr float SCALE = 0.088388347648318440f;
constexpr float THR = 8.f;
constexpr int LDQ = 512, LDK = 256, LDO = 512;
constexpr size_t SHM_V = KVBLK * D * 2, SHM_K = KVBLK * D * 2, SHM_ATTN = 2 * SHM_V + 2 * SHM_K + NW * 64 * 4;
using bf16x8 = __attribute__((ext_vector_type(8))) short;
using s16x4  = __attribute__((ext_vector_type(4))) short;
using f32x16 = __attribute__((ext_vector_type(16))) float;
using u32x4  = __attribute__((ext_vector_type(4))) unsigned;
#define KSWZ(row, colB) ((row) * 256 + ((colB) ^ (((row) & 7) << 4)))
#define SBAR() __builtin_amdgcn_sched_barrier(0)
__device__ __forceinline__ int crow(int r, int hi) { return (r & 3) + 8 * (r >> 2) + 4 * hi; }
__device__ __forceinline__ unsigned cvtpk(float lo, float hi) { unsigned r; asm volatile("v_cvt_pk_bf16_f32 %0, %1, %2" : "=v"(r) : "v"(lo), "v"(hi)); return r; }
__device__ __forceinline__ void partialSM(f32x16& p0, f32x16& p1, float& m_reg, float& mn, float& alpha) {
  constexpr float C = SCALE * 1.4426950408889634f;
  float pmax = p0[0]; for (int r = 1; r < 16; ++r) pmax = fmaxf(pmax, p0[r]); for (int r = 0; r < 16; ++r) pmax = fmaxf(pmax, p1[r]);
  { auto rr = __builtin_amdgcn_permlane32_swap(__float_as_uint(pmax), __float_as_uint(pmax), false, false);
    pmax = fmaxf(__uint_as_float(rr[0]), __uint_as_float(rr[1])); }
  if (__builtin_expect(__all(pmax - m_reg <= THR / SCALE), 1)) { mn = m_reg; alpha = 1.f; }
  else { mn = fmaxf(m_reg, pmax); alpha = __builtin_amdgcn_exp2f((m_reg - mn) * C); m_reg = mn; }
  float mnC = -mn * C;
  for (int r = 0; r < 16; ++r) p0[r] = fmaf(p0[r], C, mnC); for (int r = 0; r < 16; ++r) p1[r] = fmaf(p1[r], C, mnC);
  for (int r = 0; r < 16; ++r) p0[r] = __builtin_amdgcn_exp2f(p0[r]);
}
__device__ __forceinline__ void finishSM(f32x16& p0, f32x16& p1, float alpha, float& l_reg, bf16x8& pa0, bf16x8& pa1, bf16x8& pa2, bf16x8& pa3) {
  for (int r = 0; r < 16; ++r) p1[r] = __builtin_amdgcn_exp2f(p1[r]);
  float ps = 0; for (int r = 0; r < 16; ++r) ps += p0[r]; for (int r = 0; r < 16; ++r) ps += p1[r];
  { auto rr = __builtin_amdgcn_permlane32_swap(__float_as_uint(ps), __float_as_uint(ps), false, false);
    ps = __uint_as_float(rr[0]) + __uint_as_float(rr[1]); }
  l_reg = l_reg * alpha + ps;
#define PK4(P, BASE, OUT) do { unsigned a0 = cvtpk(P[BASE + 0], P[BASE + 1]), a1 = cvtpk(P[BASE + 2], P[BASE + 3]);   \
    unsigned b0 = cvtpk(P[BASE + 4], P[BASE + 5]), b1 = cvtpk(P[BASE + 6], P[BASE + 7]);                              \
    auto r0 = __builtin_amdgcn_permlane32_swap(a0, b0, false, false); auto r1 = __builtin_amdgcn_permlane32_swap(a1, b1, false, false); \
    u32x4 w = {r0[0], r1[0], r0[1], r1[1]}; OUT = *reinterpret_cast<bf16x8*>(&w); } while (0)
  PK4(p0, 0, pa0); PK4(p0, 8, pa1); PK4(p1, 0, pa2); PK4(p1, 8, pa3);
#undef PK4
}
__device__ __forceinline__ void qkt(f32x16& p0, f32x16& p1, const bf16* Ks, const bf16x8* qr, int r32, int hi) {
  p0 = f32x16{}; p1 = f32x16{};
  for (int d0 = 0; d0 < 8; ++d0) { int cb = (d0 * 16 + hi * 8) * 2;
    bf16x8 b0 = *reinterpret_cast<const bf16x8*>((const char*)Ks + KSWZ(r32, cb));
    bf16x8 b1 = *reinterpret_cast<const bf16x8*>((const char*)Ks + KSWZ(32 + r32, cb));
    p0 = __builtin_amdgcn_mfma_f32_32x32x16_bf16(b0, qr[d0], p0, 0, 0, 0);
    p1 = __builtin_amdgcn_mfma_f32_32x32x16_bf16(b1, qr[d0], p1, 0, 0, 0); }
}
__device__ __forceinline__ int v_st(int k, int c) { const int kk = (k & ~0xC) | ((k & 4) << 1) | ((k & 8) >> 1); return ((kk >> 3) * 4 + (c >> 5)) * 512 + ((kk & 7) * 32 + (c & 31)) * 2; }
__device__ __forceinline__ int v_rd_base(int lane) { return ((lane & 3) << 3) | (((lane >> 2) & 3) << 6) | (((lane >> 4) & 1) << 5) | (((lane >> 5) & 1) << 8); }
constexpr int v_rd_off(int d0, int ks, int half) { return d0 * 512 + ks * 4096 + half * 2048; }
template <int OFF> __device__ __forceinline__ s16x4 tr_read(int vb) {
  s16x4 r; asm volatile("ds_read_b64_tr_b16 %0, %1 offset:%2" : "=&v"(r) : "v"(vb), "i"(OFF) : "memory"); return r;
}
template <int D0> __device__ __forceinline__ void pv_one(f32x16& od, int vb, bf16x8 pa0, bf16x8 pa1, bf16x8 pa2, bf16x8 pa3) {
  const s16x4 l0 = tr_read<v_rd_off(D0, 0, 0)>(vb), h0 = tr_read<v_rd_off(D0, 0, 1)>(vb), l1 = tr_read<v_rd_off(D0, 1, 0)>(vb), h1 = tr_read<v_rd_off(D0, 1, 1)>(vb);
  const s16x4 l2 = tr_read<v_rd_off(D0, 2, 0)>(vb), h2 = tr_read<v_rd_off(D0, 2, 1)>(vb), l3 = tr_read<v_rd_off(D0, 3, 0)>(vb), h3 = tr_read<v_rd_off(D0, 3, 1)>(vb);
  asm volatile("s_waitcnt lgkmcnt(0)" ::: "memory"); SBAR();
#define PK(L, H) (bf16x8){L[0], L[1], L[2], L[3], H[0], H[1], H[2], H[3]}
  od = __builtin_amdgcn_mfma_f32_32x32x16_bf16(pa0, PK(l0, h0), od, 0, 0, 0);
  od = __builtin_amdgcn_mfma_f32_32x32x16_bf16(pa1, PK(l1, h1), od, 0, 0, 0);
  od = __builtin_amdgcn_mfma_f32_32x32x16_bf16(pa2, PK(l2, h2), od, 0, 0, 0);
  od = __builtin_amdgcn_mfma_f32_32x32x16_bf16(pa3, PK(l3, h3), od, 0, 0, 0);
#undef PK
}
__device__ __forceinline__ void pv_d0(f32x16* o, int vb, bf16x8 pa0, bf16x8 pa1, bf16x8 pa2, bf16x8 pa3) {
  pv_one<0>(o[0], vb, pa0, pa1, pa2, pa3); pv_one<1>(o[1], vb, pa0, pa1, pa2, pa3); pv_one<2>(o[2], vb, pa0, pa1, pa2, pa3); pv_one<3>(o[3], vb, pa0, pa1, pa2, pa3);
}
__device__ __forceinline__ void attn_unit(const bf16* __restrict__ Qb, const bf16* __restrict__ Kh, const bf16* __restrict__ Vh, float* __restrict__ Ob, float* __restrict__ MLb, int seq, char* lds) {
  int tid_ = threadIdx.x; asm volatile("" : "+v"(tid_));
  const int tid = tid_, wid = tid >> 6, lane = tid & 63, r32 = lane & 31, hi = lane >> 5;
  bf16* V_lds = (bf16*)lds; bf16* K_lds = (bf16*)(lds + 2 * SHM_V);
  float* ws = (float*)(lds + 2 * SHM_V + 2 * SHM_K) + wid * 64; float* al_l = ws + 32;
  float m_reg = -1e30f, l_reg = 0; f32x16 o[4] = {}; bf16x8 qr[8];
  const bf16* Qw = Qb + (long)(wid * QBLK + r32) * LDQ + hi * 8;
#pragma unroll
  for (int d0 = 0; d0 < 8; ++d0) qr[d0] = *reinterpret_cast<const bf16x8*>(Qw + d0 * 16);
  const int sr = tid >> 4, sc = (tid & 15) * 8, vst0 = v_st(sr, sc), vst1 = v_st(32 + sr, sc);
  const int vb0 = (int)(uintptr_t)V_lds + v_rd_base(lane);
  struct { bf16x8 vs0, vs1, ks0, ks1; } sr_[2];
#define SLOAD(i, k0) do { sr_[i].vs0 = *reinterpret_cast<const bf16x8*>(&Vh[(long)((k0) + sr) * LDK + sc]); sr_[i].vs1 = *reinterpret_cast<const bf16x8*>(&Vh[(long)((k0) + 32 + sr) * LDK + sc]); \
    sr_[i].ks0 = *reinterpret_cast<const bf16x8*>(&Kh[(long)((k0) + sr) * LDK + sc]); sr_[i].ks1 = *reinterpret_cast<const bf16x8*>(&Kh[(long)((k0) + 32 + sr) * LDK + sc]); } while (0)
#define SWRITE(b, i) do { *(bf16x8*)((char*)V_lds + (b) * SHM_V + vst0) = sr_[i].vs0;          \
    *(bf16x8*)((char*)V_lds + (b) * SHM_V + vst1) = sr_[i].vs1; int kc = sc * 2;               \
    *(bf16x8*)((char*)K_lds + (b) * SHM_K + KSWZ(sr, kc)) = sr_[i].ks0;                       \
    *(bf16x8*)((char*)K_lds + (b) * SHM_K + KSWZ(32 + sr, kc)) = sr_[i].ks1; } while (0)
#define SWAIT() asm volatile("s_waitcnt vmcnt(4)" ::: "memory")
#define RESC(a) do { if (__any((a) < 1.f)) { if (hi == 0) al_l[r32] = (a); asm volatile("s_waitcnt lgkmcnt(0)" ::: "memory"); \
    for (int d = 0; d < 4; ++d) for (int r = 0; r < 16; ++r) o[d][r] *= al_l[crow(r, hi)]; } } while (0)
  f32x16 pA0, pA1, pB0, pB1; float mnA, mnB, alA, alB; bf16x8 pa0, pa1, pa2, pa3; const int NT = seq / KVBLK;
  constexpr int SE = 0, SO = 1;
  SLOAD(SE, 0); asm volatile("s_waitcnt vmcnt(0)" ::: "memory"); SWRITE(0, SE); __syncthreads();
  qkt(pA0, pA1, K_lds, qr, r32, hi); partialSM(pA0, pA1, m_reg, mnA, alA);
  SLOAD(SO, KVBLK); if (2 < NT) SLOAD(SE, 2 * KVBLK);
  SWAIT(); SWRITE(1, SO); __syncthreads();
  for (int j = 1; j + 1 < NT; j += 2) {
    SBAR(); qkt(pB0, pB1, (bf16*)((char*)K_lds + SHM_K), qr, r32, hi);
    finishSM(pA0, pA1, alA, l_reg, pa0, pa1, pa2, pa3); SBAR();
    SLOAD(SO, (j + 2) * KVBLK); SBAR();
    pv_d0(o, vb0, pa0, pa1, pa2, pa3); partialSM(pB0, pB1, m_reg, mnB, alB);
    __syncthreads(); SWAIT(); SWRITE(0, SE);
    RESC(alB); __syncthreads();
    SBAR(); qkt(pA0, pA1, K_lds, qr, r32, hi);
    finishSM(pB0, pB1, alB, l_reg, pa0, pa1, pa2, pa3); SBAR();
    if (j + 3 < NT) SLOAD(SE, (j + 3) * KVBLK); SBAR();
    pv_d0(o, vb0 + (int)SHM_V, pa0, pa1, pa2, pa3); partialSM(pA0, pA1, m_reg, mnA, alA);
    __syncthreads(); SWAIT(); SWRITE(1, SO);
    RESC(alA); __syncthreads();
  }
  SBAR(); qkt(pB0, pB1, (bf16*)((char*)K_lds + SHM_K), qr, r32, hi);
  finishSM(pA0, pA1, alA, l_reg, pa0, pa1, pa2, pa3); SBAR();
  pv_d0(o, vb0, pa0, pa1, pa2, pa3); partialSM(pB0, pB1, m_reg, mnB, alB);
  __syncthreads(); RESC(alB);
  finishSM(pB0, pB1, alB, l_reg, pa0, pa1, pa2, pa3); SBAR();
  pv_d0(o, vb0 + (int)SHM_V, pa0, pa1, pa2, pa3);
  if (hi == 0) { float* ml = MLb + (long)(wid * QBLK + r32) * 8; ml[0] = m_reg; ml[1] = l_reg; }
  float* Ow = Ob + (long)(wid * QBLK) * LDO;
#pragma unroll
  for (int r = 0; r < 16; ++r) { int orow = crow(r, hi);
    for (int d0 = 0; d0 < 4; ++d0) Ow[(long)orow * LDO + d0 * 32 + r32] = o[d0][r]; }
#undef SLOAD
#undef SWRITE
#undef SWAIT
#undef RESC
}
#undef KSWZ
#undef SBAR
}

struct Frame {
    LAS unsigned char* lds;
    unsigned char* gl;
    volatile LAS unsigned* MISC;
    gu32* ctl;
    int tid, lane, wave, G, bid;
};

__device__ __forceinline__ Frame fresh(const Frame& F) {
    Frame R = F; int t = F.tid; asm volatile("" : "+v"(t)); R.tid = t; R.lane = t & 63; R.wave = __builtin_amdgcn_readfirstlane(t >> 6);
    int b = F.bid; asm volatile("" : "+s"(b)); R.bid = b; int g = F.G; asm volatile("" : "+s"(g)); R.G = g; return R;
}
__device__ __forceinline__ void tr_item(const float* __restrict__ W, int N, int k0, int n0, bf16* __restrict__ WT, int Kd, int drow0, LAS float* scr, int lane) {
#pragma unroll 8
    for (int i = 0; i < 32; ++i) { const int kk = 2 * i + (lane >> 5); scr[kk * 33 + (lane & 31)] = W[(size_t)(k0 + kk) * N + n0 + (lane & 31)]; }
    LDS_WAIT(); asm volatile("" ::: "memory");
    const int c = lane & 7;
#pragma unroll
    for (int j = 0; j < 4; ++j) { const int n = (lane >> 3) + 8 * j; const LAS float* s = scr + (8 * c) * 33 + n;
        u32x4 o; o.x = pk2(s[0 * 33], s[1 * 33]); o.y = pk2(s[2 * 33], s[3 * 33]); o.z = pk2(s[4 * 33], s[5 * 33]); o.w = pk2(s[6 * 33], s[7 * 33]);
        *(u32x4*)(WT + (size_t)(drow0 + n) * Kd + k0 + 8 * c) = o; }
    LDS_WAIT(); asm volatile("" ::: "memory");
}

struct In {
    const float *x, *c, *ctx, *c_ctx, *mod_w, *mod_b, *norm_g, *final_g, *ffn_w13, *ffn_w2, *w_in, *w_out, *lru_conv_w, *lru_conv_b, *lru_gate_w, *lru_gate_b, *lru_lambda, *attn_qk_g, *gla_gate_w, *gla_gate_b, *gla_out_g;
};

__device__ __forceinline__ void prologue_a(const Frame& F_, const In& I, unsigned char* ws) {
    const Frame F = fresh(F_);
    const int gw = F.bid * NWAVES + F.wave, NGW = F.G * NWAVES;
    { const f32x4* xs = (const f32x4*)I.x; const f32x4* cs = (const f32x4*)I.ctx; f32x4* X = (f32x4*)(ws + WS_X);
      const int nl = TL * DM / 4, nt = MR * DM / 4;
      for (int i = F.bid * 512 + F.tid; i < nt; i += F.G * 512) X[i] = (i < nl) ? xs[i] : cs[i - nl]; }
    { float* MODP = (float*)(ws + WS_YF);
      for (int it = gw; it < NLAY * 72 * 8; it += NGW) {
          const int ks = it & 7, r = it >> 3, jb = r % 72, l = r / 72; const int j = jb * 256 + 4 * F.lane;
          const float* W = I.mod_w + ((size_t)l * DM + ks * 256) * (9 * DM) + j;
          f32x4 a0 = {0.f, 0.f, 0.f, 0.f}, a1 = {0.f, 0.f, 0.f, 0.f};
#pragma unroll 8
          for (int k = 0; k < 256; ++k) { const f32x4 w = *(const f32x4*)(W + (size_t)k * (9 * DM)); const float c0 = I.c[ks * 256 + k], c1 = I.c_ctx[ks * 256 + k];
              a0 += w * siluf_(c0); a1 += w * siluf_(c1); }
          *(f32x4*)(MODP + ((size_t)(ks * NLAY + l) * 2 + 0) * (9 * DM) + j) = a0;
          *(f32x4*)(MODP + ((size_t)(ks * NLAY + l) * 2 + 1) * (9 * DM) + j) = a1;
      } }
    LAS float* scr = (LAS float*)(F.lds + RING_OFF + F.wave * 16384);
    { constexpr int PER = 32 * 352;
      bf16* dst = (bf16*)(ws + WS_W13T);
      for (int it = gw; it < 8 * PER; it += NGW) { const int mat = it / PER, r = it % PER, kb = r / 352, nb = r % 352, n0 = nb * 32;
          const int drow0 = (n0 < FF) ? (n0 / 128) * 256 + (n0 % 128) : ((n0 - FF) / 128) * 256 + 128 + ((n0 - FF) % 128);
          tr_item(I.ffn_w13 + (size_t)mat * DM * 2 * FF, 2 * FF, kb * 64, n0, dst + (size_t)mat * 2 * FF * DM, DM, drow0, scr, F.lane); } }
    { constexpr int PER = 88 * 64;
      bf16* dst = (bf16*)(ws + WS_W2T);
      for (int it = gw; it < 8 * PER; it += NGW) { const int mat = it / PER, r = it % PER, kb = r / 64, nb = r % 64;
          tr_item(I.ffn_w2 + (size_t)mat * FF * DM, DM, kb * 64, nb * 32, dst + (size_t)mat * DM * FF, FF, nb * 32, scr, F.lane); } }
    { constexpr int PER = 32 * 129;
      bf16* dst = (bf16*)(ws + WS_WINT); bf16* dlr = (bf16*)(ws + WS_WLRT);
      for (int it = gw; it < 4 * PER; it += NGW) { const int mat = it / PER, r = it % PER, kb = r / 129, nb = r % 129;
          if (nb == 112) tr_item(I.w_in + (size_t)mat * DM * DIN, DIN, kb * 64, nb * 32, dlr + (size_t)mat * 32 * DM, DM, 0, scr, F.lane);
          else tr_item(I.w_in + (size_t)mat * DM * DIN, DIN, kb * 64, nb * 32, dst + (size_t)mat * 4096 * DM, DM, (nb < 112) ? nb * 32 : nb * 32 - 32, scr, F.lane); } }
    { constexpr int PER = 32 * 64;
      bf16* dst = (bf16*)(ws + WS_WOUTT);
      for (int it = gw; it < 4 * PER; it += NGW) { const int mat = it / PER, r = it % PER, kb = r / 64, nb = r % 64;
          tr_item(I.w_out + (size_t)mat * DM * DM, DM, kb * 64, nb * 32, dst + (size_t)mat * DM * DM, DM, nb * 32, scr, F.lane); } }
}
__device__ __forceinline__ void prologue_b(const Frame& F_, const In& I, unsigned char* ws) {
    const Frame F = fresh(F_);
    const int gt = F.bid * 512 + F.tid, NGT = F.G * 512;
    { const float* MODP = (const float*)(ws + WS_YF); float* MODV = (float*)(ws + WS_MODV);
      for (int i = gt; i < NLAY * 2 * 9 * DM; i += NGT) { const int l = i / (2 * 9 * DM), j = i % (9 * DM);
          float s = I.mod_b[l * 9 * DM + j];
#pragma unroll
          for (int ks = 0; ks < 8; ++ks) s += MODP[(size_t)ks * NLAY * 2 * 9 * DM + i];
          MODV[i] = s; } }
    { bf16* A = (bf16*)(ws + WS_ADFT);
      for (int i = gt; i < TL * 2048; i += NGT) { const int k1 = i >> 11, c0 = (i & 2047) * 8; float v[8];
#pragma unroll
          for (int e = 0; e < 8; ++e) { const int col = c0 + e, t = col & 8191; const float f = (float)((k1 * t) & 8191) * (1.0f / 8192.0f);
              v[e] = (col < 8192) ? __builtin_amdgcn_cosf(f) : __builtin_amdgcn_sinf(-f); }
          u32x4 o; o.x = pk2(v[0], v[1]); o.y = pk2(v[2], v[3]); o.z = pk2(v[4], v[5]); o.w = pk2(v[6], v[7]);
          *(u32x4*)(A + (size_t)k1 * 16384 + c0) = o; } }
    { bf16* A = (bf16*)(ws + WS_ADFTC);
      for (int i = gt; i < TCX * 64; i += NGT) { const int k1 = i >> 6, c0 = (i & 63) * 8; float v[8];
#pragma unroll
          for (int e = 0; e < 8; ++e) { const int col = c0 + e, t = col & 255; const float f = (float)((k1 * t) & 255) * (1.0f / 256.0f);
              v[e] = (col < 256) ? __builtin_amdgcn_cosf(f) : __builtin_amdgcn_sinf(-f); }
          u32x4 o; o.x = pk2(v[0], v[1]); o.y = pk2(v[2], v[3]); o.z = pk2(v[4], v[5]); o.w = pk2(v[6], v[7]);
          *(u32x4*)(A + (size_t)k1 * 512 + c0) = o; } }
    { bf16* A = (bf16*)(ws + WS_ADFT1);
      for (int i = gt; i < 1024 * 64; i += NGT) { const int m = i >> 6, c0 = (i & 63) * 8, cs = m >> 9, g = (m >> 7) & 3, k2 = m & 127; float v[8];
#pragma unroll
          for (int e = 0; e < 8; ++e) { const int k = c0 + e, gp = k >> 7, c = k & 127; const float f = (float)((c * k2) & 127) * (1.0f / 128.0f);
              v[e] = (gp == g) ? (cs ? __builtin_amdgcn_sinf(f) : __builtin_amdgcn_cosf(f)) : 0.0f; }
          u32x4 o; o.x = pk2(v[0], v[1]); o.y = pk2(v[2], v[3]); o.z = pk2(v[4], v[5]); o.w = pk2(v[6], v[7]);
          *(u32x4*)(A + (size_t)m * 512 + c0) = o; } }
    { float* R = (float*)(ws + WS_ROPE);
      for (int i = gt; i < 128 * 32; i += NGT) { const int pos = i >> 5, fi = i & 31;
          const float freq = powf(10000.0f, -(float)fi / 32.0f); const float ang = (float)pos * freq;
          const double rev = (double)ang * 0.15915494309189535; const float fr = (float)(rev - floor(rev));
          R[i] = __builtin_amdgcn_cosf(fr); R[128 * 32 + i] = __builtin_amdgcn_sinf(fr); } }
}

__device__ __forceinline__ void norm_phase(const Frame& F_, const float* __restrict__ X, bf16* __restrict__ XN, const float* __restrict__ g,
                                           const float* __restrict__ shl, const float* __restrict__ scl, const float* __restrict__ shc, const float* __restrict__ scc) {
    const Frame F = fresh(F_);
    const int gw = F.bid * NWAVES + F.wave, NGW = F.G * NWAVES;
    for (int row = gw; row < MR; row += NGW) {
        const float* xr = X + (size_t)row * DM; const float* sh = (row >= TL) ? shc : shl; const float* sc = (row >= TL) ? scc : scl;
        f32x4 v[8]; float s = 0.f;
#pragma unroll
        for (int j = 0; j < 8; ++j) { v[j] = *(const f32x4*)(xr + 256 * j + 4 * F.lane); s += (v[j].x * v[j].x + v[j].y * v[j].y) + (v[j].z * v[j].z + v[j].w * v[j].w); }
        const float r = rsqrtf(wave_sum(s) * (1.0f / DM) + EPS);
#pragma unroll
        for (int j = 0; j < 8; ++j) { const int c = 256 * j + 4 * F.lane; const f32x4 gv = *(const f32x4*)(g + c), sv = *(const f32x4*)(sc + c), hv = *(const f32x4*)(sh + c);
            const f32x4 y = v[j] * r * gv * (sv + 1.0f) + hv; u32x2 o; o.x = pk2(y.x, y.y); o.y = pk2(y.z, y.w); *(u32x2*)(XN + (size_t)row * DM + c) = o; }
    }
}
__device__ __forceinline__ void final_norm(const Frame& F_, const float* __restrict__ X, float* __restrict__ out, const float* __restrict__ g) {
    const Frame F = fresh(F_);
    const int gw = F.bid * NWAVES + F.wave, NGW = F.G * NWAVES;
    for (int row = gw; row < TL; row += NGW) {
        const float* xr = X + (size_t)row * DM; f32x4 v[8]; float s = 0.f;
#pragma unroll
        for (int j = 0; j < 8; ++j) { v[j] = *(const f32x4*)(xr + 256 * j + 4 * F.lane); s += (v[j].x * v[j].x + v[j].y * v[j].y) + (v[j].z * v[j].z + v[j].w * v[j].w); }
        const float r = rsqrtf(wave_sum(s) * (1.0f / DM) + EPS);
#pragma unroll
        for (int j = 0; j < 8; ++j) { const int c = 256 * j + 4 * F.lane; *(f32x4*)(out + (size_t)row * DM + c) = v[j] * r * *(const f32x4*)(g + c); }
    }
}
__device__ __forceinline__ void lr_phase(const Frame& F_, const bf16* __restrict__ XN, const bf16* __restrict__ WLRT, float* __restrict__ LR) {
    const Frame F = fresh(F_);
    __syncthreads();
    { const u32x4* src = (const u32x4*)WLRT; LAS u32x4* dst = (LAS u32x4*)(F.lds + RING_OFF);
      for (int i = F.tid; i < 32 * DM * 2 / 16; i += 512) dst[i] = src[i]; }
    __syncthreads();
    const int gw = F.bid * NWAVES + F.wave, NGW = F.G * NWAVES;
    for (int row = gw; row < MR; row += NGW) {
        float xv[32];
#pragma unroll
        for (int j = 0; j < 8; ++j) { const u32x2 p = *(const u32x2*)(XN + (size_t)row * DM + 256 * j + 4 * F.lane);
            xv[4 * j + 0] = __uint_as_float(p.x << 16); xv[4 * j + 1] = __uint_as_float(p.x & 0xffff0000u); xv[4 * j + 2] = __uint_as_float(p.y << 16); xv[4 * j + 3] = __uint_as_float(p.y & 0xffff0000u); }
        float mine = 0.f;
        for (int c = 0; c < 32; ++c) { float s = 0.f;
#pragma unroll
            for (int j = 0; j < 8; ++j) { const u32x2 p = *(const LAS u32x2*)(F.lds + RING_OFF + ((size_t)c * DM + 256 * j + 4 * F.lane) * 2);
                s += xv[4 * j + 0] * __uint_as_float(p.x << 16) + xv[4 * j + 1] * __uint_as_float(p.x & 0xffff0000u) + xv[4 * j + 2] * __uint_as_float(p.y << 16) + xv[4 * j + 3] * __uint_as_float(p.y & 0xffff0000u); }
            s = wave_sum(s); if (F.lane == c) mine = s; }
        if (F.lane < 32) LR[(size_t)row * 32 + F.lane] = mine;
    }
    __syncthreads();
}
__device__ __forceinline__ void qkv_prep(const Frame& F_, const float* __restrict__ P, const float* __restrict__ qk_g, const float* __restrict__ ROPE, bf16* __restrict__ QB, bf16* __restrict__ KB, bf16* __restrict__ VB) {
    const Frame F = fresh(F_);
    const int gw = F.bid * NWAVES + F.wave, NGW = F.G * NWAVES;
    for (int it = gw; it < MR * 8; it += NGW) {
        const int t = it >> 3, slot = it & 7; const float* pr = P + (size_t)t * PLD;
        if (slot < 6) {
            const float* src = pr + (slot < 4 ? PC_Q + 128 * slot : PC_K + 128 * (slot - 4));
            const float* gg = qk_g + (slot < 4 ? 0 : 128);
            const int half = F.lane >> 5, i = F.lane & 31, d1 = 64 * half + i, d2 = d1 + 32;
            float e1 = src[d1], e2 = src[d2];
            const float r = rsqrtf(wave_sum(e1 * e1 + e2 * e2) * (1.0f / 128.0f) + EPS);
            e1 *= r * gg[d1]; e2 *= r * gg[d2];
            float o1 = e1, o2 = e2;
            if (t < TL) { const int pos = half ? (t & 63) : (t >> 6); const float cs = ROPE[pos * 32 + i], sn = ROPE[128 * 32 + pos * 32 + i]; o1 = e1 * cs - e2 * sn; o2 = e1 * sn + e2 * cs; }
            bf16* dst = (slot < 4) ? (QB + (size_t)t * 512 + 128 * slot) : (KB + (size_t)t * 256 + 128 * (slot - 4));
            dst[d1] = (bf16)f2bf(o1); dst[d2] = (bf16)f2bf(o2);
        } else {
            const float* src = pr + PC_V + 128 * (slot - 6); const f32x2 e = *(const f32x2*)(src + 2 * F.lane);
            *(unsigned*)(VB + (size_t)t * 256 + 128 * (slot - 6) + 2 * F.lane) = pk2(e.x, e.y);
        }
    }
}
__device__ __forceinline__ int chunk_ord(int d, int p) { return d ? (NCHUNK - 1 - p) : (p < 4 ? 128 + p : p - 4); }

__device__ __forceinline__ void lru_a(const Frame& F_, const float* __restrict__ P, const float* __restrict__ conv_w, const float* __restrict__ conv_b, const float* __restrict__ gate_w,
                                      const float* __restrict__ gate_b, const float* __restrict__ lam, float* __restrict__ HL, float* __restrict__ AC, float* __restrict__ ATOT, float* __restrict__ HEND) {
    const Frame F = fresh(F_);
    float* xs = (float*)(F.gl + RING_OFF);
    float* us = (float*)(F.gl + RING_OFF + 17408);
    float* as = (float*)(F.gl + RING_OFF + 34304);
    float* bs = (float*)(F.gl + RING_OFF + 67584);
    for (int item = F.bid; item < NCHUNK * 8; item += F.G) {
        const int n = item >> 3, hh = item & 7, t0 = n * 64, seg_lo = (n < 128) ? 0 : TL, seg_hi = (n < 128) ? TL : MR;
        __syncthreads();
        for (int e = F.tid; e < 67 * 64; e += 512) { const int r = e >> 6, cl = e & 63, t = t0 - 2 + r; xs[e] = (t >= seg_lo && t < seg_hi) ? P[(size_t)t * PLD + PC_LX + hh * 64 + cl] : 0.0f; }
        __syncthreads();
        for (int e = F.tid; e < 4096; e += 512) { const int tok = e >> 6, cl = e & 63, c = hh * 64 + cl; float u = conv_b[c];
#pragma unroll
            for (int j = 0; j < 4; ++j) u += conv_w[j * 512 + c] * xs[(tok + j) * 64 + cl];
            us[tok * 65 + cl] = u; }
        __syncthreads();
        { const int tok = F.lane, cg = F.wave; float acc[4][8];
#pragma unroll
          for (int a = 0; a < 4; ++a)
#pragma unroll
              for (int b = 0; b < 8; ++b) acc[a][b] = 0.f;
          for (int i = 0; i < 64; ++i) { const float uv = us[tok * 65 + i];
#pragma unroll
              for (int dg = 0; dg < 4; ++dg) { const float* wrow = gate_w + ((size_t)((dg * 8 + hh) * 64 + i)) * 64 + cg * 8;
#pragma unroll
                  for (int jj = 0; jj < 8; ++jj) acc[dg][jj] += uv * wrow[jj]; } }
#pragma unroll
          for (int d = 0; d < 2; ++d)
#pragma unroll
              for (int jj = 0; jj < 8; ++jj) { const int cl = cg * 8 + jj, c = hh * 64 + cl;
                  const float r = sigmoidf_(acc[d * 2 + 0][jj] + gate_b[(d * 2 + 0) * 512 + c]), ig = sigmoidf_(acc[d * 2 + 1][jj] + gate_b[(d * 2 + 1) * 512 + c]);
                  const float sp = log1pf(__expf(-lam[d * 512 + c])); const float la = -8.0f * r * sp;
                  as[(d * 64 + cl) * 65 + tok] = __expf(la); bs[(d * 64 + cl) * 65 + tok] = sqrtf(-expm1f(2.0f * la)) * (ig * us[tok * 65 + cl]); } }
        __syncthreads();
        if (F.tid < 128) { const int d = F.tid >> 6, cl = F.tid & 63, c = hh * 64 + cl; float h = 0.f, A = 1.f;
            for (int st = 0; st < 64; ++st) { const int tok = d ? 63 - st : st; const float a = as[(d * 64 + cl) * 65 + tok], b = bs[(d * 64 + cl) * 65 + tok];
                h = a * h + b; A *= a; const size_t o = ((size_t)d * MR + t0 + tok) * 512 + c; HL[o] = h; AC[o] = A; }
            ATOT[((size_t)d * NCHUNK + n) * 512 + c] = A; HEND[((size_t)d * NCHUNK + n) * 512 + c] = h; }
    }
}
__device__ __forceinline__ void lru_b(const Frame& F_, int b0, const float* __restrict__ ATOT, const float* __restrict__ HEND, float* __restrict__ CIN) {
    const Frame F = fresh(F_);
    for (int d = 0; d < 2; ++d) if (F.bid == ((b0 + d) % F.G)) {
        const int c = F.tid; float carry = 0.f;
        for (int p = 0; p < NCHUNK; p += 4) { float A[4], H[4];
#pragma unroll
            for (int k = 0; k < 4; ++k) { const int n = chunk_ord(d, p + k); A[k] = ATOT[((size_t)d * NCHUNK + n) * 512 + c]; H[k] = HEND[((size_t)d * NCHUNK + n) * 512 + c]; }
#pragma unroll
            for (int k = 0; k < 4; ++k) { const int n = chunk_ord(d, p + k); CIN[((size_t)d * NCHUNK + n) * 512 + c] = carry; carry = A[k] * carry + H[k]; } }
    }
}
__device__ __forceinline__ void gla_a(const Frame& F_, const float* __restrict__ P, const float* __restrict__ LR, const float* __restrict__ gw_, const float* __restrict__ gb_,
                                      float* __restrict__ BC, float* __restrict__ DS, float* __restrict__ DEC) {
    const Frame F = fresh(F_);
    float* lrs = (float*)(F.gl + RING_OFF);
    float* bc = (float*)(F.gl + RING_OFF + 8704);
    float* ks = (float*)(F.gl + RING_OFF + 41984);
    float* kout = (float*)(F.gl + RING_OFF + 58368);
    float* vs = (float*)(F.gl + RING_OFF + 91136);
    float* tots = (float*)(F.gl + RING_OFF + 123904);
    for (int item = F.bid; item < NCHUNK * 4; item += F.G) {
        const int n = item >> 2, hh = item & 3, t0 = n * 64;
        __syncthreads();
        for (int e = F.tid; e < 2048; e += 512) lrs[(e >> 5) * 33 + (e & 31)] = LR[(size_t)(t0 + (e >> 5)) * 32 + (e & 31)];
        for (int e = F.tid; e < 4096; e += 512) ks[e] = P[(size_t)(t0 + (e >> 6)) * PLD + PC_GK + hh * 64 + (e & 63)];
        for (int e = F.tid; e < 8192; e += 512) vs[e] = P[(size_t)(t0 + (e >> 7)) * PLD + PC_GV + hh * 128 + (e & 127)];
        __syncthreads();
        { const int tok = F.lane, d = F.wave >> 2, dk0 = (F.wave & 3) * 16;
#pragma unroll 4
          for (int jj = 0; jj < 16; ++jj) { const int dk = dk0 + jj, col = hh * 64 + dk; float z = gb_[d * 256 + col];
#pragma unroll
              for (int r = 0; r < 16; ++r) z += lrs[tok * 33 + 16 * d + r] * gw_[(d * 16 + r) * 256 + col];
              bc[(d * 64 + dk) * 65 + tok] = -(fmaxf(-z, 0.0f) + log1pf(__expf(-fabsf(z)))) * (1.0f / 16.0f); } }
        __syncthreads();
        if (F.tid < 128) { const int d = F.tid >> 6, dk = F.tid & 63; float run = 0.f;
            for (int st = 0; st < 64; ++st) { const int tok = d ? 63 - st : st; run += bc[(d * 64 + dk) * 65 + tok]; bc[(d * 64 + dk) * 65 + tok] = run;
                BC[((size_t)d * MR + t0 + tok) * 256 + hh * 64 + dk] = run; }
            tots[d * 64 + dk] = run; DEC[((size_t)(n * 4 + hh) * 2 + d) * 64 + dk] = __expf(run); }
        __syncthreads();
        for (int e = F.tid; e < 8192; e += 512) { const int d = e >> 12, s = (e >> 6) & 63, dk = e & 63; kout[e] = ks[s * 64 + dk] * __expf(tots[d * 64 + dk] - bc[(d * 64 + dk) * 65 + s]); }
        __syncthreads();
        { const int dv = F.tid & 127, dkg = F.tid >> 7; float acc[2][16];
#pragma unroll
          for (int d = 0; d < 2; ++d)
#pragma unroll
              for (int j = 0; j < 16; ++j) acc[d][j] = 0.f;
          for (int s = 0; s < 64; ++s) { const float vv = vs[s * 128 + dv];
#pragma unroll
              for (int d = 0; d < 2; ++d)
#pragma unroll
                  for (int j = 0; j < 16; ++j) acc[d][j] += kout[(d * 64 + s) * 64 + dkg * 16 + j] * vv; }
#pragma unroll
          for (int d = 0; d < 2; ++d)
#pragma unroll
              for (int j = 0; j < 16; ++j) DS[(((size_t)(n * 4 + hh) * 2 + d) * 64 + dkg * 16 + j) * 128 + dv] = acc[d][j]; }
    }
}
__device__ __forceinline__ void gla_b(const Frame& F_, const float* __restrict__ DS, const float* __restrict__ DEC, float* __restrict__ SP) {
    const Frame F = fresh(F_);
    const int rb = F.G - 1 - F.bid;
    for (int g = rb * 512 + F.tid; g < 4 * 2 * 64 * 128; g += F.G * 512) {
        const int dv = g & 127, dk = (g >> 7) & 63, d = (g >> 13) & 1, hh = g >> 14; float S = 0.f;
        for (int p = 0; p < NCHUNK; p += 4) { float dec[4], ds[4];
#pragma unroll
            for (int k = 0; k < 4; ++k) { const size_t idx = (size_t)(chunk_ord(d, p + k) * 4 + hh) * 2 + d; dec[k] = DEC[idx * 64 + dk]; ds[k] = DS[(idx * 64 + dk) * 128 + dv]; }
#pragma unroll
            for (int k = 0; k < 4; ++k) { const size_t idx = (size_t)(chunk_ord(d, p + k) * 4 + hh) * 2 + d; SP[(idx * 64 + dk) * 128 + dv] = S; S = dec[k] * S + ds[k]; } }
    }
}
__device__ __forceinline__ void gla_c(const Frame& F_, const float* __restrict__ P, const float* __restrict__ BC, const float* __restrict__ SP, const float* __restrict__ out_g, bf16* __restrict__ MIX) {
    const Frame F = fresh(F_);
    float* qt = (float*)(F.gl + RING_OFF);
    float* kin = (float*)(F.gl + RING_OFF + 16640);
    float* attm = (float*)(F.gl + RING_OFF + 33280);
    float* vs = (float*)(F.gl + RING_OFF + 49664);
    float* sps = (float*)(F.gl + RING_OFF + 82432);
    float* red = (float*)(F.gl + RING_OFF + 115200);
    for (int item = F.bid; item < NCHUNK * 4; item += F.G) {
        const int n = item >> 2, hh = item & 3, t0 = n * 64;
        const int dv = F.tid & 127, tokg = F.tid >> 7;
        float acc[16];
#pragma unroll
        for (int j = 0; j < 16; ++j) acc[j] = 0.f;
        __syncthreads();
        for (int e = F.tid; e < 8192; e += 512) vs[e] = P[(size_t)(t0 + (e >> 7)) * PLD + PC_GV + hh * 128 + (e & 127)];
        for (int d = 0; d < 2; ++d) {
            __syncthreads();
            for (int e = F.tid; e < 4096; e += 512) { const int tok = e >> 6, dk = e & 63; const float b = BC[((size_t)d * MR + t0 + tok) * 256 + hh * 64 + dk];
                const float q = P[(size_t)(t0 + tok) * PLD + PC_GQ + hh * 64 + dk], k = P[(size_t)(t0 + tok) * PLD + PC_GK + hh * 64 + dk];
                qt[tok * 65 + dk] = q * 0.125f * __expf(b); kin[tok * 65 + dk] = k * __expf(-b); }
            { const float* sp = SP + (((size_t)(n * 4 + hh) * 2 + d) * 64) * 128; for (int e = F.tid; e < 8192; e += 512) sps[e] = sp[e]; }
            __syncthreads();
            { const int s = F.lane, tg = F.wave; float a8[8];
#pragma unroll
              for (int j = 0; j < 8; ++j) a8[j] = 0.f;
              for (int dk = 0; dk < 64; ++dk) { const float kv = kin[s * 65 + dk];
#pragma unroll
                  for (int j = 0; j < 8; ++j) a8[j] += qt[(tg * 8 + j) * 65 + dk] * kv; }
#pragma unroll
              for (int j = 0; j < 8; ++j) { const int tok = tg * 8 + j; const bool keep = d ? (s >= tok) : (s <= tok); attm[tok * 64 + s] = keep ? a8[j] : 0.0f; } }
            __syncthreads();
            for (int s = 0; s < 64; ++s) { const float vv = vs[s * 128 + dv];
#pragma unroll
                for (int j = 0; j < 16; ++j) acc[j] += attm[(tokg * 16 + j) * 64 + s] * vv; }
            for (int dk = 0; dk < 64; ++dk) { const float sv = sps[dk * 128 + dv];
#pragma unroll
                for (int j = 0; j < 16; ++j) acc[j] += qt[(tokg * 16 + j) * 65 + dk] * sv; }
        }
#pragma unroll
        for (int j = 0; j < 16; ++j) { const float ss = wave_sum(acc[j] * acc[j]); if (F.lane == 0) red[(tokg * 16 + j) * 2 + (F.wave & 1)] = ss; }
        __syncthreads();
        const float og = out_g[dv];
#pragma unroll
        for (int j = 0; j < 16; ++j) { const int tok = tokg * 16 + j; const float ms = (red[tok * 2] + red[tok * 2 + 1]) * (1.0f / 128.0f); const float r = rsqrtf(ms + EPS);
            const float g = P[(size_t)(t0 + tok) * PLD + PC_GG + hh * 128 + dv];
            MIX[(size_t)(t0 + tok) * DM + 1024 + hh * 128 + dv] = (bf16)f2bf(acc[j] * r * og * siluf_(g)); }
    }
}
__device__ __forceinline__ void mix_finalize(const Frame& F_, const float* __restrict__ P, const float* __restrict__ HL, const float* __restrict__ AC, const float* __restrict__ CIN,
                                             const float* __restrict__ OP, const float* __restrict__ ML, const float* __restrict__ YF, bf16* __restrict__ MIX) {
    const Frame F = fresh(F_);
    const int gt = F.bid * 512 + F.tid, NGT = F.G * 512;
    for (int i = gt; i < MR * 128; i += NGT) { const int t = i >> 7, c = (i & 127) * 4, n = t >> 6; f32x4 h = {0.f, 0.f, 0.f, 0.f};
#pragma unroll
        for (int d = 0; d < 2; ++d) { const size_t o = ((size_t)d * MR + t) * 512 + c; h += *(const f32x4*)(HL + o) + *(const f32x4*)(AC + o) * *(const f32x4*)(CIN + ((size_t)d * NCHUNK + n) * 512 + c); }
        const f32x4 g = *(const f32x4*)(P + (size_t)t * PLD + PC_LG + c);
        u32x2 o; o.x = pk2(h.x * gelu_tanh_(g.x), h.y * gelu_tanh_(g.y)); o.y = pk2(h.z * gelu_tanh_(g.z), h.w * gelu_tanh_(g.w));
        *(u32x2*)(MIX + (size_t)t * DM + c) = o; }
    for (int i = gt; i < MR * 128; i += NGT) { const int t = i >> 7, h = (i >> 5) & 3, c = (i & 31) * 4; constexpr float C = att::SCALE * 1.4426950408889634f;
        const f32x4 o0 = *(const f32x4*)(OP + (size_t)t * 512 + h * 128 + c); const float m0 = ML[(size_t)t * 8 + h * 2], l0 = ML[(size_t)t * 8 + h * 2 + 1];
        f32x4 o;
        if (t < TL) { const f32x4 o1 = *(const f32x4*)(OP + ((size_t)MR + t) * 512 + h * 128 + c); const float m1 = ML[((size_t)MR + t) * 8 + h * 2], l1 = ML[((size_t)MR + t) * 8 + h * 2 + 1];
            const float M = fmaxf(m0, m1), w0 = __builtin_amdgcn_exp2f((m0 - M) * C), w1 = __builtin_amdgcn_exp2f((m1 - M) * C); const float inv = 1.0f / (l0 * w0 + l1 * w1);
            o = (o0 * w0 + o1 * w1) * inv; }
        else o = o0 * (1.0f / l0);
        u32x2 w; w.x = pk2(o.x, o.y); w.y = pk2(o.z, o.w); *(u32x2*)(MIX + (size_t)t * DM + 512 + h * 128 + c) = w; }
    for (int i = gt; i < MR * 128; i += NGT) { const int t = i >> 7, c = (i & 127) * 4; f32x4 y = *(const f32x4*)(YF + (size_t)t * 512 + c);
        if (t < TL) {
#pragma unroll
            for (int p = 1; p < 4; ++p) y += *(const f32x4*)(YF + ((size_t)p * MR + t) * 512 + c); }
        y = y * ((t < TL) ? (1.0f / 1024.0f) : 0.005524271728019903f);
        u32x2 w; w.x = pk2(y.x, y.y); w.y = pk2(y.z, y.w); *(u32x2*)(MIX + (size_t)t * DM + 1536 + c) = w; }
}

constexpr int PTR_OFF = MISC_OFF + 128;
__device__ __forceinline__ unsigned long long lds_ptr(const Frame& F, int i) {
    const unsigned long long v = *(volatile LAS unsigned long long*)(F.lds + PTR_OFF + 8 * i);
    const unsigned lo = __builtin_amdgcn_readfirstlane((unsigned)v), hi = __builtin_amdgcn_readfirstlane((unsigned)(v >> 32));
    return ((unsigned long long)hi << 32) | lo;
}
constexpr int NPHASE = 2 + 12 * NLAY + 1;
struct Args { const float* in[21]; float* out; unsigned char* ws; int ph_lo, ph_hi; };
static_assert(sizeof(Args) == 21 * 8 + 8 + 8 + 8, "Args has no padding");

__global__ void __launch_bounds__(NWAVES * 64, 2) fwd_kernel(Args args) {
    extern __shared__ __attribute__((aligned(16))) unsigned char lds[];
    Frame F;
    F.lds = (LAS unsigned char*)lds; F.gl = lds;
    F.MISC = (volatile LAS unsigned*)(F.lds + MISC_OFF);
    F.tid = threadIdx.x; F.lane = F.tid & 63; F.wave = __builtin_amdgcn_readfirstlane(F.tid >> 6);
    F.G = gridDim.x; F.bid = blockIdx.x;
    F.ctl = (gu32*)(args.ws + WS_CTL);
    for (int u = F.tid; u < (LDS_BYTES - LDSCTL_OFF) / 4; u += NWAVES * 64) ((LAS unsigned*)(F.lds + LDSCTL_OFF))[u] = 0u;
    __syncthreads();
    if (F.tid < 21) ((LAS unsigned long long*)(F.lds + PTR_OFF))[F.tid] = (unsigned long long)args.in[F.tid];
    if (F.tid == 21) ((LAS unsigned long long*)(F.lds + PTR_OFF))[21] = (unsigned long long)args.out;
    if (F.tid == 22) ((LAS unsigned long long*)(F.lds + PTR_OFF))[22] = (unsigned long long)args.ws;
    __syncthreads();
#define INP(i) ((const float*)lds_ptr(F, (i)))
#define WSL() ((unsigned char*)lds_ptr(F, 22))
#if MK_ONE_LAUNCH
    XcdBarrier bar = xcd_barrier_post((unsigned*)(F.ctl + CW_BAR), F.MISC + 8);
#define GRID_BAR() xcd_barrier(bar)
#else
#define GRID_BAR() do { } while (0)
#endif
    const int lo = args.ph_lo, hi = args.ph_hi;
#define IN(k) (lo <= (k) && (k) < hi)
#define SEAM(k) do { if (IN(k) && IN((k) + 1)) GRID_BAR(); } while (0)

    if (IN(0) || IN(1)) {
        In I; I.x = INP(0); I.c = INP(1); I.ctx = INP(2); I.c_ctx = INP(3); I.mod_w = INP(4); I.mod_b = INP(5); I.norm_g = INP(6); I.final_g = INP(7);
        I.ffn_w13 = INP(8); I.ffn_w2 = INP(9); I.w_in = INP(10); I.w_out = INP(11); I.lru_conv_w = INP(12); I.lru_conv_b = INP(13); I.lru_gate_w = INP(14);
        I.lru_gate_b = INP(15); I.lru_lambda = INP(16); I.attn_qk_g = INP(17); I.gla_gate_w = INP(18); I.gla_gate_b = INP(19); I.gla_out_g = INP(20);
        if (IN(0)) { prologue_a(F, I, WSL()); SEAM(0); }
        if (IN(1)) { prologue_b(F, I, WSL()); SEAM(1); }
    }

    for (int s = 0; s < 2 * NLAY; ++s) {
        const int l = s >> 1, f = s & 1, pb = 2 + 12 * l + 9 * f;
        { const int j = f ? 2 : 0;
          if (IN(pb)) { unsigned char* ws = WSL(); const float* modl = (const float*)(ws + WS_MODV) + (size_t)(l * 2 + 0) * 9 * DM; const float* modc = modl + 9 * DM;
              norm_phase(F, (const float*)(ws + WS_X), (bf16*)(ws + WS_XN), INP(6) + (size_t)(l * 3 + j) * DM, modl + (3 * j) * DM, modl + (3 * j + 1) * DM, modc + (3 * j) * DM, modc + (3 * j + 1) * DM); SEAM(pb); }
          if (IN(pb + 1)) { unsigned char* ws = WSL();
              pg8::Gemm g{(const bf16*)(ws + WS_XN), (const bf16*)(ws + WS_W13T) + (size_t)(l * 2 + f) * 2 * FF * DM, DM}; pg8::StaticOrder S; S.init(MR, 2 * FF, DM / 64, F.G, F.bid);
              pg8::EpiSwiGLU E{(bf16*)(ws + WS_H), FF};
              pg8::gemm_phase<pg8::EpiSwiGLU, pg8::StaticOrder, true, true>(F.lds + RING_OFF, g, S, E); SEAM(pb + 1); }
          if (IN(pb + 2)) { unsigned char* ws = WSL(); const float* modl = (const float*)(ws + WS_MODV) + (size_t)(l * 2 + 0) * 9 * DM;
              pg8::Gemm g{(const bf16*)(ws + WS_H), (const bf16*)(ws + WS_W2T) + (size_t)(l * 2 + f) * DM * FF, FF}; pg8::StaticOrder S; S.init(MR, DM, FF / 64, F.G, F.bid);
              pg8::EpiResid E{(float*)(ws + WS_X), DM, modl + (3 * j + 2) * DM, 9 * DM, 0.5f, TL / 256};
              pg8::gemm_phase<pg8::EpiResid, pg8::StaticOrder, true, true>(F.lds + RING_OFF, g, S, E); SEAM(pb + 2); } }
        if (f == 0) {
            const int mb = pb + 3;
            if (IN(mb)) { unsigned char* ws = WSL(); const float* modl = (const float*)(ws + WS_MODV) + (size_t)(l * 2 + 0) * 9 * DM; const float* modc = modl + 9 * DM;
                norm_phase(F, (const float*)(ws + WS_X), (bf16*)(ws + WS_XN), INP(6) + (size_t)(l * 3 + 1) * DM, modl + 3 * DM, modl + 4 * DM, modc + 3 * DM, modc + 4 * DM); SEAM(mb); }
            if (IN(mb + 1)) {
                unsigned char* ws = WSL();
                { pg8::Gemm g{(const bf16*)(ws + WS_XN), (const bf16*)(ws + WS_WINT) + (size_t)l * 4096 * DM, DM}; pg8::StaticOrder S; S.init(MR, 4096, DM / 64, F.G, F.bid);
                  pg8::EpiP E{(float*)(ws + WS_P), PLD, (bf16*)(ws + WS_UF)};
                  pg8::gemm_phase<pg8::EpiP, pg8::StaticOrder, true, true>(F.lds + RING_OFF, g, S, E); }
                lr_phase(F, (const bf16*)(ws + WS_XN), (const bf16*)(ws + WS_WLRT) + (size_t)l * 32 * DM, (float*)(ws + WS_LR));
                SEAM(mb + 1); }
            if (IN(mb + 2)) {
                { unsigned char* ws = WSL(); pg8::Gemm g{(const bf16*)(ws + WS_ADFT1), (const bf16*)(ws + WS_UF), 512}; pg8::StaticOrder S; S.init(1024, MR, 8, F.G, F.bid); pg8::EpiZT E{(bf16*)(ws + WS_ZT), (long)((WS_ZTC - WS_ZT) / 2)};
                  pg8::gemm_phase<pg8::EpiZT, pg8::StaticOrder, true, true>(F.lds + RING_OFF, g, S, E); }
                { unsigned char* ws = WSL(); qkv_prep(F, (const float*)(ws + WS_P), INP(17) + (size_t)l * 256, (const float*)(ws + WS_ROPE), (bf16*)(ws + WS_QB), (bf16*)(ws + WS_KB), (bf16*)(ws + WS_VB)); }
                { unsigned char* ws = WSL(); lru_a(F, (const float*)(ws + WS_P), INP(12) + (size_t)l * 4 * 512, INP(13) + (size_t)l * 512, INP(14) + (size_t)l * 2 * 2 * 8 * 64 * 64, INP(15) + (size_t)l * 2 * 2 * 512, INP(16) + (size_t)l * 2 * 512,
                        (float*)(ws + WS_HL), (float*)(ws + WS_AC), (float*)(ws + WS_ATOT), (float*)(ws + WS_HEND)); }
                { unsigned char* ws = WSL(); gla_a(F, (const float*)(ws + WS_P), (const float*)(ws + WS_LR), INP(18) + (size_t)l * 2 * 16 * 256, INP(19) + (size_t)l * 2 * 256, (float*)(ws + WS_BC), (float*)(ws + WS_DS), (float*)(ws + WS_DEC)); }
                SEAM(mb + 2); }
            if (IN(mb + 3)) {
                { unsigned char* ws = WSL(); const bf16* QB = (const bf16*)(ws + WS_QB); const bf16* KB = (const bf16*)(ws + WS_KB); const bf16* VB = (const bf16*)(ws + WS_VB); float* OP = (float*)(ws + WS_OP); float* ML = (float*)(ws + WS_ML);
                  int bid_ = F.bid; asm volatile("" : "+s"(bid_));
                  for (int L = bid_; L < 260; L += F.G) {
                    const bf16 *q, *k, *v; float *o, *ml; int seq;
                    if (L < 256) { const int xcd = L & 7, j = L >> 3, combo = xcd >> 1, kvh = combo >> 1, sp = combo & 1, idx = (xcd & 1) * 32 + j, h = kvh * 2 + (idx >> 5), qb = idx & 31;
                        q = QB + (size_t)(qb * 256) * 512 + h * 128; k = KB + (size_t)(sp * 4224) * 256 + kvh * 128; v = VB + (size_t)(sp * 4224) * 256 + kvh * 128;
                        o = OP + ((size_t)sp * MR + qb * 256) * 512 + h * 128; ml = ML + ((size_t)sp * MR + qb * 256) * 8 + h * 2; seq = 4224; }
                    else { const int h = L - 256, kvh = h >> 1;
                        q = QB + (size_t)TL * 512 + h * 128; k = KB + (size_t)TL * 256 + kvh * 128; v = VB + (size_t)TL * 256 + kvh * 128;
                        o = OP + (size_t)TL * 512 + h * 128; ml = ML + (size_t)TL * 8 + h * 2; seq = TCX; }
                    __syncthreads();
                    att::attn_unit(q, k, v, o, ml, seq, (char*)lds + RING_OFF);
                  }
                  __syncthreads(); }
                { unsigned char* ws = WSL(); pg8::Gemm g{(const bf16*)(ws + WS_ADFT), (const bf16*)(ws + WS_ZT), 16384}; pg8::SplitOrder S; S.init(TL, 512, 4, 64, F.G, F.bid); pg8::EpiYF E{(float*)(ws + WS_YF), 0, (size_t)MR * 512};
                  pg8::gemm_phase<pg8::EpiYF, pg8::SplitOrder, true, true>(F.lds + RING_OFF, g, S, E); }
                { unsigned char* ws = WSL(); pg8::Gemm g{(const bf16*)(ws + WS_ADFTC), (const bf16*)(ws + WS_ZTC), 512}; pg8::SplitOrder S; S.init(TCX, 512, 1, 8, F.G, F.bid); pg8::EpiYF E{(float*)(ws + WS_YF), TL, (size_t)MR * 512};
                  pg8::gemm_phase<pg8::EpiYF, pg8::SplitOrder, true, true>(F.lds + RING_OFF, g, S, E); }
                { unsigned char* ws = WSL(); lru_b(F, 64, (const float*)(ws + WS_ATOT), (const float*)(ws + WS_HEND), (float*)(ws + WS_CIN)); }
                { unsigned char* ws = WSL(); gla_b(F, (const float*)(ws + WS_DS), (const float*)(ws + WS_DEC), (float*)(ws + WS_SP)); }
                SEAM(mb + 3); }
            if (IN(mb + 4)) {
                { unsigned char* ws = WSL(); gla_c(F, (const float*)(ws + WS_P), (const float*)(ws + WS_BC), (const float*)(ws + WS_SP), INP(20) + (size_t)l * 128, (bf16*)(ws + WS_MIX)); }
                { unsigned char* ws = WSL(); mix_finalize(F, (const float*)(ws + WS_P), (const float*)(ws + WS_HL), (const float*)(ws + WS_AC), (const float*)(ws + WS_CIN), (const float*)(ws + WS_OP), (const float*)(ws + WS_ML), (const float*)(ws + WS_YF), (bf16*)(ws + WS_MIX)); }
                SEAM(mb + 4); }
            if (IN(mb + 5)) {
                unsigned char* ws = WSL(); const float* modl = (const float*)(ws + WS_MODV) + (size_t)(l * 2 + 0) * 9 * DM;
                pg8::Gemm g{(const bf16*)(ws + WS_MIX), (const bf16*)(ws + WS_WOUTT) + (size_t)l * DM * DM, DM}; pg8::StaticOrder S; S.init(MR, DM, DM / 64, F.G, F.bid);
                pg8::EpiResid E{(float*)(ws + WS_X), DM, modl + 5 * DM, 9 * DM, 1.0f, TL / 256};
                pg8::gemm_phase<pg8::EpiResid, pg8::StaticOrder, true, true>(F.lds + RING_OFF, g, S, E); SEAM(mb + 5); }
        }
    }
    if (IN(NPHASE - 1)) { unsigned char* ws = WSL(); final_norm(F, (const float*)(ws + WS_X), (float*)lds_ptr(F, 21), INP(7)); }
#undef IN
#undef SEAM
}

extern "C" void kernel_launch(void* const* d_in, const int* in_sizes, int n_in, void* d_out, int out_size, void* d_ws, size_t ws_size, hipStream_t stream) {
    static int grid = 0;
    if (grid == 0) {
        if (n_in != 21 || in_sizes[0] != TL * DM || out_size != TL * DM || ws_size < WS_END) {
            fprintf(stderr, "kernel_launch: unexpected shapes: n_in %d in0 %d out %d ws %zu (need %zu); nothing launched\n", n_in, n_in > 0 ? in_sizes[0] : -1, out_size, ws_size, (size_t)WS_END); grid = -1; return; }
        int dev = 0, cus = 0, per_cu = 0;
        if (hipGetDevice(&dev) != hipSuccess || hipDeviceGetAttribute(&cus, hipDeviceAttributeMultiprocessorCount, dev) != hipSuccess) { fprintf(stderr, "kernel_launch: device query failed\n"); grid = -1; return; }
        if (hipFuncSetAttribute((const void*)fwd_kernel, hipFuncAttributeMaxDynamicSharedMemorySize, LDS_BYTES) != hipSuccess) { fprintf(stderr, "kernel_launch: hipFuncSetAttribute failed\n"); grid = -1; return; }
        if (hipOccupancyMaxActiveBlocksPerMultiprocessor(&per_cu, (const void*)fwd_kernel, NWAVES * 64, LDS_BYTES) != hipSuccess || per_cu < 1)
            fprintf(stderr, "kernel_launch: note: occupancy query reports %d workgroups per CU\n", per_cu);
        (void)hipGetLastError();
        grid = cus;
    }
    if (grid < 0) return;
    if (hipMemsetAsync((char*)d_ws + WS_CTL, 0, CTL_ZERO_BYTES, stream) != hipSuccess) { fprintf(stderr, "kernel_launch: memset failed\n"); return; }
    Args a{};
    for (int i = 0; i < 21; ++i) a.in[i] = (const float*)d_in[i];
    a.out = (float*)d_out; a.ws = (unsigned char*)d_ws;
#if MK_ONE_LAUNCH
    a.ph_lo = 0; a.ph_hi = NPHASE;
    hipLaunchKernelGGL(fwd_kernel, dim3(grid), dim3(NWAVES * 64), LDS_BYTES, stream, a);
#else
    for (int ph = 0; ph < NPHASE; ++ph) { a.ph_lo = ph; a.ph_hi = ph + 1; hipLaunchKernelGGL(fwd_kernel, dim3(grid), dim3(NWAVES * 64), LDS_BYTES, stream, a); }
#endif
    const hipError_t le = hipPeekAtLastError();
    if (le != hipSuccess) fprintf(stderr, "kernel_launch: launch failed: %s\n", hipGetErrorName(le));
}
```

```cpp
#include <hip/hip_runtime.h>
#include <cstdio>
#include <cstdint>

#ifndef MK_ONE_LAUNCH
#define MK_ONE_LAUNCH 1
#endif

constexpr int DM = 2048, TL = 8192, TCX = 256, MR = TL + TCX, FF = 5632, NLAY = 4, DIN = 4128, NCHUNK = MR / 64;
constexpr int PLD = 3584;
constexpr int PC_LX = 0, PC_LG = 512, PC_Q = 1024, PC_K = 1536, PC_V = 1792, PC_GQ = 2048, PC_GK = 2304, PC_GV = 2560, PC_GG = 3072;
constexpr float EPS = 1e-6f;

constexpr size_t al256(size_t x) { return (x + 255) / 256 * 256; }
constexpr size_t WS_CTL = 0, CTL_ZERO_BYTES = 1u << 20;
constexpr size_t WS_MODV = WS_CTL + CTL_ZERO_BYTES;
constexpr size_t WS_W13T = al256(WS_MODV + (size_t)NLAY * 2 * 9 * DM * 4);
constexpr size_t WS_W2T  = al256(WS_W13T + (size_t)8 * 2 * FF * DM * 2);
constexpr size_t WS_WINT = al256(WS_W2T + (size_t)8 * DM * FF * 2);
constexpr size_t WS_WLRT = al256(WS_WINT + (size_t)4 * 4096 * DM * 2);
constexpr size_t WS_WOUTT = al256(WS_WLRT + (size_t)4 * 32 * DM * 2);
constexpr size_t WS_ADFT = al256(WS_WOUTT + (size_t)4 * DM * DM * 2);
constexpr size_t WS_ADFTC = al256(WS_ADFT + (size_t)TL * 2 * TL * 2);
constexpr size_t WS_ADFT1 = al256(WS_ADFTC + (size_t)TCX * 2 * TCX * 2);
constexpr size_t WS_ROPE = al256(WS_ADFT1 + (size_t)1024 * 512 * 2);
constexpr size_t WS_X = al256(WS_ROPE + (size_t)2 * 128 * 32 * 4);
constexpr size_t WS_XN = al256(WS_X + (size_t)MR * DM * 4);
constexpr size_t WS_H = al256(WS_XN + (size_t)MR * DM * 2);
constexpr size_t WS_P = al256(WS_H + (size_t)MR * FF * 2);
constexpr size_t WS_UF = al256(WS_P + (size_t)MR * PLD * 4);
constexpr size_t WS_LR = al256(WS_UF + (size_t)MR * 512 * 2);
constexpr size_t WS_QB = al256(WS_LR + (size_t)MR * 32 * 4);
constexpr size_t WS_KB = al256(WS_QB + (size_t)MR * 512 * 2);
constexpr size_t WS_VB = al256(WS_KB + (size_t)MR * 256 * 2);
constexpr size_t WS_OP = al256(WS_VB + (size_t)MR * 256 * 2);
constexpr size_t WS_ML = al256(WS_OP + (size_t)2 * MR * 512 * 4);
constexpr size_t WS_HL = al256(WS_ML + (size_t)2 * MR * 4 * 2 * 4);
constexpr size_t WS_AC = al256(WS_HL + (size_t)2 * MR * 512 * 4);
constexpr size_t WS_ATOT = al256(WS_AC + (size_t)2 * MR * 512 * 4);
constexpr size_t WS_HEND = al256(WS_ATOT + (size_t)2 * NCHUNK * 512 * 4);
constexpr size_t WS_CIN = al256(WS_HEND + (size_t)2 * NCHUNK * 512 * 4);
constexpr size_t WS_BC = al256(WS_CIN + (size_t)2 * NCHUNK * 512 * 4);
constexpr size_t WS_DS = al256(WS_BC + (size_t)2 * MR * 256 * 4);
constexpr size_t WS_SP = al256(WS_DS + (size_t)NCHUNK * 4 * 2 * 64 * 128 * 4);
constexpr size_t WS_DEC = al256(WS_SP + (size_t)NCHUNK * 4 * 2 * 64 * 128 * 4);
constexpr size_t WS_ZT = al256(WS_DEC + (size_t)NCHUNK * 4 * 2 * 64 * 4);
constexpr size_t WS_ZTC = al256(WS_ZT + (size_t)512 * 16384 * 2);
constexpr size_t WS_YF = al256(WS_ZTC + (size_t)512 * 512 * 2);
constexpr size_t WS_MIX = al256(WS_YF + (size_t)4 * MR * 512 * 4);
constexpr size_t WS_END = al256(WS_MIX + (size_t)MR * DM * 2);

constexpr int CW_TMO = 0, CW_CODE = 1, CW_BAR = 4096;

constexpr int RING_OFF = 0, RING_BYTES = 131072;
constexpr int LDSCTL_OFF = RING_BYTES, MISC_OFF = LDSCTL_OFF + 320;
constexpr int LDS_BYTES = 147456;
constexpr int NWAVES = 8;

#define GAS __attribute__((address_space(1)))
#define LAS __attribute__((address_space(3)))
typedef unsigned short bf16;
typedef float f32x4 __attribute__((ext_vector_type(4)));
typedef float f32x2 __attribute__((ext_vector_type(2)));
typedef unsigned u32x4 __attribute__((ext_vector_type(4)));
typedef unsigned u32x2 __attribute__((ext_vector_type(2)));
typedef GAS unsigned gu32;
#define RLX_AGENT __ATOMIC_RELAXED, __HIP_MEMORY_SCOPE_AGENT
#define LDS_WAIT() asm volatile("s_waitcnt lgkmcnt(0)" ::: "memory")
#define VM_WAIT() asm volatile("s_waitcnt vmcnt(0)" ::: "memory")
__device__ __forceinline__ unsigned f2bf(float f) { unsigned u = __builtin_bit_cast(unsigned, f); return (u + 0x7fffu + ((u >> 16) & 1u)) >> 16; }
__device__ __forceinline__ unsigned pk2(float lo, float hi) { return f2bf(lo) | (f2bf(hi) << 16); }
__device__ __forceinline__ float wave_sum(float v) {
#pragma unroll
    for (int o = 1; o < 64; o <<= 1) v += __shfl_xor(v, o);
    return v;
}
__device__ __forceinline__ float sigmoidf_(float x) { return 1.0f / (1.0f + __expf(-x)); }
__device__ __forceinline__ float siluf_(float x) { return x / (1.0f + __expf(-x)); }
__device__ __forceinline__ float gelu_tanh_(float x) { const float u = 0.7978845608028654f * (x + 0.044715f * x * x * x); return 0.5f * x * (1.0f + tanhf(u)); }

namespace pg8 {
#define PG8_LAS __attribute__((address_space(3)))
typedef unsigned short bf16_t;
typedef short bf16x8 __attribute__((ext_vector_type(8)));
typedef float f32x4 __attribute__((ext_vector_type(4)));
typedef unsigned u32x4 __attribute__((ext_vector_type(4)));
constexpr int BM = 256, BK = 64, HALF = 128, HTB = HALF * BK * 2  , STAGE_BYTES = 8 * HTB, NXCD = 8, WGM = 8;

__host__ __device__ __forceinline__ int lds_byte(int r, int c) { const int st = (r >> 4) * 2 + (c >> 5), rr = r & 15, cc = c & 31, ob = rr * 64 + cc * 2; return st * 1024 + (ob ^ (((ob >> 9) & 1) << 5)); }
__host__ __device__ __forceinline__ void stage_rc(int b, int& R, int& C) { const int st = b / 1024, sb = b % 1024, swz = sb ^ (((sb >> 9) & 1) << 5); R = (st >> 1) * 16 + swz / 64; C = (st & 1) * 32 + (swz % 64) / 2; }
__host__ __device__ __forceinline__ int perm32(int rho) { const int n = rho >> 4, i = rho & 15; return 8 * (i >> 2) + 4 * n + (i & 3); }

struct Unit { int pm, pn, kt0, nt; };
struct Gemm { const bf16_t* A; const bf16_t* Bt; int K; };

struct StaticOrder {
    int nM, nN, nwg, G, c, nt;
    __host__ __device__ void init(int M, int N, int nt_, int G_, int c_) { nM = M / BM; nN = N / BM; nwg = nM * nN; G = G_; c = c_; nt = nt_; }
    __host__ __device__ bool next(int i, Unit& u) const {
        const long L = (long)i * G + c; if (L >= nwg) return false;
        int wgid = (int)L; { const int q = nwg / NXCD, r = nwg % NXCD, xcd = wgid % NXCD, off = wgid / NXCD; wgid = (xcd < r ? xcd * (q + 1) : r * (q + 1) + (xcd - r) * q) + off; }
        const int nig = WGM * nN, gid = wgid / nig, fm = gid * WGM, gsz = (nM - fm) < WGM ? (nM - fm) : WGM;
        u.pm = fm + ((wgid % nig) % gsz); u.pn = (wgid % nig) / gsz; u.kt0 = 0; u.nt = nt; return true;
    }
    __device__ __forceinline__ void a_ready(const Unit&) const {}
    __device__ __forceinline__ void done(const Unit&) const {}
};
struct SplitOrder {
    int nM, nN, nS, total, G, c, nt;
    __host__ __device__ void init(int M, int N, int nS_, int nt_, int G_, int c_) { nM = M / BM; nN = N / BM; nS = nS_; total = nM * nN * nS; G = G_; c = c_; nt = nt_; }
    __host__ __device__ bool next(int i, Unit& u) const {
        const long L = (long)i * G + c; if (L >= total) return false;
        const int l = (int)L; u.pm = l % nM; const int r = l / nM; u.pn = r % nN; u.kt0 = (r / nN) * nt; u.nt = nt; return true;
    }
    __device__ __forceinline__ void a_ready(const Unit&) const {}
    __device__ __forceinline__ void done(const Unit&) const {}
};

__device__ __forceinline__ unsigned cvt_pk_bf16(float lo, float hi) { unsigned r; asm volatile("v_cvt_pk_bf16_f32 %0, %1, %2" : "=v"(r) : "v"(lo), "v"(hi)); return r; }


struct EpiSwiGLU {
    static constexpr bool PERM = true, AFTER_DRAIN = false;
    bf16_t* H; int ldh;
    __device__ __forceinline__ void operator()(const f32x4 (&acc)[2][2][4][2], const Unit& u, int wr, int wc, int fr, int fq) const {
        const int row0 = u.pm * BM + wr * 64 + fr, col0 = u.pn * HALF + wc * 32 + 8 * fq;
#pragma unroll
        for (int ai = 0; ai < 2; ++ai)
#pragma unroll
            for (int m = 0; m < 4; ++m) { bf16_t* rowp = H + (size_t)(row0 + ai * HALF + m * 16) * ldh + col0;
                float o[8];
#pragma unroll
                for (int n = 0; n < 2; ++n)
#pragma unroll
                    for (int i = 0; i < 4; ++i) { const float gt = acc[ai][0][m][n][i], up = acc[ai][1][m][n][i]; o[4 * n + i] = gt * __builtin_amdgcn_rcpf(1.0f + __expf(-gt)) * up; }
                u32x4 w; w.x = cvt_pk_bf16(o[0], o[1]); w.y = cvt_pk_bf16(o[2], o[3]); w.z = cvt_pk_bf16(o[4], o[5]); w.w = cvt_pk_bf16(o[6], o[7]);
                *(u32x4*)rowp = w; }
    }
};
struct EpiResid {
    static constexpr bool PERM = false, AFTER_DRAIN = false;
    float* X; int ldx; const float* gl; int gc_delta; float coef; int ctx_pm;
    __device__ __forceinline__ void operator()(const f32x4 (&acc)[2][2][4][2], const Unit& u, int wr, int wc, int fr, int fq) const {
        const int row0 = u.pm * BM + wr * 64 + fr, col0 = u.pn * BM + wc * 32 + 4 * fq;
        const float* gate = gl + ((u.pm == ctx_pm) ? gc_delta : 0);
        f32x4 gv[2][2];
#pragma unroll
        for (int bj = 0; bj < 2; ++bj)
#pragma unroll
            for (int n = 0; n < 2; ++n) gv[bj][n] = *(const f32x4*)(gate + col0 + bj * HALF + n * 16) * coef;
#pragma unroll
        for (int ai = 0; ai < 2; ++ai)
#pragma unroll
            for (int m = 0; m < 4; ++m) { float* rowp = X + (size_t)(row0 + ai * HALF + m * 16) * ldx + col0;
#pragma unroll
                for (int bj = 0; bj < 2; ++bj)
#pragma unroll
                    for (int n = 0; n < 2; ++n) { f32x4* p = (f32x4*)(rowp + bj * HALF + n * 16); *p = *p + gv[bj][n] * acc[ai][bj][m][n]; }
                if (m & 1) asm volatile("" ::: "memory"); }
    }
};
struct EpiP {
    static constexpr bool PERM = false, AFTER_DRAIN = false;
    float* P; int ldp; bf16_t* UF;
    __device__ __forceinline__ void operator()(const f32x4 (&acc)[2][2][4][2], const Unit& u, int wr, int wc, int fr, int fq) const {
        const int row0 = u.pm * BM + wr * 64 + fr;
        if (u.pn < 14) {
            const int col0 = u.pn * BM + wc * 32 + 4 * fq;
#pragma unroll
            for (int ai = 0; ai < 2; ++ai)
#pragma unroll
                for (int m = 0; m < 4; ++m) { float* rowp = P + (size_t)(row0 + ai * HALF + m * 16) * ldp + col0;
#pragma unroll
                    for (int bj = 0; bj < 2; ++bj)
#pragma unroll
                        for (int n = 0; n < 2; ++n) *(f32x4*)(rowp + bj * HALF + n * 16) = acc[ai][bj][m][n]; }
        } else {
            const int col0 = (u.pn - 14) * BM + wc * 32 + 4 * fq;
#pragma unroll
            for (int ai = 0; ai < 2; ++ai)
#pragma unroll
                for (int m = 0; m < 4; ++m) { bf16_t* rowp = UF + (size_t)(row0 + ai * HALF + m * 16) * 512 + col0;
#pragma unroll
                    for (int bj = 0; bj < 2; ++bj)
#pragma unroll
                        for (int n = 0; n < 2; ++n) { const f32x4 v = acc[ai][bj][m][n]; u32x2 w; w.x = cvt_pk_bf16(v[0], v[1]); w.y = cvt_pk_bf16(v[2], v[3]); *(u32x2*)(rowp + bj * HALF + n * 16) = w; } }
        }
    }
};
struct EpiZT {
    static constexpr bool PERM = true, AFTER_DRAIN = false;
    bf16_t* ZT; long ztc_delta;
    __device__ __forceinline__ void operator()(const f32x4 (&acc)[2][2][4][2], const Unit& u, int wr, int wc, int fr, int fq) const {
        const int row0 = u.pm * BM + wr * 64 + fr; const bool ctx = (u.pn == 32);
        const int col0 = (ctx ? 0 : u.pn * BM) + wc * 32 + 8 * fq;
#pragma unroll
        for (int ai = 0; ai < 2; ++ai)
#pragma unroll
            for (int m = 0; m < 4; ++m) { const int r = row0 + ai * HALF + m * 16, cs = r >> 9, j = r & 511;
                bf16_t* rowp = ZT + (ctx ? (ztc_delta + (long)j * 512 + cs * 256) : ((long)j * 16384 + cs * 8192)) + col0;
#pragma unroll
                for (int bj = 0; bj < 2; ++bj) { const f32x4 v0 = acc[ai][bj][m][0], v1 = acc[ai][bj][m][1];
                    u32x4 w; w.x = cvt_pk_bf16(v0[0], v0[1]); w.y = cvt_pk_bf16(v0[2], v0[3]); w.z = cvt_pk_bf16(v1[0], v1[1]); w.w = cvt_pk_bf16(v1[2], v1[3]);
                    *(u32x4*)(rowp + bj * HALF) = w; } }
    }
};
struct EpiYF {
    static constexpr bool PERM = false, AFTER_DRAIN = false;
    float* YF; int row_off; size_t part_stride;
    __device__ __forceinline__ void operator()(const f32x4 (&acc)[2][2][4][2], const Unit& u, int wr, int wc, int fr, int fq) const {
        const int row0 = row_off + u.pm * BM + wr * 64 + fr, col0 = u.pn * BM + wc * 32 + 4 * fq;
        float* base = YF + (size_t)(u.kt0 / u.nt) * part_stride;
#pragma unroll
        for (int ai = 0; ai < 2; ++ai)
#pragma unroll
            for (int m = 0; m < 4; ++m) { float* rowp = base + (size_t)(row0 + ai * HALF + m * 16) * 512 + col0;
#pragma unroll
                for (int bj = 0; bj < 2; ++bj)
#pragma unroll
                    for (int n = 0; n < 2; ++n) *(f32x4*)(rowp + bj * HALF + n * 16) = acc[ai][bj][m][n]; }
    }
};

template <class Epi, class Sched, bool ALIGN_EPI = false, bool SP2 = false>
__device__ __forceinline__ void gemm_phase(PG8_LAS unsigned char* lds, const Gemm g, const Sched& S, const Epi& E) {
    int tid_ = threadIdx.x; asm volatile("" : "+v"(tid_));
    const int tid = tid_, wid = __builtin_amdgcn_readfirstlane(tid >> 6), lane = tid & 63, wr = wid >> 2, wc = wid & 3, fr = lane & 15, fq = lane >> 4;
    const int K = g.K;
    unsigned voffA[2], voffB[2];
#pragma unroll
    for (int i = 0; i < 2; ++i) { int R, C; stage_rc(tid * 16 + i * 8192, R, C); const int Rb = Epi::PERM ? ((R & ~31) + perm32(R & 31)) : R;
        voffA[i] = (unsigned)(R * K + C) * 2u; voffB[i] = (unsigned)(Rb * K + C) * 2u; }
    const size_t kstep = (size_t)(BK * 2);
    const size_t hstep = (size_t)HALF * K * 2;
    const size_t tstep = 2 * hstep;
    const unsigned ldsw = (unsigned)wid * 1024u;
    const int aoff = lds_byte(wr * 64 + fr, fq * 8), boff = lds_byte(wc * 32 + fr, fq * 8);
#define PG8_SA(b, h) (((b) * 2 + (h)) * HTB)
#define PG8_SB(b, h) ((4 + (b) * 2 + (h)) * HTB)
#define PG8_STAGE(bufoff, gbase, voff) do { _Pragma("unroll") for (int _i = 0; _i < 2; ++_i) \
        __builtin_amdgcn_global_load_lds((const unsigned*)((const char*)(gbase) + (voff)[_i]), (PG8_LAS unsigned*)(lds + (bufoff) + ldsw + _i * 8192), 16, 0, 0); } while (0)
#define PG8_LDA(dst, b, h) do { _Pragma("unroll") for (int m = 0; m < 4; ++m) _Pragma("unroll") for (int k = 0; k < 2; ++k) dst[m][k] = *(const PG8_LAS bf16x8*)(lds + PG8_SA(b, h) + aoff + m * 2048 + k * 1024); } while (0)
#define PG8_LDB(dst, b, h) do { _Pragma("unroll") for (int n = 0; n < 2; ++n) _Pragma("unroll") for (int k = 0; k < 2; ++k) dst[n][k] = *(const PG8_LAS bf16x8*)(lds + PG8_SB(b, h) + boff + n * 2048 + k * 1024); } while (0)
#define PG8_MMA(ai, bj, At, Bt) do { __builtin_amdgcn_s_setprio(1); _Pragma("unroll") for (int m = 0; m < 4; ++m) _Pragma("unroll") for (int n = 0; n < 2; ++n) _Pragma("unroll") for (int k = 0; k < 2; ++k) \
        acc[ai][bj][m][n] = __builtin_amdgcn_mfma_f32_16x16x32_bf16(Bt[n][k], At[m][k], acc[ai][bj][m][n], 0, 0, 0); __builtin_amdgcn_s_setprio(0); } while (0)
#define PG8_WAIT_V(n) asm volatile("s_waitcnt vmcnt(" #n ")" ::: "memory")
#define PG8_WAIT_L(n) asm volatile("s_waitcnt lgkmcnt(" #n ")" ::: "memory")
#define PG8_BAR __builtin_amdgcn_s_barrier()
#define PG8_SCHED __builtin_amdgcn_sched_barrier(0)
    Unit cur, nxt; int ui = 0;
    if (!S.next(0, cur)) return;
    f32x4 acc[2][2][4][2];
#pragma unroll
    for (int a = 0; a < 2; ++a)
#pragma unroll
        for (int b = 0; b < 2; ++b)
#pragma unroll
            for (int m = 0; m < 4; ++m)
#pragma unroll
                for (int n = 0; n < 2; ++n) acc[a][b][m][n] = (f32x4){0.f, 0.f, 0.f, 0.f};
    bf16x8 At[4][2], B0[2][2], B1[2][2];
    const char* cA = (const char*)g.A + (size_t)cur.pm * tstep + (size_t)cur.kt0 * kstep; const char* cB = (const char*)g.Bt + (size_t)cur.pn * tstep + (size_t)cur.kt0 * kstep;
    S.a_ready(cur);
    if constexpr (SP2) {
        PG8_STAGE(PG8_SB(0, 0), cB, voffB); PG8_STAGE(PG8_SB(0, 1), cB + hstep, voffB); PG8_STAGE(PG8_SA(0, 0), cA, voffA); PG8_STAGE(PG8_SA(0, 1), cA + hstep, voffA);
        if (wr == 1) PG8_BAR;
        PG8_WAIT_V(2); PG8_BAR;
        PG8_STAGE(PG8_SB(1, 0), cB + kstep, voffB); PG8_STAGE(PG8_SA(1, 0), cA + kstep, voffA); PG8_STAGE(PG8_SB(1, 1), cB + hstep + kstep, voffB);
        PG8_WAIT_V(6); PG8_BAR;
    } else {
        PG8_STAGE(PG8_SB(0, 0), cB, voffB); PG8_STAGE(PG8_SA(0, 0), cA, voffA); PG8_STAGE(PG8_SB(0, 1), cB + hstep, voffB); PG8_STAGE(PG8_SA(0, 1), cA + hstep, voffA);
        if (wr == 1) PG8_BAR;
        PG8_WAIT_V(4); PG8_BAR;
        PG8_STAGE(PG8_SB(1, 0), cB + kstep, voffB); PG8_STAGE(PG8_SA(1, 0), cA + kstep, voffA); PG8_STAGE(PG8_SB(1, 1), cB + hstep + kstep, voffB);
        PG8_WAIT_V(6); PG8_BAR;
    }
    for (;;) {
        const bool has_next = S.next(ui + 1, nxt);
        const char* nA = has_next ? (const char*)g.A + (size_t)nxt.pm * tstep + (size_t)nxt.kt0 * kstep : cA; const char* nB = has_next ? (const char*)g.Bt + (size_t)nxt.pn * tstep + (size_t)nxt.kt0 * kstep : cB;
        const int nt = cur.nt;
        for (int t = 0; t < nt; t += 2) {
            const bool last = (t == nt - 2);
            const char* a1 = cA + (size_t)(t + 1) * kstep;
            const char* a2 = last ? nA : cA + (size_t)(t + 2) * kstep; const char* b2 = last ? nB : cB + (size_t)(t + 2) * kstep;
            const char* a3 = a2 + kstep; const char* b3 = b2 + kstep;
            if (last && has_next) S.a_ready(nxt);
            if constexpr (SP2) {
            PG8_LDB(B0, 0, 0); PG8_LDB(B1, 0, 1); PG8_SCHED; PG8_LDA(At, 0, 0); PG8_STAGE(PG8_SA(1, 1), a1 + hstep, voffA);
            PG8_WAIT_V(8); PG8_WAIT_L(0); PG8_BAR; PG8_MMA(0, 0, At, B0); PG8_MMA(0, 1, At, B1); PG8_BAR; PG8_SCHED;
            PG8_LDA(At, 0, 1); PG8_STAGE(PG8_SB(0, 0), b2, voffB); PG8_STAGE(PG8_SB(0, 1), b2 + hstep, voffB); PG8_STAGE(PG8_SA(0, 0), a2, voffA);
            PG8_WAIT_V(8); PG8_WAIT_L(0); PG8_BAR; PG8_MMA(1, 0, At, B0); PG8_MMA(1, 1, At, B1); PG8_BAR; PG8_SCHED;
            PG8_LDB(B0, 1, 0); PG8_LDB(B1, 1, 1); PG8_SCHED; PG8_LDA(At, 1, 0); PG8_STAGE(PG8_SA(0, 1), a2 + hstep, voffA);
            PG8_WAIT_V(8); PG8_WAIT_L(0); PG8_BAR; PG8_MMA(0, 0, At, B0); PG8_MMA(0, 1, At, B1); PG8_BAR; PG8_SCHED;
            PG8_LDA(At, 1, 1); PG8_STAGE(PG8_SB(1, 0), b3, voffB); PG8_STAGE(PG8_SB(1, 1), b3 + hstep, voffB); PG8_STAGE(PG8_SA(1, 0), a3, voffA);
            PG8_WAIT_V(8); PG8_WAIT_L(0); PG8_BAR; PG8_MMA(1, 0, At, B0); PG8_MMA(1, 1, At, B1); PG8_BAR; PG8_SCHED;
            } else {
            PG8_LDB(B0, 0, 0); PG8_SCHED; PG8_LDA(At, 0, 0); PG8_STAGE(PG8_SA(1, 1), a1 + hstep, voffA);
            PG8_WAIT_L(8); PG8_BAR; PG8_WAIT_L(0); PG8_MMA(0, 0, At, B0); PG8_BAR; PG8_SCHED;
            PG8_LDB(B1, 0, 1); PG8_STAGE(PG8_SB(0, 0), b2, voffB);
            PG8_BAR; PG8_WAIT_L(0); PG8_MMA(0, 1, At, B1); PG8_BAR;
            PG8_LDA(At, 0, 1); PG8_STAGE(PG8_SA(0, 0), a2, voffA);
            PG8_BAR; PG8_WAIT_L(0); PG8_MMA(1, 0, At, B0); PG8_BAR; PG8_SCHED;
            PG8_STAGE(PG8_SB(0, 1), b2 + hstep, voffB);
            PG8_WAIT_V(6); PG8_BAR; PG8_MMA(1, 1, At, B1); PG8_BAR;
            PG8_LDB(B0, 1, 0); PG8_SCHED; PG8_LDA(At, 1, 0); PG8_STAGE(PG8_SA(0, 1), a2 + hstep, voffA);
            PG8_WAIT_L(8); PG8_BAR; PG8_WAIT_L(0); PG8_MMA(0, 0, At, B0); PG8_BAR; PG8_SCHED;
            PG8_LDB(B1, 1, 1); PG8_STAGE(PG8_SB(1, 0), b3, voffB);
            PG8_BAR; PG8_WAIT_L(0); PG8_MMA(0, 1, At, B1); PG8_BAR;
            PG8_LDA(At, 1, 1); PG8_STAGE(PG8_SA(1, 0), a3, voffA);
            PG8_BAR; PG8_WAIT_L(0); PG8_MMA(1, 0, At, B0); PG8_BAR; PG8_SCHED;
            PG8_STAGE(PG8_SB(1, 1), b3 + hstep, voffB);
            PG8_WAIT_V(6); PG8_BAR; PG8_MMA(1, 1, At, B1); PG8_BAR;
            }
        }
        if constexpr (ALIGN_EPI) { if (wr == 0) PG8_BAR; }
        if constexpr (!Epi::AFTER_DRAIN) { E(acc, cur, wr, wc, fr, fq); S.done(cur); }
        if (!has_next) break;
#pragma unroll
        for (int a = 0; a < 2; ++a)
#pragma unroll
            for (int b = 0; b < 2; ++b)
#pragma unroll
                for (int m = 0; m < 4; ++m)
#pragma unroll
                    for (int n = 0; n < 2; ++n) acc[a][b][m][n] = (f32x4){0.f, 0.f, 0.f, 0.f};
        cur = nxt; cA = nA; cB = nB; ++ui;
        if constexpr (ALIGN_EPI) { if (wr == 1) PG8_BAR; }
    }
    PG8_WAIT_V(0);
    if constexpr (!ALIGN_EPI) { if (wr == 0) PG8_BAR; }
    PG8_BAR;
    if constexpr (Epi::AFTER_DRAIN) { E.fused(acc, cur, wr, wc, fr, fq, lds, wid, lane); S.done(cur); }
#undef PG8_SA
#undef PG8_SB
#undef PG8_STAGE
#undef PG8_LDA
#undef PG8_LDB
#undef PG8_MMA
#undef PG8_WAIT_V
#undef PG8_WAIT_L
#undef PG8_BAR
#undef PG8_SCHED
}
}
#define XB_TMO      128
#define XB_XCNT(j)  (256  + 64 * (j))
#define XB_XSUB(j)  (1280 + 64 * (j))
#define XB_XGEN(j)  (2304 + 64 * (j))
#define XB_TOP      3328
#define XB_TOPGEN   3392
#define XCD_BAR_WORDS 3456
#define XB_SPIN_CAP (1u << 18)

__device__ __forceinline__ unsigned xb_ld(unsigned* p)              { return __hip_atomic_load(p, __ATOMIC_RELAXED, __HIP_MEMORY_SCOPE_AGENT); }
__device__ __forceinline__ unsigned xb_add(unsigned* p, unsigned v) { return __hip_atomic_fetch_add(p, v, __ATOMIC_RELAXED, __HIP_MEMORY_SCOPE_AGENT); }
__device__ __forceinline__ unsigned xb_xcc_id() { return (unsigned)__builtin_amdgcn_s_getreg((3 << 11) | 20) & 0xFu; }
#define XB_SPIN(cond, bar) do { unsigned _sp = 0; while (cond) { __builtin_amdgcn_s_sleep(1); \
    if ((++_sp & 255u) == 0u) { if (xb_ld(&(bar)[XB_TMO])) break; if (_sp > XB_SPIN_CAP) { atomicAdd(&(bar)[XB_TMO], 1u); break; } } } } while (0)

struct XcdBarrier {
    unsigned* bar; unsigned x;
    volatile LAS unsigned* st;
};

__device__ __forceinline__ XcdBarrier xcd_barrier_post(unsigned* bar, volatile LAS unsigned* st) {
    XcdBarrier b; b.bar = bar; b.x = xb_xcc_id(); b.st = st;
    if (threadIdx.x == 0) (void)xb_add(&bar[XB_XCNT(b.x)], 1u);
    return b;
}
__device__ __forceinline__ void xcd_barrier_complete(unsigned* bar, unsigned x, unsigned& nloc, unsigned& nx) {
    const unsigned G = gridDim.x * gridDim.y * gridDim.z;
    unsigned sum, cnt, mine, sp = 0u;
    for (;;) {
        sum = 0u; cnt = 0u; mine = 0u;
#pragma unroll
        for (unsigned j = 0; j < 16; ++j) { const unsigned c = xb_ld(&bar[XB_XCNT(j)]); sum += c; cnt += (c > 0u) ? 1u : 0u; mine = (j == x) ? c : mine; }
        if (sum == G) break;
        __builtin_amdgcn_s_sleep(1);
        if ((++sp & 255u) == 0u) { if (xb_ld(&bar[XB_TMO])) break; if (sp > XB_SPIN_CAP) { atomicAdd(&bar[XB_TMO], 1u); break; } }
    }
    nloc = mine > 0u ? mine : 1u; nx = cnt > 0u ? cnt : 1u;
}

__device__ __forceinline__ void xcd_barrier(const XcdBarrier& b) {
    asm volatile("s_waitcnt vmcnt(0)" ::: "memory");
    __syncthreads();
    if (threadIdx.x == 0) {
        unsigned* bar = b.bar;
        __builtin_amdgcn_s_waitcnt(0);
        unsigned nloc = b.st[0], nx = b.st[1];
        if (nloc == 0u) { xcd_barrier_complete(bar, b.x, nloc, nx); b.st[0] = nloc; b.st[1] = nx; }
        const unsigned old = xb_add(&bar[XB_XSUB(b.x)], 1u);
        const unsigned gen = old / nloc;
        if (old + 1u == (gen + 1u) * nloc) {
            __builtin_amdgcn_fence(__ATOMIC_RELEASE, "agent");
            asm volatile("s_waitcnt vmcnt(0)" ::: "memory");
            const unsigned og = xb_add(&bar[XB_TOP], 1u);
            const unsigned tg = og / nx;
            if (og + 1u == (tg + 1u) * nx) xb_add(&bar[XB_TOPGEN], 1u);
            else XB_SPIN(xb_ld(&bar[XB_TOPGEN]) == tg, bar);
            __builtin_amdgcn_fence(__ATOMIC_ACQUIRE, "agent");
            xb_add(&bar[XB_XGEN(b.x)], 1u);
            asm volatile("s_waitcnt vmcnt(0)" ::: "memory");
        } else {
            XB_SPIN(xb_ld(&bar[XB_XGEN(b.x)]) == gen, bar);
            __builtin_amdgcn_fence(__ATOMIC_ACQUIRE, "agent");
            asm volatile("s_waitcnt vmcnt(0)" ::: "memory");
        }
    }
    __syncthreads();
}

namespace att {
typedef unsigned short bf16;
constexpr int D = 128, NW = 8, QBLK = 32, KVBLK = 64;
constexpr float SCALE = 0.088388347648318440f;
constexpr float THR = 8.f;
constexpr int LDQ = 512, LDK = 256, LDO = 512;
constexpr size_t SHM_V = KVBLK * D * 2, SHM_K = KVBLK * D * 2, SHM_ATTN = 2 * SHM_V + 2 * SHM_K + NW * 64 * 4;
using bf16x8 = __attribute__((ext_vector_type(8))) short;
using s16x4  = __attribute__((ext_vector_type(4))) short;
using f32x16 = __attribute__((ext_vector_type(16))) float;
using u32x4  = __attribute__((ext_vector_type(4))) unsigned;
#define KSWZ(row, colB) ((row) * 256 + ((colB) ^ (((row) & 7) << 4)))
#define SBAR() __builtin_amdgcn_sched_barrier(0)
__device__ __forceinline__ int crow(int r, int hi) { return (r & 3) + 8 * (r >> 2) + 4 * hi; }
__device__ __forceinline__ unsigned cvtpk(float lo, float hi) { unsigned r; asm volatile("v_cvt_pk_bf16_f32 %0, %1, %2" : "=v"(r) : "v"(lo), "v"(hi)); return r; }
__device__ __forceinline__ void partialSM(f32x16& p0, f32x16& p1, float& m_reg, float& mn, float& alpha) {
  constexpr float C = SCALE * 1.4426950408889634f;
  float pmax = p0[0]; for (int r = 1; r < 16; ++r) pmax = fmaxf(pmax, p0[r]); for (int r = 0; r < 16; ++r) pmax = fmaxf(pmax, p1[r]);
  { auto rr = __builtin_amdgcn_permlane32_swap(__float_as_uint(pmax), __float_as_uint(pmax), false, false);
    pmax = fmaxf(__uint_as_float(rr[0]), __uint_as_float(rr[1])); }
  if (__builtin_expect(__all(pmax - m_reg <= THR / SCALE), 1)) { mn = m_reg; alpha = 1.f; }
  else { mn = fmaxf(m_reg, pmax); alpha = __builtin_amdgcn_exp2f((m_reg - mn) * C); m_reg = mn; }
  float mnC = -mn * C;
  for (int r = 0; r < 16; ++r) p0[r] = fmaf(p0[r], C, mnC); for (int r = 0; r < 16; ++r) p1[r] = fmaf(p1[r], C, mnC);
  for (int r = 0; r < 16; ++r) p0[r] = __builtin_amdgcn_exp2f(p0[r]);
}
__device__ __forceinline__ void finishSM(f32x16& p0, f32x16& p1, float alpha, float& l_reg, bf16x8& pa0, bf16x8& pa1, bf16x8& pa2, bf16x8& pa3) {
  for (int r = 0; r < 16; ++r) p1[r] = __builtin_amdgcn_exp2f(p1[r]);
  float ps = 0; for (int r = 0; r < 16; ++r) ps += p0[r]; for (int r = 0; r < 16; ++r) ps += p1[r];
  { auto rr = __builtin_amdgcn_permlane32_swap(__float_as_uint(ps), __float_as_uint(ps), false, false);
    ps = __uint_as_float(rr[0]) + __uint_as_float(rr[1]); }
  l_reg = l_reg * alpha + ps;
#define PK4(P, BASE, OUT) do { unsigned a0 = cvtpk(P[BASE + 0], P[BASE + 1]), a1 = cvtpk(P[BASE + 2], P[BASE + 3]);   \
    unsigned b0 = cvtpk(P[BASE + 4], P[BASE + 5]), b1 = cvtpk(P[BASE + 6], P[BASE + 7]);                              \
    auto r0 = __builtin_amdgcn_permlane32_swap(a0, b0, false, false); auto r1 = __builtin_amdgcn_permlane32_swap(a1, b1, false, false); \
    u32x4 w = {r0[0], r1[0], r0[1], r1[1]}; OUT = *reinterpret_cast<bf16x8*>(&w); } while (0)
  PK4(p0, 0, pa0); PK4(p0, 8, pa1); PK4(p1, 0, pa2); PK4(p1, 8, pa3);
#undef PK4
}
__device__ __forceinline__ void qkt(f32x16& p0, f32x16& p1, const bf16* Ks, const bf16x8* qr, int r32, int hi) {
  p0 = f32x16{}; p1 = f32x16{};
  for (int d0 = 0; d0 < 8; ++d0) { int cb = (d0 * 16 + hi * 8) * 2;
    bf16x8 b0 = *reinterpret_cast<const bf16x8*>((const char*)Ks + KSWZ(r32, cb));
    bf16x8 b1 = *reinterpret_cast<const bf16x8*>((const char*)Ks + KSWZ(32 + r32, cb));
    p0 = __builtin_amdgcn_mfma_f32_32x32x16_bf16(b0, qr[d0], p0, 0, 0, 0);
    p1 = __builtin_amdgcn_mfma_f32_32x32x16_bf16(b1, qr[d0], p1, 0, 0, 0); }
}
__device__ __forceinline__ int v_st(int k, int c) { const int kk = (k & ~0xC) | ((k & 4) << 1) | ((k & 8) >> 1); return ((kk >> 3) * 4 + (c >> 5)) * 512 + ((kk & 7) * 32 + (c & 31)) * 2; }
__device__ __forceinline__ int v_rd_base(int lane) { return ((lane & 3) << 3) | (((lane >> 2) & 3) << 6) | (((lane >> 4) & 1) << 5) | (((lane >> 5) & 1) << 8); }
constexpr int v_rd_off(int d0, int ks, int half) { return d0 * 512 + ks * 4096 + half * 2048; }
template <int OFF> __device__ __forceinline__ s16x4 tr_read(int vb) {
  s16x4 r; asm volatile("ds_read_b64_tr_b16 %0, %1 offset:%2" : "=&v"(r) : "v"(vb), "i"(OFF) : "memory"); return r;
}
template <int D0> __device__ __forceinline__ void pv_one(f32x16& od, int vb, bf16x8 pa0, bf16x8 pa1, bf16x8 pa2, bf16x8 pa3) {
  const s16x4 l0 = tr_read<v_rd_off(D0, 0, 0)>(vb), h0 = tr_read<v_rd_off(D0, 0, 1)>(vb), l1 = tr_read<v_rd_off(D0, 1, 0)>(vb), h1 = tr_read<v_rd_off(D0, 1, 1)>(vb);
  const s16x4 l2 = tr_read<v_rd_off(D0, 2, 0)>(vb), h2 = tr_read<v_rd_off(D0, 2, 1)>(vb), l3 = tr_read<v_rd_off(D0, 3, 0)>(vb), h3 = tr_read<v_rd_off(D0, 3, 1)>(vb);
  asm volatile("s_waitcnt lgkmcnt(0)" ::: "memory"); SBAR();
#define PK(L, H) (bf16x8){L[0], L[1], L[2], L[3], H[0], H[1], H[2], H[3]}
  od = __builtin_amdgcn_mfma_f32_32x32x16_bf16(pa0, PK(l0, h0), od, 0, 0, 0);
  od = __builtin_amdgcn_mfma_f32_32x32x16_bf16(pa1, PK(l1, h1), od, 0, 0, 0);
  od = __builtin_amdgcn_mfma_f32_32x32x16_bf16(pa2, PK(l2, h2), od, 0, 0, 0);
  od = __builtin_amdgcn_mfma_f32_32x32x16_bf16(pa3, PK(l3, h3), od, 0, 0, 0);
#undef PK
}
__device__ __forceinline__ void pv_d0(f32x16* o, int vb, bf16x8 pa0, bf16x8 pa1, bf16x8 pa2, bf16x8 pa3) {
  pv_one<0>(o[0], vb, pa0, pa1, pa2, pa3); pv_one<1>(o[1], vb, pa0, pa1, pa2, pa3); pv_one<2>(o[2], vb, pa0, pa1, pa2, pa3); pv_one<3>(o[3], vb, pa0, pa1, pa2, pa3);
}
__device__ __forceinline__ void attn_unit(const bf16* __restrict__ Qb, const bf16* __restrict__ Kh, const bf16* __restrict__ Vh, float* __restrict__ Ob, float* __restrict__ MLb, int seq, char* lds) {
  int tid_ = threadIdx.x; asm volatile("" : "+v"(tid_));
  const int tid = tid_, wid = tid >> 6, lane = tid & 63, r32 = lane & 31, hi = lane >> 5;
  bf16* V_lds = (bf16*)lds; bf16* K_lds = (bf16*)(lds + 2 * SHM_V);
  float* ws = (float*)(lds + 2 * SHM_V + 2 * SHM_K) + wid * 64; float* al_l = ws + 32;
  float m_reg = -1e30f, l_reg = 0; f32x16 o[4] = {}; bf16x8 qr[8];
  const bf16* Qw = Qb + (long)(wid * QBLK + r32) * LDQ + hi * 8;
#pragma unroll
  for (int d0 = 0; d0 < 8; ++d0) qr[d0] = *reinterpret_cast<const bf16x8*>(Qw + d0 * 16);
  const int sr = tid >> 4, sc = (tid & 15) * 8, vst0 = v_st(sr, sc), vst1 = v_st(32 + sr, sc);
  const int vb0 = (int)(uintptr_t)V_lds + v_rd_base(lane);
  struct { bf16x8 vs0, vs1, ks0, ks1; } sr_[2];
#define SLOAD(i, k0) do { sr_[i].vs0 = *reinterpret_cast<const bf16x8*>(&Vh[(long)((k0) + sr) * LDK + sc]); sr_[i].vs1 = *reinterpret_cast<const bf16x8*>(&Vh[(long)((k0) + 32 + sr) * LDK + sc]); \
    sr_[i].ks0 = *reinterpret_cast<const bf16x8*>(&Kh[(long)((k0) + sr) * LDK + sc]); sr_[i].ks1 = *reinterpret_cast<const bf16x8*>(&Kh[(long)((k0) + 32 + sr) * LDK + sc]); } while (0)
#define SWRITE(b, i) do { *(bf16x8*)((char*)V_lds + (b) * SHM_V + vst0) = sr_[i].vs0;          \
    *(bf16x8*)((char*)V_lds + (b) * SHM_V + vst1) = sr_[i].vs1; int kc = sc * 2;               \
    *(bf16x8*)((char*)K_lds + (b) * SHM_K + KSWZ(sr, kc)) = sr_[i].ks0;                       \
    *(bf16x8*)((char*)K_lds + (b) * SHM_K + KSWZ(32 + sr, kc)) = sr_[i].ks1; } while (0)
#define SWAIT() asm volatile("s_waitcnt vmcnt(4)" ::: "memory")
#define RESC(a) do { if (__any((a) < 1.f)) { if (hi == 0) al_l[r32] = (a); asm volatile("s_waitcnt lgkmcnt(0)" ::: "memory"); \
    for (int d = 0; d < 4; ++d) for (int r = 0; r < 16; ++r) o[d][r] *= al_l[crow(r, hi)]; } } while (0)
  f32x16 pA0, pA1, pB0, pB1; float mnA, mnB, alA, alB; bf16x8 pa0, pa1, pa2, pa3; const int NT = seq / KVBLK;
  constexpr int SE = 0, SO = 1;
  SLOAD(SE, 0); asm volatile("s_waitcnt vmcnt(0)" ::: "memory"); SWRITE(0, SE); __syncthreads();
  qkt(pA0, pA1, K_lds, qr, r32, hi); partialSM(pA0, pA1, m_reg, mnA, alA);
  SLOAD(SO, KVBLK); if (2 < NT) SLOAD(SE, 2 * KVBLK);
  SWAIT(); SWRITE(1, SO); __syncthreads();
  for (int j = 1; j + 1 < NT; j += 2) {
    SBAR(); qkt(pB0, pB1, (bf16*)((char*)K_lds + SHM_K), qr, r32, hi);
    finishSM(pA0, pA1, alA, l_reg, pa0, pa1, pa2, pa3); SBAR();
    SLOAD(SO, (j + 2) * KVBLK); SBAR();
    pv_d0(o, vb0, pa0, pa1, pa2, pa3); partialSM(pB0, pB1, m_reg, mnB, alB);
    __syncthreads(); SWAIT(); SWRITE(0, SE);
    RESC(alB); __syncthreads();
    SBAR(); qkt(pA0, pA1, K_lds, qr, r32, hi);
    finishSM(pB0, pB1, alB, l_reg, pa0, pa1, pa2, pa3); SBAR();
    if (j + 3 < NT) SLOAD(SE, (j + 3) * KVBLK); SBAR();
    pv_d0(o, vb0 + (int)SHM_V, pa0, pa1, pa2, pa3); partialSM(pA0, pA1, m_reg, mnA, alA);
    __syncthreads(); SWAIT(); SWRITE(1, SO);
    RESC(alA); __syncthreads();
  }
  SBAR(); qkt(pB0, pB1, (bf16*)((char*)K_lds + SHM_K), qr, r32, hi);
  finishSM(pA0, pA1, alA, l_reg, pa0, pa1, pa2, pa3); SBAR();
  pv_d0(o, vb0, pa0, pa1, pa2, pa3); partialSM(pB0, pB1, m_reg, mnB, alB);
  __syncthreads(); RESC(alB);
  finishSM(pB0, pB1, alB, l_reg, pa0, pa1, pa2, pa3); SBAR();
  pv_d0(o, vb0 + (int)SHM_V, pa0, pa1, pa2, pa3);
  if (hi == 0) { float* ml = MLb + (long)(wid * QBLK + r32) * 8; ml[0] = m_reg; ml[1] = l_reg; }
  float* Ow = Ob + (long)(wid * QBLK) * LDO;
#pragma unroll
  for (int r = 0; r < 16; ++r) { int orow = crow(r, hi);
    for (int d0 = 0; d0 < 4; ++d0) Ow[(long)orow * LDO + d0 * 32 + r32] = o[d0][r]; }
#undef SLOAD
#undef SWRITE
#undef SWAIT
#undef RESC
}
#undef KSWZ
#undef SBAR
}

struct Frame {
    LAS unsigned char* lds;
    unsigned char* gl;
    volatile LAS unsigned* MISC;
    gu32* ctl;
    int tid, lane, wave, G, bid;
};

__device__ __forceinline__ Frame fresh(const Frame& F) {
    Frame R = F; int t = F.tid; asm volatile("" : "+v"(t)); R.tid = t; R.lane = t & 63; R.wave = __builtin_amdgcn_readfirstlane(t >> 6);
    int b = F.bid; asm volatile("" : "+s"(b)); R.bid = b; int g = F.G; asm volatile("" : "+s"(g)); R.G = g; return R;
}
__device__ __forceinline__ void tr_item(const float* __restrict__ W, int N, int k0, int n0, bf16* __restrict__ WT, int Kd, int drow0, LAS float* scr, int lane) {
#pragma unroll 8
    for (int i = 0; i < 32; ++i) { const int kk = 2 * i + (lane >> 5); scr[kk * 33 + (lane & 31)] = W[(size_t)(k0 + kk) * N + n0 + (lane & 31)]; }
    LDS_WAIT(); asm volatile("" ::: "memory");
    const int c = lane & 7;
#pragma unroll
    for (int j = 0; j < 4; ++j) { const int n = (lane >> 3) + 8 * j; const LAS float* s = scr + (8 * c) * 33 + n;
        u32x4 o; o.x = pk2(s[0 * 33], s[1 * 33]); o.y = pk2(s[2 * 33], s[3 * 33]); o.z = pk2(s[4 * 33], s[5 * 33]); o.w = pk2(s[6 * 33], s[7 * 33]);
        *(u32x4*)(WT + (size_t)(drow0 + n) * Kd + k0 + 8 * c) = o; }
    LDS_WAIT(); asm volatile("" ::: "memory");
}

struct In {
    const float *x, *c, *ctx, *c_ctx, *mod_w, *mod_b, *norm_g, *final_g, *ffn_w13, *ffn_w2, *w_in, *w_out, *lru_conv_w, *lru_conv_b, *lru_gate_w, *lru_gate_b, *lru_lambda, *attn_qk_g, *gla_gate_w, *gla_gate_b, *gla_out_g;
};

__device__ __forceinline__ void prologue_a(const Frame& F_, const In& I, unsigned char* ws) {
    const Frame F = fresh(F_);
    const int gw = F.bid * NWAVES + F.wave, NGW = F.G * NWAVES;
    { const f32x4* xs = (const f32x4*)I.x; const f32x4* cs = (const f32x4*)I.ctx; f32x4* X = (f32x4*)(ws + WS_X);
      const int nl = TL * DM / 4, nt = MR * DM / 4;
      for (int i = F.bid * 512 + F.tid; i < nt; i += F.G * 512) X[i] = (i < nl) ? xs[i] : cs[i - nl]; }
    { float* MODP = (float*)(ws + WS_YF);
      for (int it = gw; it < NLAY * 72 * 8; it += NGW) {
          const int ks = it & 7, r = it >> 3, jb = r % 72, l = r / 72; const int j = jb * 256 + 4 * F.lane;
          const float* W = I.mod_w + ((size_t)l * DM + ks * 256) * (9 * DM) + j;
          f32x4 a0 = {0.f, 0.f, 0.f, 0.f}, a1 = {0.f, 0.f, 0.f, 0.f};
#pragma unroll 8
          for (int k = 0; k < 256; ++k) { const f32x4 w = *(const f32x4*)(W + (size_t)k * (9 * DM)); const float c0 = I.c[ks * 256 + k], c1 = I.c_ctx[ks * 256 + k];
              a0 += w * siluf_(c0); a1 += w * siluf_(c1); }
          *(f32x4*)(MODP + ((size_t)(ks * NLAY + l) * 2 + 0) * (9 * DM) + j) = a0;
          *(f32x4*)(MODP + ((size_t)(ks * NLAY + l) * 2 + 1) * (9 * DM) + j) = a1;
      } }
    LAS float* scr = (LAS float*)(F.lds + RING_OFF + F.wave * 16384);
    { constexpr int PER = 32 * 352;
      bf16* dst = (bf16*)(ws + WS_W13T);
      for (int it = gw; it < 8 * PER; it += NGW) { const int mat = it / PER, r = it % PER, kb = r / 352, nb = r % 352, n0 = nb * 32;
          const int drow0 = (n0 < FF) ? (n0 / 128) * 256 + (n0 % 128) : ((n0 - FF) / 128) * 256 + 128 + ((n0 - FF) % 128);
          tr_item(I.ffn_w13 + (size_t)mat * DM * 2 * FF, 2 * FF, kb * 64, n0, dst + (size_t)mat * 2 * FF * DM, DM, drow0, scr, F.lane); } }
    { constexpr int PER = 88 * 64;
      bf16* dst = (bf16*)(ws + WS_W2T);
      for (int it = gw; it < 8 * PER; it += NGW) { const int mat = it / PER, r = it % PER, kb = r / 64, nb = r % 64;
          tr_item(I.ffn_w2 + (size_t)mat * FF * DM, DM, kb * 64, nb * 32, dst + (size_t)mat * DM * FF, FF, nb * 32, scr, F.lane); } }
    { constexpr int PER = 32 * 129;
      bf16* dst = (bf16*)(ws + WS_WINT); bf16* dlr = (bf16*)(ws + WS_WLRT);
      for (int it = gw; it < 4 * PER; it += NGW) { const int mat = it / PER, r = it % PER, kb = r / 129, nb = r % 129;
          if (nb == 112) tr_item(I.w_in + (size_t)mat * DM * DIN, DIN, kb * 64, nb * 32, dlr + (size_t)mat * 32 * DM, DM, 0, scr, F.lane);
          else tr_item(I.w_in + (size_t)mat * DM * DIN, DIN, kb * 64, nb * 32, dst + (size_t)mat * 4096 * DM, DM, (nb < 112) ? nb * 32 : nb * 32 - 32, scr, F.lane); } }
    { constexpr int PER = 32 * 64;
      bf16* dst = (bf16*)(ws + WS_WOUTT);
      for (int it = gw; it < 4 * PER; it += NGW) { const int mat = it / PER, r = it % PER, kb = r / 64, nb = r % 64;
          tr_item(I.w_out + (size_t)mat * DM * DM, DM, kb * 64, nb * 32, dst + (size_t)mat * DM * DM, DM, nb * 32, scr, F.lane); } }
}
__device__ __forceinline__ void prologue_b(const Frame& F_, const In& I, unsigned char* ws) {
    const Frame F = fresh(F_);
    const int gt = F.bid * 512 + F.tid, NGT = F.G * 512;
    { const float* MODP = (const float*)(ws + WS_YF); float* MODV = (float*)(ws + WS_MODV);
      for (int i = gt; i < NLAY * 2 * 9 * DM; i += NGT) { const int l = i / (2 * 9 * DM), j = i % (9 * DM);
          float s = I.mod_b[l * 9 * DM + j];
#pragma unroll
          for (int ks = 0; ks < 8; ++ks) s += MODP[(size_t)ks * NLAY * 2 * 9 * DM + i];
          MODV[i] = s; } }
    { bf16* A = (bf16*)(ws + WS_ADFT);
      for (int i = gt; i < TL * 2048; i += NGT) { const int k1 = i >> 11, c0 = (i & 2047) * 8; float v[8];
#pragma unroll
          for (int e = 0; e < 8; ++e) { const int col = c0 + e, t = col & 8191; const float f = (float)((k1 * t) & 8191) * (1.0f / 8192.0f);
              v[e] = (col < 8192) ? __builtin_amdgcn_cosf(f) : __builtin_amdgcn_sinf(-f); }
          u32x4 o; o.x = pk2(v[0], v[1]); o.y = pk2(v[2], v[3]); o.z = pk2(v[4], v[5]); o.w = pk2(v[6], v[7]);
          *(u32x4*)(A + (size_t)k1 * 16384 + c0) = o; } }
    { bf16* A = (bf16*)(ws + WS_ADFTC);
      for (int i = gt; i < TCX * 64; i += NGT) { const int k1 = i >> 6, c0 = (i & 63) * 8; float v[8];
#pragma unroll
          for (int e = 0; e < 8; ++e) { const int col = c0 + e, t = col & 255; const float f = (float)((k1 * t) & 255) * (1.0f / 256.0f);
              v[e] = (col < 256) ? __builtin_amdgcn_cosf(f) : __builtin_amdgcn_sinf(-f); }
          u32x4 o; o.x = pk2(v[0], v[1]); o.y = pk2(v[2], v[3]); o.z = pk2(v[4], v[5]); o.w = pk2(v[6], v[7]);
          *(u32x4*)(A + (size_t)k1 * 512 + c0) = o; } }
    { bf16* A = (bf16*)(ws + WS_ADFT1);
      for (int i = gt; i < 1024 * 64; i += NGT) { const int m = i >> 6, c0 = (i & 63) * 8, cs = m >> 9, g = (m >> 7) & 3, k2 = m & 127; float v[8];
#pragma unroll
          for (int e = 0; e < 8; ++e) { const int k = c0 + e, gp = k >> 7, c = k & 127; const float f = (float)((c * k2) & 127) * (1.0f / 128.0f);
              v[e] = (gp == g) ? (cs ? __builtin_amdgcn_sinf(f) : __builtin_amdgcn_cosf(f)) : 0.0f; }
          u32x4 o; o.x = pk2(v[0], v[1]); o.y = pk2(v[2], v[3]); o.z = pk2(v[4], v[5]); o.w = pk2(v[6], v[7]);
          *(u32x4*)(A + (size_t)m * 512 + c0) = o; } }
    { float* R = (float*)(ws + WS_ROPE);
      for (int i = gt; i < 128 * 32; i += NGT) { const int pos = i >> 5, fi = i & 31;
          const float freq = powf(10000.0f, -(float)fi / 32.0f); const float ang = (float)pos * freq;
          const double rev = (double)ang * 0.15915494309189535; const float fr = (float)(rev - floor(rev));
          R[i] = __builtin_amdgcn_cosf(fr); R[128 * 32 + i] = __builtin_amdgcn_sinf(fr); } }
}

__device__ __forceinline__ void norm_phase(const Frame& F_, const float* __restrict__ X, bf16* __restrict__ XN, const float* __restrict__ g,
                                           const float* __restrict__ shl, const float* __restrict__ scl, const float* __restrict__ shc, const float* __restrict__ scc) {
    const Frame F = fresh(F_);
    const int gw = F.bid * NWAVES + F.wave, NGW = F.G * NWAVES;
    for (int row = gw; row < MR; row += NGW) {
        const float* xr = X + (size_t)row * DM; const float* sh = (row >= TL) ? shc : shl; const float* sc = (row >= TL) ? scc : scl;
        f32x4 v[8]; float s = 0.f;
#pragma unroll
        for (int j = 0; j < 8; ++j) { v[j] = *(const f32x4*)(xr + 256 * j + 4 * F.lane); s += (v[j].x * v[j].x + v[j].y * v[j].y) + (v[j].z * v[j].z + v[j].w * v[j].w); }
        const float r = rsqrtf(wave_sum(s) * (1.0f / DM) + EPS);
#pragma unroll
        for (int j = 0; j < 8; ++j) { const int c = 256 * j + 4 * F.lane; const f32x4 gv = *(const f32x4*)(g + c), sv = *(const f32x4*)(sc + c), hv = *(const f32x4*)(sh + c);
            const f32x4 y = v[j] * r * gv * (sv + 1.0f) + hv; u32x2 o; o.x = pk2(y.x, y.y); o.y = pk2(y.z, y.w); *(u32x2*)(XN + (size_t)row * DM + c) = o; }
    }
}
__device__ __forceinline__ void final_norm(const Frame& F_, const float* __restrict__ X, float* __restrict__ out, const float* __restrict__ g) {
    const Frame F = fresh(F_);
    const int gw = F.bid * NWAVES + F.wave, NGW = F.G * NWAVES;
    for (int row = gw; row < TL; row += NGW) {
        const float* xr = X + (size_t)row * DM; f32x4 v[8]; float s = 0.f;
#pragma unroll
        for (int j = 0; j < 8; ++j) { v[j] = *(const f32x4*)(xr + 256 * j + 4 * F.lane); s += (v[j].x * v[j].x + v[j].y * v[j].y) + (v[j].z * v[j].z + v[j].w * v[j].w); }
        const float r = rsqrtf(wave_sum(s) * (1.0f / DM) + EPS);
#pragma unroll
        for (int j = 0; j < 8; ++j) { const int c = 256 * j + 4 * F.lane; *(f32x4*)(out + (size_t)row * DM + c) = v[j] * r * *(const f32x4*)(g + c); }
    }
}
__device__ __forceinline__ void lr_phase(const Frame& F_, const bf16* __restrict__ XN, const bf16* __restrict__ WLRT, float* __restrict__ LR) {
    const Frame F = fresh(F_);
    __syncthreads();
    { const u32x4* src = (const u32x4*)WLRT; LAS u32x4* dst = (LAS u32x4*)(F.lds + RING_OFF);
      for (int i = F.tid; i < 32 * DM * 2 / 16; i += 512) dst[i] = src[i]; }
    __syncthreads();
    const int gw = F.bid * NWAVES + F.wave, NGW = F.G * NWAVES;
    for (int row = gw; row < MR; row += NGW) {
        float xv[32];
#pragma unroll
        for (int j = 0; j < 8; ++j) { const u32x2 p = *(const u32x2*)(XN + (size_t)row * DM + 256 * j + 4 * F.lane);
            xv[4 * j + 0] = __uint_as_float(p.x << 16); xv[4 * j + 1] = __uint_as_float(p.x & 0xffff0000u); xv[4 * j + 2] = __uint_as_float(p.y << 16); xv[4 * j + 3] = __uint_as_float(p.y & 0xffff0000u); }
        float mine = 0.f;
        for (int c = 0; c < 32; ++c) { float s = 0.f;
#pragma unroll
            for (int j = 0; j < 8; ++j) { const u32x2 p = *(const LAS u32x2*)(F.lds + RING_OFF + ((size_t)c * DM + 256 * j + 4 * F.lane) * 2);
                s += xv[4 * j + 0] * __uint_as_float(p.x << 16) + xv[4 * j + 1] * __uint_as_float(p.x & 0xffff0000u) + xv[4 * j + 2] * __uint_as_float(p.y << 16) + xv[4 * j + 3] * __uint_as_float(p.y & 0xffff0000u); }
            s = wave_sum(s); if (F.lane == c) mine = s; }
        if (F.lane < 32) LR[(size_t)row * 32 + F.lane] = mine;
    }
    __syncthreads();
}
__device__ __forceinline__ void qkv_prep(const Frame& F_, const float* __restrict__ P, const float* __restrict__ qk_g, const float* __restrict__ ROPE, bf16* __restrict__ QB, bf16* __restrict__ KB, bf16* __restrict__ VB) {
    const Frame F = fresh(F_);
    const int gw = F.bid * NWAVES + F.wave, NGW = F.G * NWAVES;
    for (int it = gw; it < MR * 8; it += NGW) {
        const int t = it >> 3, slot = it & 7; const float* pr = P + (size_t)t * PLD;
        if (slot < 6) {
            const float* src = pr + (slot < 4 ? PC_Q + 128 * slot : PC_K + 128 * (slot - 4));
            const float* gg = qk_g + (slot < 4 ? 0 : 128);
            const int half = F.lane >> 5, i = F.lane & 31, d1 = 64 * half + i, d2 = d1 + 32;
            float e1 = src[d1], e2 = src[d2];
            const float r = rsqrtf(wave_sum(e1 * e1 + e2 * e2) * (1.0f / 128.0f) + EPS);
            e1 *= r * gg[d1]; e2 *= r * gg[d2];
            float o1 = e1, o2 = e2;
            if (t < TL) { const int pos = half ? (t & 63) : (t >> 6); const float cs = ROPE[pos * 32 + i], sn = ROPE[128 * 32 + pos * 32 + i]; o1 = e1 * cs - e2 * sn; o2 = e1 * sn + e2 * cs; }
            bf16* dst = (slot < 4) ? (QB + (size_t)t * 512 + 128 * slot) : (KB + (size_t)t * 256 + 128 * (slot - 4));
            dst[d1] = (bf16)f2bf(o1); dst[d2] = (bf16)f2bf(o2);
        } else {
            const float* src = pr + PC_V + 128 * (slot - 6); const f32x2 e = *(const f32x2*)(src + 2 * F.lane);
            *(unsigned*)(VB + (size_t)t * 256 + 128 * (slot - 6) + 2 * F.lane) = pk2(e.x, e.y);
        }
    }
}
__device__ __forceinline__ int chunk_ord(int d, int p) { return d ? (NCHUNK - 1 - p) : (p < 4 ? 128 + p : p - 4); }

__device__ __forceinline__ void lru_a(const Frame& F_, const float* __restrict__ P, const float* __restrict__ conv_w, const float* __restrict__ conv_b, const float* __restrict__ gate_w,
                                      const float* __restrict__ gate_b, const float* __restrict__ lam, float* __restrict__ HL, float* __restrict__ AC, float* __restrict__ ATOT, float* __restrict__ HEND) {
    const Frame F = fresh(F_);
    float* xs = (float*)(F.gl + RING_OFF);
    float* us = (float*)(F.gl + RING_OFF + 17408);
    float* as = (float*)(F.gl + RING_OFF + 34304);
    float* bs = (float*)(F.gl + RING_OFF + 67584);
    for (int item = F.bid; item < NCHUNK * 8; item += F.G) {
        const int n = item >> 3, hh = item & 7, t0 = n * 64, seg_lo = (n < 128) ? 0 : TL, seg_hi = (n < 128) ? TL : MR;
        __syncthreads();
        for (int e = F.tid; e < 67 * 64; e += 512) { const int r = e >> 6, cl = e & 63, t = t0 - 2 + r; xs[e] = (t >= seg_lo && t < seg_hi) ? P[(size_t)t * PLD + PC_LX + hh * 64 + cl] : 0.0f; }
        __syncthreads();
        for (int e = F.tid; e < 4096; e += 512) { const int tok = e >> 6, cl = e & 63, c = hh * 64 + cl; float u = conv_b[c];
#pragma unroll
            for (int j = 0; j < 4; ++j) u += conv_w[j * 512 + c] * xs[(tok + j) * 64 + cl];
            us[tok * 65 + cl] = u; }
        __syncthreads();
        { const int tok = F.lane, cg = F.wave; float acc[4][8];
#pragma unroll
          for (int a = 0; a < 4; ++a)
#pragma unroll
              for (int b = 0; b < 8; ++b) acc[a][b] = 0.f;
          for (int i = 0; i < 64; ++i) { const float uv = us[tok * 65 + i];
#pragma unroll
              for (int dg = 0; dg < 4; ++dg) { const float* wrow = gate_w + ((size_t)((dg * 8 + hh) * 64 + i)) * 64 + cg * 8;
#pragma unroll
                  for (int jj = 0; jj < 8; ++jj) acc[dg][jj] += uv * wrow[jj]; } }
#pragma unroll
          for (int d = 0; d < 2; ++d)
#pragma unroll
              for (int jj = 0; jj < 8; ++jj) { const int cl = cg * 8 + jj, c = hh * 64 + cl;
                  const float r = sigmoidf_(acc[d * 2 + 0][jj] + gate_b[(d * 2 + 0) * 512 + c]), ig = sigmoidf_(acc[d * 2 + 1][jj] + gate_b[(d * 2 + 1) * 512 + c]);
                  const float sp = log1pf(__expf(-lam[d * 512 + c])); const float la = -8.0f * r * sp;
                  as[(d * 64 + cl) * 65 + tok] = __expf(la); bs[(d * 64 + cl) * 65 + tok] = sqrtf(-expm1f(2.0f * la)) * (ig * us[tok * 65 + cl]); } }
        __syncthreads();
        if (F.tid < 128) { const int d = F.tid >> 6, cl = F.tid & 63, c = hh * 64 + cl; float h = 0.f, A = 1.f;
            for (int st = 0; st < 64; ++st) { const int tok = d ? 63 - st : st; const float a = as[(d * 64 + cl) * 65 + tok], b = bs[(d * 64 + cl) * 65 + tok];
                h = a * h + b; A *= a; const size_t o = ((size_t)d * MR + t0 + tok) * 512 + c; HL[o] = h; AC[o] = A; }
            ATOT[((size_t)d * NCHUNK + n) * 512 + c] = A; HEND[((size_t)d * NCHUNK + n) * 512 + c] = h; }
    }
}
__device__ __forceinline__ void lru_b(const Frame& F_, int b0, const float* __restrict__ ATOT, const float* __restrict__ HEND, float* __restrict__ CIN) {
    const Frame F = fresh(F_);
    for (int d = 0; d < 2; ++d) if (F.bid == ((b0 + d) % F.G)) {
        const int c = F.tid; float carry = 0.f;
        for (int p = 0; p < NCHUNK; p += 4) { float A[4], H[4];
#pragma unroll
            for (int k = 0; k < 4; ++k) { const int n = chunk_ord(d, p + k); A[k] = ATOT[((size_t)d * NCHUNK + n) * 512 + c]; H[k] = HEND[((size_t)d * NCHUNK + n) * 512 + c]; }
#pragma unroll
            for (int k = 0; k < 4; ++k) { const int n = chunk_ord(d, p + k); CIN[((size_t)d * NCHUNK + n) * 512 + c] = carry; carry = A[k] * carry + H[k]; } }
    }
}
__device__ __forceinline__ void gla_a(const Frame& F_, const float* __restrict__ P, const float* __restrict__ LR, const float* __restrict__ gw_, const float* __restrict__ gb_,
                                      float* __restrict__ BC, float* __restrict__ DS, float* __restrict__ DEC) {
    const Frame F = fresh(F_);
    float* lrs = (float*)(F.gl + RING_OFF);
    float* bc = (float*)(F.gl + RING_OFF + 8704);
    float* ks = (float*)(F.gl + RING_OFF + 41984);
    float* kout = (float*)(F.gl + RING_OFF + 58368);
    float* vs = (float*)(F.gl + RING_OFF + 91136);
    float* tots = (float*)(F.gl + RING_OFF + 123904);
    for (int item = F.bid; item < NCHUNK * 4; item += F.G) {
        const int n = item >> 2, hh = item & 3, t0 = n * 64;
        __syncthreads();
        for (int e = F.tid; e < 2048; e += 512) lrs[(e >> 5) * 33 + (e & 31)] = LR[(size_t)(t0 + (e >> 5)) * 32 + (e & 31)];
        for (int e = F.tid; e < 4096; e += 512) ks[e] = P[(size_t)(t0 + (e >> 6)) * PLD + PC_GK + hh * 64 + (e & 63)];
        for (int e = F.tid; e < 8192; e += 512) vs[e] = P[(size_t)(t0 + (e >> 7)) * PLD + PC_GV + hh * 128 + (e & 127)];
        __syncthreads();
        { const int tok = F.lane, d = F.wave >> 2, dk0 = (F.wave & 3) * 16;
#pragma unroll 4
          for (int jj = 0; jj < 16; ++jj) { const int dk = dk0 + jj, col = hh * 64 + dk; float z = gb_[d * 256 + col];
#pragma unroll
              for (int r = 0; r < 16; ++r) z += lrs[tok * 33 + 16 * d + r] * gw_[(d * 16 + r) * 256 + col];
              bc[(d * 64 + dk) * 65 + tok] = -(fmaxf(-z, 0.0f) + log1pf(__expf(-fabsf(z)))) * (1.0f / 16.0f); } }
        __syncthreads();
        if (F.tid < 128) { const int d = F.tid >> 6, dk = F.tid & 63; float run = 0.f;
            for (int st = 0; st < 64; ++st) { const int tok = d ? 63 - st : st; run += bc[(d * 64 + dk) * 65 + tok]; bc[(d * 64 + dk) * 65 + tok] = run;
                BC[((size_t)d * MR + t0 + tok) * 256 + hh * 64 + dk] = run; }
            tots[d * 64 + dk] = run; DEC[((size_t)(n * 4 + hh) * 2 + d) * 64 + dk] = __expf(run); }
        __syncthreads();
        for (int e = F.tid; e < 8192; e += 512) { const int d = e >> 12, s = (e >> 6) & 63, dk = e & 63; kout[e] = ks[s * 64 + dk] * __expf(tots[d * 64 + dk] - bc[(d * 64 + dk) * 65 + s]); }
        __syncthreads();
        { const int dv = F.tid & 127, dkg = F.tid >> 7; float acc[2][16];
#pragma unroll
          for (int d = 0; d < 2; ++d)
#pragma unroll
              for (int j = 0; j < 16; ++j) acc[d][j] = 0.f;
          for (int s = 0; s < 64; ++s) { const float vv = vs[s * 128 + dv];
#pragma unroll
              for (int d = 0; d < 2; ++d)
#pragma unroll
                  for (int j = 0; j < 16; ++j) acc[d][j] += kout[(d * 64 + s) * 64 + dkg * 16 + j] * vv; }
#pragma unroll
          for (int d = 0; d < 2; ++d)
#pragma unroll
              for (int j = 0; j < 16; ++j) DS[(((size_t)(n * 4 + hh) * 2 + d) * 64 + dkg * 16 + j) * 128 + dv] = acc[d][j]; }
    }
}
__device__ __forceinline__ void gla_b(const Frame& F_, const float* __restrict__ DS, const float* __restrict__ DEC, float* __restrict__ SP) {
    const Frame F = fresh(F_);
    const int rb = F.G - 1 - F.bid;
    for (int g = rb * 512 + F.tid; g < 4 * 2 * 64 * 128; g += F.G * 512) {
        const int dv = g & 127, dk = (g >> 7) & 63, d = (g >> 13) & 1, hh = g >> 14; float S = 0.f;
        for (int p = 0; p < NCHUNK; p += 4) { float dec[4], ds[4];
#pragma unroll
            for (int k = 0; k < 4; ++k) { const size_t idx = (size_t)(chunk_ord(d, p + k) * 4 + hh) * 2 + d; dec[k] = DEC[idx * 64 + dk]; ds[k] = DS[(idx * 64 + dk) * 128 + dv]; }
#pragma unroll
            for (int k = 0; k < 4; ++k) { const size_t idx = (size_t)(chunk_ord(d, p + k) * 4 + hh) * 2 + d; SP[(idx * 64 + dk) * 128 + dv] = S; S = dec[k] * S + ds[k]; } }
    }
}
__device__ __forceinline__ void gla_c(const Frame& F_, const float* __restrict__ P, const float* __restrict__ BC, const float* __restrict__ SP, const float* __restrict__ out_g, bf16* __restrict__ MIX) {
    const Frame F = fresh(F_);
    float* qt = (float*)(F.gl + RING_OFF);
    float* kin = (float*)(F.gl + RING_OFF + 16640);
    float* attm = (float*)(F.gl + RING_OFF + 33280);
    float* vs = (float*)(F.gl + RING_OFF + 49664);
    float* sps = (float*)(F.gl + RING_OFF + 82432);
    float* red = (float*)(F.gl + RING_OFF + 115200);
    for (int item = F.bid; item < NCHUNK * 4; item += F.G) {
        const int n = item >> 2, hh = item & 3, t0 = n * 64;
        const int dv = F.tid & 127, tokg = F.tid >> 7;
        float acc[16];
#pragma unroll
        for (int j = 0; j < 16; ++j) acc[j] = 0.f;
        __syncthreads();
        for (int e = F.tid; e < 8192; e += 512) vs[e] = P[(size_t)(t0 + (e >> 7)) * PLD + PC_GV + hh * 128 + (e & 127)];
        for (int d = 0; d < 2; ++d) {
            __syncthreads();
            for (int e = F.tid; e < 4096; e += 512) { const int tok = e >> 6, dk = e & 63; const float b = BC[((size_t)d * MR + t0 + tok) * 256 + hh * 64 + dk];
                const float q = P[(size_t)(t0 + tok) * PLD + PC_GQ + hh * 64 + dk], k = P[(size_t)(t0 + tok) * PLD + PC_GK + hh * 64 + dk];
                qt[tok * 65 + dk] = q * 0.125f * __expf(b); kin[tok * 65 + dk] = k * __expf(-b); }
            { const float* sp = SP + (((size_t)(n * 4 + hh) * 2 + d) * 64) * 128; for (int e = F.tid; e < 8192; e += 512) sps[e] = sp[e]; }
            __syncthreads();
            { const int s = F.lane, tg = F.wave; float a8[8];
#pragma unroll
              for (int j = 0; j < 8; ++j) a8[j] = 0.f;
              for (int dk = 0; dk < 64; ++dk) { const float kv = kin[s * 65 + dk];
#pragma unroll
                  for (int j = 0; j < 8; ++j) a8[j] += qt[(tg * 8 + j) * 65 + dk] * kv; }
#pragma unroll
              for (int j = 0; j < 8; ++j) { const int tok = tg * 8 + j; const bool keep = d ? (s >= tok) : (s <= tok); attm[tok * 64 + s] = keep ? a8[j] : 0.0f; } }
            __syncthreads();
            for (int s = 0; s < 64; ++s) { const float vv = vs[s * 128 + dv];
#pragma unroll
                for (int j = 0; j < 16; ++j) acc[j] += attm[(tokg * 16 + j) * 64 + s] * vv; }
            for (int dk = 0; dk < 64; ++dk) { const float sv = sps[dk * 128 + dv];
#pragma unroll
                for (int j = 0; j < 16; ++j) acc[j] += qt[(tokg * 16 + j) * 65 + dk] * sv; }
        }
#pragma unroll
        for (int j = 0; j < 16; ++j) { const float ss = wave_sum(acc[j] * acc[j]); if (F.lane == 0) red[(tokg * 16 + j) * 2 + (F.wave & 1)] = ss; }
        __syncthreads();
        const float og = out_g[dv];
#pragma unroll
        for (int j = 0; j < 16; ++j) { const int tok = tokg * 16 + j; const float ms = (red[tok * 2] + red[tok * 2 + 1]) * (1.0f / 128.0f); const float r = rsqrtf(ms + EPS);
            const float g = P[(size_t)(t0 + tok) * PLD + PC_GG + hh * 128 + dv];
            MIX[(size_t)(t0 + tok) * DM + 1024 + hh * 128 + dv] = (bf16)f2bf(acc[j] * r * og * siluf_(g)); }
    }
}
__device__ __forceinline__ void mix_finalize(const Frame& F_, const float* __restrict__ P, const float* __restrict__ HL, const float* __restrict__ AC, const float* __restrict__ CIN,
                                             const float* __restrict__ OP, const float* __restrict__ ML, const float* __restrict__ YF, bf16* __restrict__ MIX) {
    const Frame F = fresh(F_);
    const int gt = F.bid * 512 + F.tid, NGT = F.G * 512;
    for (int i = gt; i < MR * 128; i += NGT) { const int t = i >> 7, c = (i & 127) * 4, n = t >> 6; f32x4 h = {0.f, 0.f, 0.f, 0.f};
#pragma unroll
        for (int d = 0; d < 2; ++d) { const size_t o = ((size_t)d * MR + t) * 512 + c; h += *(const f32x4*)(HL + o) + *(const f32x4*)(AC + o) * *(const f32x4*)(CIN + ((size_t)d * NCHUNK + n) * 512 + c); }
        const f32x4 g = *(const f32x4*)(P + (size_t)t * PLD + PC_LG + c);
        u32x2 o; o.x = pk2(h.x * gelu_tanh_(g.x), h.y * gelu_tanh_(g.y)); o.y = pk2(h.z * gelu_tanh_(g.z), h.w * gelu_tanh_(g.w));
        *(u32x2*)(MIX + (size_t)t * DM + c) = o; }
    for (int i = gt; i < MR * 128; i += NGT) { const int t = i >> 7, h = (i >> 5) & 3, c = (i & 31) * 4; constexpr float C = att::SCALE * 1.4426950408889634f;
        const f32x4 o0 = *(const f32x4*)(OP + (size_t)t * 512 + h * 128 + c); const float m0 = ML[(size_t)t * 8 + h * 2], l0 = ML[(size_t)t * 8 + h * 2 + 1];
        f32x4 o;
        if (t < TL) { const f32x4 o1 = *(const f32x4*)(OP + ((size_t)MR + t) * 512 + h * 128 + c); const float m1 = ML[((size_t)MR + t) * 8 + h * 2], l1 = ML[((size_t)MR + t) * 8 + h * 2 + 1];
            const float M = fmaxf(m0, m1), w0 = __builtin_amdgcn_exp2f((m0 - M) * C), w1 = __builtin_amdgcn_exp2f((m1 - M) * C); const float inv = 1.0f / (l0 * w0 + l1 * w1);
            o = (o0 * w0 + o1 * w1) * inv; }
        else o = o0 * (1.0f / l0);
        u32x2 w; w.x = pk2(o.x, o.y); w.y = pk2(o.z, o.w); *(u32x2*)(MIX + (size_t)t * DM + 512 + h * 128 + c) = w; }
    for (int i = gt; i < MR * 128; i += NGT) { const int t = i >> 7, c = (i & 127) * 4; f32x4 y = *(const f32x4*)(YF + (size_t)t * 512 + c);
        if (t < TL) {
#pragma unroll
            for (int p = 1; p < 4; ++p) y += *(const f32x4*)(YF + ((size_t)p * MR + t) * 512 + c); }
        y = y * ((t < TL) ? (1.0f / 1024.0f) : 0.005524271728019903f);
        u32x2 w; w.x = pk2(y.x, y.y); w.y = pk2(y.z, y.w); *(u32x2*)(MIX + (size_t)t * DM + 1536 + c) = w; }
}

constexpr int PTR_OFF = MISC_OFF + 128;
__device__ __forceinline__ unsigned long long lds_ptr(const Frame& F, int i) {
    const unsigned long long v = *(volatile LAS unsigned long long*)(F.lds + PTR_OFF + 8 * i);
    const unsigned lo = __builtin_amdgcn_readfirstlane((unsigned)v), hi = __builtin_amdgcn_readfirstlane((unsigned)(v >> 32));
    return ((unsigned long long)hi << 32) | lo;
}
constexpr int NPHASE = 2 + 12 * NLAY + 1;
struct Args { const float* in[21]; float* out; unsigned char* ws; int ph_lo, ph_hi; };
static_assert(sizeof(Args) == 21 * 8 + 8 + 8 + 8, "Args has no padding");

__global__ void __launch_bounds__(NWAVES * 64, 2) fwd_kernel(Args args) {
    extern __shared__ __attribute__((aligned(16))) unsigned char lds[];
    Frame F;
    F.lds = (LAS unsigned char*)lds; F.gl = lds;
    F.MISC = (volatile LAS unsigned*)(F.lds + MISC_OFF);
    F.tid = threadIdx.x; F.lane = F.tid & 63; F.wave = __builtin_amdgcn_readfirstlane(F.tid >> 6);
    F.G = gridDim.x; F.bid = blockIdx.x;
    F.ctl = (gu32*)(args.ws + WS_CTL);
    for (int u = F.tid; u < (LDS_BYTES - LDSCTL_OFF) / 4; u += NWAVES * 64) ((LAS unsigned*)(F.lds + LDSCTL_OFF))[u] = 0u;
    __syncthreads();
    if (F.tid < 21) ((LAS unsigned long long*)(F.lds + PTR_OFF))[F.tid] = (unsigned long long)args.in[F.tid];
    if (F.tid == 21) ((LAS unsigned long long*)(F.lds + PTR_OFF))[21] = (unsigned long long)args.out;
    if (F.tid == 22) ((LAS unsigned long long*)(F.lds + PTR_OFF))[22] = (unsigned long long)args.ws;
    __syncthreads();
#define INP(i) ((const float*)lds_ptr(F, (i)))
#define WSL() ((unsigned char*)lds_ptr(F, 22))
#if MK_ONE_LAUNCH
    XcdBarrier bar = xcd_barrier_post((unsigned*)(F.ctl + CW_BAR), F.MISC + 8);
#define GRID_BAR() xcd_barrier(bar)
#else
#define GRID_BAR() do { } while (0)
#endif
    const int lo = args.ph_lo, hi = args.ph_hi;
#define IN(k) (lo <= (k) && (k) < hi)
#define SEAM(k) do { if (IN(k) && IN((k) + 1)) GRID_BAR(); } while (0)

    if (IN(0) || IN(1)) {
        In I; I.x = INP(0); I.c = INP(1); I.ctx = INP(2); I.c_ctx = INP(3); I.mod_w = INP(4); I.mod_b = INP(5); I.norm_g = INP(6); I.final_g = INP(7);
        I.ffn_w13 = INP(8); I.ffn_w2 = INP(9); I.w_in = INP(10); I.w_out = INP(11); I.lru_conv_w = INP(12); I.lru_conv_b = INP(13); I.lru_gate_w = INP(14);
        I.lru_gate_b = INP(15); I.lru_lambda = INP(16); I.attn_qk_g = INP(17); I.gla_gate_w = INP(18); I.gla_gate_b = INP(19); I.gla_out_g = INP(20);
        if (IN(0)) { prologue_a(F, I, WSL()); SEAM(0); }
        if (IN(1)) { prologue_b(F, I, WSL()); SEAM(1); }
    }

    for (int s = 0; s < 2 * NLAY; ++s) {
        const int l = s >> 1, f = s & 1, pb = 2 + 12 * l + 9 * f;
        { const int j = f ? 2 : 0;
          if (IN(pb)) { unsigned char* ws = WSL(); const float* modl = (const float*)(ws + WS_MODV) + (size_t)(l * 2 + 0) * 9 * DM; const float* modc = modl + 9 * DM;
              norm_phase(F, (const float*)(ws + WS_X), (bf16*)(ws + WS_XN), INP(6) + (size_t)(l * 3 + j) * DM, modl + (3 * j) * DM, modl + (3 * j + 1) * DM, modc + (3 * j) * DM, modc + (3 * j + 1) * DM); SEAM(pb); }
          if (IN(pb + 1)) { unsigned char* ws = WSL();
              pg8::Gemm g{(const bf16*)(ws + WS_XN), (const bf16*)(ws + WS_W13T) + (size_t)(l * 2 + f) * 2 * FF * DM, DM}; pg8::StaticOrder S; S.init(MR, 2 * FF, DM / 64, F.G, F.bid);
              pg8::EpiSwiGLU E{(bf16*)(ws + WS_H), FF};
              pg8::gemm_phase<pg8::EpiSwiGLU, pg8::StaticOrder, true, true>(F.lds + RING_OFF, g, S, E); SEAM(pb + 1); }
          if (IN(pb + 2)) { unsigned char* ws = WSL(); const float* modl = (const float*)(ws + WS_MODV) + (size_t)(l * 2 + 0) * 9 * DM;
              pg8::Gemm g{(const bf16*)(ws + WS_H), (const bf16*)(ws + WS_W2T) + (size_t)(l * 2 + f) * DM * FF, FF}; pg8::StaticOrder S; S.init(MR, DM, FF / 64, F.G, F.bid);
              pg8::EpiResid E{(float*)(ws + WS_X), DM, modl + (3 * j + 2) * DM, 9 * DM, 0.5f, TL / 256};
              pg8::gemm_phase<pg8::EpiResid, pg8::StaticOrder, true, true>(F.lds + RING_OFF, g, S, E); SEAM(pb + 2); } }
        if (f == 0) {
            const int mb = pb + 3;
            if (IN(mb)) { unsigned char* ws = WSL(); const float* modl = (const float*)(ws + WS_MODV) + (size_t)(l * 2 + 0) * 9 * DM; const float* modc = modl + 9 * DM;
                norm_phase(F, (const float*)(ws + WS_X), (bf16*)(ws + WS_XN), INP(6) + (size_t)(l * 3 + 1) * DM, modl + 3 * DM, modl + 4 * DM, modc + 3 * DM, modc + 4 * DM); SEAM(mb); }
            if (IN(mb + 1)) {
                unsigned char* ws = WSL();
                { pg8::Gemm g{(const bf16*)(ws + WS_XN), (const bf16*)(ws + WS_WINT) + (size_t)l * 4096 * DM, DM}; pg8::StaticOrder S; S.init(MR, 4096, DM / 64, F.G, F.bid);
                  pg8::EpiP E{(float*)(ws + WS_P), PLD, (bf16*)(ws + WS_UF)};
                  pg8::gemm_phase<pg8::EpiP, pg8::StaticOrder, true, true>(F.lds + RING_OFF, g, S, E); }
                lr_phase(F, (const bf16*)(ws + WS_XN), (const bf16*)(ws + WS_WLRT) + (size_t)l * 32 * DM, (float*)(ws + WS_LR));
                SEAM(mb + 1); }
            if (IN(mb + 2)) {
                { unsigned char* ws = WSL(); pg8::Gemm g{(const bf16*)(ws + WS_ADFT1), (const bf16*)(ws + WS_UF), 512}; pg8::StaticOrder S; S.init(1024, MR, 8, F.G, F.bid); pg8::EpiZT E{(bf16*)(ws + WS_ZT), (long)((WS_ZTC - WS_ZT) / 2)};
                  pg8::gemm_phase<pg8::EpiZT, pg8::StaticOrder, true, true>(F.lds + RING_OFF, g, S, E); }
                { unsigned char* ws = WSL(); qkv_prep(F, (const float*)(ws + WS_P), INP(17) + (size_t)l * 256, (const float*)(ws + WS_ROPE), (bf16*)(ws + WS_QB), (bf16*)(ws + WS_KB), (bf16*)(ws + WS_VB)); }
                { unsigned char* ws = WSL(); lru_a(F, (const float*)(ws + WS_P), INP(12) + (size_t)l * 4 * 512, INP(13) + (size_t)l * 512, INP(14) + (size_t)l * 2 * 2 * 8 * 64 * 64, INP(15) + (size_t)l * 2 * 2 * 512, INP(16) + (size_t)l * 2 * 512,
                        (float*)(ws + WS_HL), (float*)(ws + WS_AC), (float*)(ws + WS_ATOT), (float*)(ws + WS_HEND)); }
                { unsigned char* ws = WSL(); gla_a(F, (const float*)(ws + WS_P), (const float*)(ws + WS_LR), INP(18) + (size_t)l * 2 * 16 * 256, INP(19) + (size_t)l * 2 * 256, (float*)(ws + WS_BC), (float*)(ws + WS_DS), (float*)(ws + WS_DEC)); }
                SEAM(mb + 2); }
            if (IN(mb + 3)) {
                { unsigned char* ws = WSL(); const bf16* QB = (const bf16*)(ws + WS_QB); const bf16* KB = (const bf16*)(ws + WS_KB); const bf16* VB = (const bf16*)(ws + WS_VB); float* OP = (float*)(ws + WS_OP); float* ML = (float*)(ws + WS_ML);
                  int bid_ = F.bid; asm volatile("" : "+s"(bid_));
                  for (int L = bid_; L < 260; L += F.G) {
                    const bf16 *q, *k, *v; float *o, *ml; int seq;
                    if (L < 256) { const int xcd = L & 7, j = L >> 3, combo = xcd >> 1, kvh = combo >> 1, sp = combo & 1, idx = (xcd & 1) * 32 + j, h = kvh * 2 + (idx >> 5), qb = idx & 31;
                        q = QB + (size_t)(qb * 256) * 512 + h * 128; k = KB + (size_t)(sp * 4224) * 256 + kvh * 128; v = VB + (size_t)(sp * 4224) * 256 + kvh * 128;
                        o = OP + ((size_t)sp * MR + qb * 256) * 512 + h * 128; ml = ML + ((size_t)sp * MR + qb * 256) * 8 + h * 2; seq = 4224; }
                    else { const int h = L - 256, kvh = h >> 1;
                        q = QB + (size_t)TL * 512 + h * 128; k = KB + (size_t)TL * 256 + kvh * 128; v = VB + (size_t)TL * 256 + kvh * 128;
                        o = OP + (size_t)TL * 512 + h * 128; ml = ML + (size_t)TL * 8 + h * 2; seq = TCX; }
                    __syncthreads();
                    att::attn_unit(q, k, v, o, ml, seq, (char*)lds + RING_OFF);
                  }
                  __syncthreads(); }
                { unsigned char* ws = WSL(); pg8::Gemm g{(const bf16*)(ws + WS_ADFT), (const bf16*)(ws + WS_ZT), 16384}; pg8::SplitOrder S; S.init(TL, 512, 4, 64, F.G, F.bid); pg8::EpiYF E{(float*)(ws + WS_YF), 0, (size_t)MR * 512};
                  pg8::gemm_phase<pg8::EpiYF, pg8::SplitOrder, true, true>(F.lds + RING_OFF, g, S, E); }
                { unsigned char* ws = WSL(); pg8::Gemm g{(const bf16*)(ws + WS_ADFTC), (const bf16*)(ws + WS_ZTC), 512}; pg8::SplitOrder S; S.init(TCX, 512, 1, 8, F.G, F.bid); pg8::EpiYF E{(float*)(ws + WS_YF), TL, (size_t)MR * 512};
                  pg8::gemm_phase<pg8::EpiYF, pg8::SplitOrder, true, true>(F.lds + RING_OFF, g, S, E); }
                { unsigned char* ws = WSL(); lru_b(F, 64, (const float*)(ws + WS_ATOT), (const float*)(ws + WS_HEND), (float*)(ws + WS_CIN)); }
                { unsigned char* ws = WSL(); gla_b(F, (const float*)(ws + WS_DS), (const float*)(ws + WS_DEC), (float*)(ws + WS_SP)); }
                SEAM(mb + 3); }
            if (IN(mb + 4)) {
                { unsigned char* ws = WSL(); gla_c(F, (const float*)(ws + WS_P), (const float*)(ws + WS_BC), (const float*)(ws + WS_SP), INP(20) + (size_t)l * 128, (bf16*)(ws + WS_MIX)); }
                { unsigned char* ws = WSL(); mix_finalize(F, (const float*)(ws + WS_P), (const float*)(ws + WS_HL), (const float*)(ws + WS_AC), (const float*)(ws + WS_CIN), (const float*)(ws + WS_OP), (const float*)(ws + WS_ML), (const float*)(ws + WS_YF), (bf16*)(ws + WS_MIX)); }
                SEAM(mb + 4); }
            if (IN(mb + 5)) {
                unsigned char* ws = WSL(); const float* modl = (const float*)(ws + WS_MODV) + (size_t)(l * 2 + 0) * 9 * DM;
                pg8::Gemm g{(const bf16*)(ws + WS_MIX), (const bf16*)(ws + WS_WOUTT) + (size_t)l * DM * DM, DM}; pg8::StaticOrder S; S.init(MR, DM, DM / 64, F.G, F.bid);
                pg8::EpiResid E{(float*)(ws + WS_X), DM, modl + 5 * DM, 9 * DM, 1.0f, TL / 256};
                pg8::gemm_phase<pg8::EpiResid, pg8::StaticOrder, true, true>(F.lds + RING_OFF, g, S, E); SEAM(mb + 5); }
        }
    }
    if (IN(NPHASE - 1)) { unsigned char* ws = WSL(); final_norm(F, (const float*)(ws + WS_X), (float*)lds_ptr(F, 21), INP(7)); }
#undef IN
#undef SEAM
}

extern "C" void kernel_launch(void* const* d_in, const int* in_sizes, int n_in, void* d_out, int out_size, void* d_ws, size_t ws_size, hipStream_t stream) {
    static int grid = 0;
    if (grid == 0) {
        if (n_in != 21 || in_sizes[0] != TL * DM || out_size != TL * DM || ws_size < WS_END) {
            fprintf(stderr, "kernel_launch: unexpected shapes: n_in %d in0 %d out %d ws %zu (need %zu); nothing launched\n", n_in, n_in > 0 ? in_sizes[0] : -1, out_size, ws_size, (size_t)WS_END); grid = -1; return; }
        int dev = 0, cus = 0, per_cu = 0;
        if (hipGetDevice(&dev) != hipSuccess || hipDeviceGetAttribute(&cus, hipDeviceAttributeMultiprocessorCount, dev) != hipSuccess) { fprintf(stderr, "kernel_launch: device query failed\n"); grid = -1; return; }
        if (hipFuncSetAttribute((const void*)fwd_kernel, hipFuncAttributeMaxDynamicSharedMemorySize, LDS_BYTES) != hipSuccess) { fprintf(stderr, "kernel_launch: hipFuncSetAttribute failed\n"); grid = -1; return; }
        if (hipOccupancyMaxActiveBlocksPerMultiprocessor(&per_cu, (const void*)fwd_kernel, NWAVES * 64, LDS_BYTES) != hipSuccess || per_cu < 1)
            fprintf(stderr, "kernel_launch: note: occupancy query reports %d workgroups per CU\n", per_cu);
        (void)hipGetLastError();
        grid = cus;
    }
    if (grid < 0) return;
    if (hipMemsetAsync((char*)d_ws + WS_CTL, 0, CTL_ZERO_BYTES, stream) != hipSuccess) { fprintf(stderr, "kernel_launch: memset failed\n"); return; }
    Args a{};
    for (int i = 0; i < 21; ++i) a.in[i] = (const float*)d_in[i];
    a.out = (float*)d_out; a.ws = (unsigned char*)d_ws;
#if MK_ONE_LAUNCH
    a.ph_lo = 0; a.ph_hi = NPHASE;
    hipLaunchKernelGGL(fwd_kernel, dim3(grid), dim3(NWAVES * 64), LDS_BYTES, stream, a);
#else
    for (int ph = 0; ph < NPHASE; ++ph) { a.ph_lo = ph; a.ph_hi = ph + 1; hipLaunchKernelGGL(fwd_kernel, dim3(grid), dim3(NWAVES * 64), LDS_BYTES, stream, a); }
#endif
    const hipError_t le = hipPeekAtLastError();
    if (le != hipSuccess) fprintf(stderr, "kernel_launch: launch failed: %s\n", hipGetErrorName(le));
}
```

```cpp
#include <hip/hip_runtime.h>
#include <cstdio>
#include <cstdint>

#ifndef MK_ONE_LAUNCH
#define MK_ONE_LAUNCH 1
#endif

constexpr int DM = 2048, TL = 8192, TCX = 256, MR = TL + TCX, FF = 5632, NLAY = 4, DIN = 4128, NCHUNK = MR / 64;
constexpr int PLD = 3584;
constexpr int PC_LX = 0, PC_LG = 512, PC_Q = 1024, PC_K = 1536, PC_V = 1792, PC_GQ = 2048, PC_GK = 2304, PC_GV = 2560, PC_GG = 3072;
constexpr float EPS = 1e-6f;

constexpr size_t al256(size_t x) { return (x + 255) / 256 * 256; }
constexpr size_t WS_CTL = 0, CTL_ZERO_BYTES = 1u << 20;
constexpr size_t WS_MODV = WS_CTL + CTL_ZERO_BYTES;
constexpr size_t WS_W13T = al256(WS_MODV + (size_t)NLAY * 2 * 9 * DM * 4);
constexpr size_t WS_W2T  = al256(WS_W13T + (size_t)8 * 2 * FF * DM * 2);
constexpr size_t WS_WINT = al256(WS_W2T + (size_t)8 * DM * FF * 2);
constexpr size_t WS_WLRT = al256(WS_WINT + (size_t)4 * 4096 * DM * 2);
constexpr size_t WS_WOUTT = al256(WS_WLRT + (size_t)4 * 32 * DM * 2);
constexpr size_t WS_DA = al256(WS_WOUTT + (size_t)4 * DM * DM * 2);
constexpr size_t WS_DB = al256(WS_DA + (size_t)128 * 128 * 2);
constexpr size_t WS_AT = al256(WS_DB + (size_t)128 * 256 * 2);
constexpr size_t WS_ADFTC = al256(WS_AT + (size_t)64 * 2 * 512 * 128 * 2);
constexpr size_t WS_ADFT1 = al256(WS_ADFTC + (size_t)TCX * 2 * TCX * 2);
constexpr size_t WS_ROPE = al256(WS_ADFT1 + (size_t)1024 * 512 * 2);
constexpr size_t WS_X = al256(WS_ROPE + (size_t)2 * 128 * 32 * 4);
constexpr size_t WS_XN = al256(WS_X + (size_t)MR * DM * 4);
constexpr size_t WS_H = al256(WS_XN + (size_t)MR * DM * 2);
constexpr size_t WS_P = al256(WS_H + (size_t)MR * FF * 2);
constexpr size_t WS_UF = al256(WS_P + (size_t)MR * PLD * 4);
constexpr size_t WS_LR = al256(WS_UF + (size_t)MR * 512 * 2);
constexpr size_t WS_QB = al256(WS_LR + (size_t)MR * 32 * 4);
constexpr size_t WS_KB = al256(WS_QB + (size_t)MR * 512 * 2);
constexpr size_t WS_VB = al256(WS_KB + (size_t)MR * 256 * 2);
constexpr size_t WS_OP = al256(WS_VB + (size_t)MR * 256 * 2);
constexpr size_t WS_ML = al256(WS_OP + (size_t)2 * MR * 512 * 4);
constexpr size_t WS_HL = al256(WS_ML + (size_t)2 * MR * 4 * 2 * 4);
constexpr size_t WS_AC = al256(WS_HL + (size_t)2 * MR * 512 * 4);
constexpr size_t WS_ATOT = al256(WS_AC + (size_t)2 * MR * 512 * 4);
constexpr size_t WS_HEND = al256(WS_ATOT + (size_t)2 * NCHUNK * 512 * 4);
constexpr size_t WS_CIN = al256(WS_HEND + (size_t)2 * NCHUNK * 512 * 4);
constexpr size_t WS_BC = al256(WS_CIN + (size_t)2 * NCHUNK * 512 * 4);
constexpr size_t WS_DS = al256(WS_BC + (size_t)2 * MR * 256 * 4);
constexpr size_t WS_SP = al256(WS_DS + (size_t)NCHUNK * 4 * 2 * 64 * 128 * 4);
constexpr size_t WS_DEC = al256(WS_SP + (size_t)NCHUNK * 4 * 2 * 64 * 128 * 4);
constexpr size_t WS_ZT = al256(WS_DEC + (size_t)NCHUNK * 4 * 2 * 64 * 4);
constexpr size_t WS_ZTC = al256(WS_ZT + (size_t)512 * 16384 * 2);
constexpr size_t WS_YF = al256(WS_ZTC + (size_t)512 * 512 * 2);
constexpr size_t WS_MIX = al256(WS_YF + (size_t)4 * MR * 512 * 4);
constexpr size_t WS_CP = al256(WS_MIX + (size_t)MR * DM * 2);
constexpr size_t WS_PP = al256(WS_CP + (size_t)11 * TCX * DM * 4);
constexpr size_t WS_WGT = al256(WS_PP + (size_t)8 * TCX * 4096 * 4);
constexpr size_t WS_END = al256(WS_WGT + (size_t)4 * 32 * 4096 * 2);

constexpr int CW_TMO = 0, CW_CODE = 1, CW_BAR = 4096;

constexpr int RING_OFF = 0, RING_BYTES = 131072;
constexpr int LDSCTL_OFF = RING_BYTES, MISC_OFF = LDSCTL_OFF + 320;
constexpr int LDS_BYTES = 147456;
constexpr int NWAVES = 8;

#define GAS __attribute__((address_space(1)))
#define LAS __attribute__((address_space(3)))
typedef unsigned short bf16;
typedef float f32x4 __attribute__((ext_vector_type(4)));
typedef float f32x2 __attribute__((ext_vector_type(2)));
typedef unsigned u32x4 __attribute__((ext_vector_type(4)));
typedef unsigned u32x2 __attribute__((ext_vector_type(2)));
typedef GAS unsigned gu32;
#define RLX_AGENT __ATOMIC_RELAXED, __HIP_MEMORY_SCOPE_AGENT
#define LDS_WAIT() asm volatile("s_waitcnt lgkmcnt(0)" ::: "memory")
#define VM_WAIT() asm volatile("s_waitcnt vmcnt(0)" ::: "memory")
__device__ __forceinline__ unsigned f2bf(float f) { unsigned u = __builtin_bit_cast(unsigned, f); return (u + 0x7fffu + ((u >> 16) & 1u)) >> 16; }
__device__ __forceinline__ unsigned pk2(float lo, float hi) { return f2bf(lo) | (f2bf(hi) << 16); }
__device__ __forceinline__ int lane_id() { return (int)__builtin_amdgcn_mbcnt_hi(~0u, __builtin_amdgcn_mbcnt_lo(~0u, 0u)); }
__device__ __forceinline__ float wave_sum(float v) {
#pragma unroll
    for (int o = 1; o < 64; o <<= 1) v += __shfl_xor(v, o);
    return v;
}
__device__ __forceinline__ float sigmoidf_(float x) { return __builtin_amdgcn_rcpf(1.0f + __expf(-x)); }
__device__ __forceinline__ float siluf_(float x) { return x * __builtin_amdgcn_rcpf(1.0f + __expf(-x)); }
__device__ __forceinline__ float gelu_tanh_(float x) { const float u = 0.7978845608028654f * (x + 0.044715f * x * x * x); return x * __builtin_amdgcn_rcpf(1.0f + __expf(-2.0f * u)); }
__device__ __forceinline__ float one_minus_exp_(float x) {
    const float ser = -x * (1.0f + 0.5f * x * (1.0f + (1.0f / 3.0f) * x * (1.0f + 0.25f * x * (1.0f + 0.2f * x * (1.0f + (1.0f / 6.0f) * x)))));
    return (x > -0.5f) ? ser : (1.0f - __expf(x)); }
__device__ __forceinline__ int first_item(int bid, int G, int off) { int r = (bid - off) % G; return r < 0 ? r + G : r; }

namespace pg8 {
#define PG8_LAS __attribute__((address_space(3)))
#define PG8_GAS __attribute__((address_space(1)))
typedef unsigned short bf16_t;
typedef short bf16x8 __attribute__((ext_vector_type(8)));
typedef float f32x4 __attribute__((ext_vector_type(4)));
typedef unsigned u32x4 __attribute__((ext_vector_type(4)));
constexpr int BM = 256, BK = 64, HALF = 128, HTB = HALF * BK * 2  , STAGE_BYTES = 8 * HTB, NXCD = 8, WGM = 8;

__host__ __device__ __forceinline__ int lds_byte(int r, int c) { const int st = (r >> 4) * 2 + (c >> 5), rr = r & 15, cc = c & 31, ob = rr * 64 + cc * 2; return st * 1024 + (ob ^ (((ob >> 9) & 1) << 5)); }
__host__ __device__ __forceinline__ void stage_rc(int b, int& R, int& C) { const int st = b / 1024, sb = b % 1024, swz = sb ^ (((sb >> 9) & 1) << 5); R = (st >> 1) * 16 + swz / 64; C = (st & 1) * 32 + (swz % 64) / 2; }
__host__ __device__ __forceinline__ int perm32(int rho) { const int n = rho >> 4, i = rho & 15; return 8 * (i >> 2) + 4 * n + (i & 3); }

struct Unit { int pm, pn, kt0, nt; };
struct Gemm { const bf16_t* A; const bf16_t* Bt; int K; };

struct StaticOrder {
    int nM, nN, nwg, G, c, nt;
    __host__ __device__ void init(int M, int N, int nt_, int G_, int c_) { nM = M / BM; nN = N / BM; nwg = nM * nN; G = G_; c = c_; nt = nt_; }
    __host__ __device__ bool next(int i, Unit& u) const {
        const long L = (long)i * G + c; if (L >= nwg) return false;
        int wgid = (int)L; { const int q = nwg / NXCD, r = nwg % NXCD, xcd = wgid % NXCD, off = wgid / NXCD; wgid = (xcd < r ? xcd * (q + 1) : r * (q + 1) + (xcd - r) * q) + off; }
        const int nig = WGM * nN, gid = wgid / nig, fm = gid * WGM, gsz = (nM - fm) < WGM ? (nM - fm) : WGM;
        u.pm = fm + ((wgid % nig) % gsz); u.pn = (wgid % nig) / gsz; u.kt0 = 0; u.nt = nt; return true;
    }
    __device__ __forceinline__ void a_ready(const Unit&) const {}
    __device__ __forceinline__ void done(const Unit&) const {}
};
struct SplitOrder {
    int nM, nN, nS, total, G, c, nt;
    __host__ __device__ void init(int M, int N, int nS_, int nt_, int G_, int c_) { nM = M / BM; nN = N / BM; nS = nS_; total = nM * nN * nS; G = G_; c = c_; nt = nt_; }
    __host__ __device__ bool next(int i, Unit& u) const {
        const long L = (long)i * G + c; if (L >= total) return false;
        const int l = (int)L; u.pm = l % nM; const int r = l / nM; u.pn = r % nN; u.kt0 = (r / nN) * nt; u.nt = nt; return true;
    }
    __device__ __forceinline__ void a_ready(const Unit&) const {}
    __device__ __forceinline__ void done(const Unit&) const {}
};

struct LatCtxOrder {
    StaticOrder lat; int nNc, nmini, ntm, cpm;
    __host__ __device__ void init(int Mlat, int N, int nt_, int nslices, int G_, int c_) { lat.init(Mlat, N, nt_, G_, c_); nNc = N / BM; ntm = nt_ / nslices; nmini = nNc * nslices; cpm = Mlat / BM; }
    __host__ __device__ bool next(int i, Unit& u) const {
        if (lat.next(i, u)) return true;
        const long m = (long)i * lat.G + lat.c - lat.nwg; if (m < 0 || m >= nmini) return false;
        u.pm = cpm; u.pn = (int)m % nNc; u.kt0 = ((int)m / nNc) * ntm; u.nt = ntm; return true;
    }
    __device__ __forceinline__ void a_ready(const Unit&) const {}
    __device__ __forceinline__ void done(const Unit&) const {}
};

__device__ __forceinline__ unsigned cvt_pk_bf16(float lo, float hi) { unsigned r; asm volatile("v_cvt_pk_bf16_f32 %0, %1, %2" : "=v"(r) : "v"(lo), "v"(hi)); return r; }


struct EpiSwiGLU {
    static constexpr bool PERM = true, AFTER_DRAIN = false;
    bf16_t* H; int ldh;
    __device__ __forceinline__ void operator()(const f32x4 (&acc)[2][2][4][2], const Unit& u, int wr, int wc, int fr, int fq) const {
        const int row0 = u.pm * BM + wr * 64 + fr, col0 = u.pn * HALF + wc * 32 + 8 * fq;
#pragma unroll
        for (int ai = 0; ai < 2; ++ai)
#pragma unroll
            for (int m = 0; m < 4; ++m) { bf16_t* rowp = H + (size_t)(row0 + ai * HALF + m * 16) * ldh + col0;
                float o[8];
#pragma unroll
                for (int n = 0; n < 2; ++n)
#pragma unroll
                    for (int i = 0; i < 4; ++i) { const float gt = acc[ai][0][m][n][i], up = acc[ai][1][m][n][i]; o[4 * n + i] = gt * __builtin_amdgcn_rcpf(1.0f + __expf(-gt)) * up; }
                u32x4 w; w.x = cvt_pk_bf16(o[0], o[1]); w.y = cvt_pk_bf16(o[2], o[3]); w.z = cvt_pk_bf16(o[4], o[5]); w.w = cvt_pk_bf16(o[6], o[7]);
                *(PG8_GAS u32x4*)rowp = w; }
    }
};
template <bool FIRST>
struct EpiResid {
    static constexpr bool PERM = true, AFTER_DRAIN = false;
    float* X; const float* Xin; int ldx; const float* gl; float coef; int ctx_pm; long cp_delta;
    __device__ __forceinline__ void operator()(const f32x4 (&acc)[2][2][4][2], const Unit& u, int wr, int wc, int fr, int fq) const {
        const int col0 = u.pn * BM + wc * 32 + 8 * fq;
        if (u.pm == ctx_pm) {
            float* base = X + cp_delta + (size_t)(u.kt0 / u.nt) * 256 * ldx + (size_t)(wr * 64 + fr) * ldx + col0;
#pragma unroll
            for (int ai = 0; ai < 2; ++ai)
#pragma unroll
                for (int m = 0; m < 4; ++m) { float* rowp = base + (size_t)(ai * HALF + m * 16) * ldx;
#pragma unroll
                    for (int bj = 0; bj < 2; ++bj)
#pragma unroll
                        for (int n = 0; n < 2; ++n) *(PG8_GAS f32x4*)(rowp + bj * HALF + n * 4) = acc[ai][bj][m][n]; }
            return; }
        const int row0 = u.pm * BM + wr * 64 + fr;
        const float* gate = gl;
        f32x4 gv[2][2];
#pragma unroll
        for (int bj = 0; bj < 2; ++bj)
#pragma unroll
            for (int n = 0; n < 2; ++n) gv[bj][n] = *(const PG8_GAS f32x4*)(gate + col0 + bj * HALF + n * 4) * coef;
        constexpr int MB = FIRST ? 2 : 4;
#pragma unroll
        for (int aim = 0; aim < 2 * (4 / MB); ++aim) { const int ai = aim / (4 / MB), m0 = (aim % (4 / MB)) * MB;
            u32x4 p[4][2]; f32x4 q[4][2][2];
#pragma unroll
            for (int m = m0; m < m0 + MB; ++m) { const size_t ro = (size_t)(row0 + ai * HALF + m * 16) * ldx + col0; const bf16_t* rowp = (const bf16_t*)X + ro; const float* rowi = Xin + ro;
#pragma unroll
                for (int bj = 0; bj < 2; ++bj) {
                    if (FIRST) { q[m][bj][0] = *(const PG8_GAS f32x4*)(rowi + bj * HALF); q[m][bj][1] = *(const PG8_GAS f32x4*)(rowi + bj * HALF + 4); }
                    else p[m][bj] = *(const PG8_GAS u32x4*)(rowp + bj * HALF); } }
#pragma unroll
            for (int m = m0; m < m0 + MB; ++m) { const size_t ro = (size_t)(row0 + ai * HALF + m * 16) * ldx + col0; bf16_t* rowp = (bf16_t*)X + ro;
#pragma unroll
                for (int bj = 0; bj < 2; ++bj) { f32x4 o0, o1;
                    if (FIRST) { o0 = q[m][bj][0]; o1 = q[m][bj][1]; }
                    else { const u32x4 pp = p[m][bj];
                        o0[0] = __builtin_bit_cast(float, pp.x << 16); o0[1] = __builtin_bit_cast(float, pp.x & 0xffff0000u); o0[2] = __builtin_bit_cast(float, pp.y << 16); o0[3] = __builtin_bit_cast(float, pp.y & 0xffff0000u);
                        o1[0] = __builtin_bit_cast(float, pp.z << 16); o1[1] = __builtin_bit_cast(float, pp.z & 0xffff0000u); o1[2] = __builtin_bit_cast(float, pp.w << 16); o1[3] = __builtin_bit_cast(float, pp.w & 0xffff0000u); }
                    o0 += gv[bj][0] * acc[ai][bj][m][0]; o1 += gv[bj][1] * acc[ai][bj][m][1];
                    u32x4 w; w.x = cvt_pk_bf16(o0[0], o0[1]); w.y = cvt_pk_bf16(o0[2], o0[3]); w.z = cvt_pk_bf16(o1[0], o1[1]); w.w = cvt_pk_bf16(o1[2], o1[3]); *(PG8_GAS u32x4*)(rowp + bj * HALF) = w; } }
            asm volatile("" ::: "memory"); }
    }
};
struct EpiP {
    static constexpr bool PERM = false, AFTER_DRAIN = false;
    float* P; int ldp; bf16_t* UF; long pp_delta; int ctx_pm;
    __device__ __forceinline__ void operator()(const f32x4 (&acc)[2][2][4][2], const Unit& u, int wr, int wc, int fr, int fq) const {
        const int row0 = u.pm * BM + wr * 64 + fr;
        if (u.pm == ctx_pm) {
            float* base = P + pp_delta + (size_t)(u.kt0 / u.nt) * 256 * 4096 + (size_t)(wr * 64 + fr) * 4096 + u.pn * BM + wc * 32 + 4 * fq;
#pragma unroll
            for (int ai = 0; ai < 2; ++ai)
#pragma unroll
                for (int m = 0; m < 4; ++m) { float* rowp = base + (size_t)(ai * HALF + m * 16) * 4096;
#pragma unroll
                    for (int bj = 0; bj < 2; ++bj)
#pragma unroll
                        for (int n = 0; n < 2; ++n) *(PG8_GAS f32x4*)(rowp + bj * HALF + n * 16) = acc[ai][bj][m][n]; }
        } else if (u.pn < 14) {
            const int col0 = u.pn * BM + wc * 32 + 4 * fq;
#pragma unroll
            for (int ai = 0; ai < 2; ++ai)
#pragma unroll
                for (int m = 0; m < 4; ++m) { float* rowp = P + (size_t)(row0 + ai * HALF + m * 16) * ldp + col0;
#pragma unroll
                    for (int bj = 0; bj < 2; ++bj)
#pragma unroll
                        for (int n = 0; n < 2; ++n) *(PG8_GAS f32x4*)(rowp + bj * HALF + n * 16) = acc[ai][bj][m][n]; }
        } else {
            const int col0 = (u.pn - 14) * BM + wc * 32 + 4 * fq;
#pragma unroll
            for (int ai = 0; ai < 2; ++ai)
#pragma unroll
                for (int m = 0; m < 4; ++m) { const int rr = row0 + ai * HALF + m * 16; bf16_t* rowp = UF + (size_t)(((rr & 127) << 6) | (rr >> 7)) * 512 + col0;
#pragma unroll
                    for (int bj = 0; bj < 2; ++bj)
#pragma unroll
                        for (int n = 0; n < 2; ++n) { const f32x4 v = acc[ai][bj][m][n]; u32x2 w; w.x = cvt_pk_bf16(v[0], v[1]); w.y = cvt_pk_bf16(v[2], v[3]); *(PG8_GAS u32x2*)(rowp + bj * HALF + n * 16) = w; } }
        }
    }
};
struct EpiZT {
    static constexpr bool PERM = true, AFTER_DRAIN = false;
    bf16_t* ZT; long ztc_delta;
    __device__ __forceinline__ void operator()(const f32x4 (&acc)[2][2][4][2], const Unit& u, int wr, int wc, int fr, int fq) const {
        const int row0 = u.pm * BM + wr * 64 + fr; const bool ctx = (u.pn == 32);
        const int col0 = (ctx ? 0 : u.pn * BM) + wc * 32 + 8 * fq;
#pragma unroll
        for (int ai = 0; ai < 2; ++ai)
#pragma unroll
            for (int m = 0; m < 4; ++m) { const int r = row0 + ai * HALF + m * 16, cs = r >> 9, j = r & 511;
#pragma unroll
                for (int bj = 0; bj < 2; ++bj) { const int np = col0 + bj * HALF;
                    bf16_t* rowp = ZT + (ctx ? (ztc_delta + (long)j * 512 + cs * 256 + np) : ((((long)cs * 128 + (np >> 6)) * 512 + j) * 64 + (np & 63))) - bj * HALF; const f32x4 v0 = acc[ai][bj][m][0], v1 = acc[ai][bj][m][1];
                    u32x4 w; w.x = cvt_pk_bf16(v0[0], v0[1]); w.y = cvt_pk_bf16(v0[2], v0[3]); w.z = cvt_pk_bf16(v1[0], v1[1]); w.w = cvt_pk_bf16(v1[2], v1[3]);
                    *(PG8_GAS u32x4*)(rowp + bj * HALF) = w; } }
    }
};
struct EpiYF {
    static constexpr bool PERM = false, AFTER_DRAIN = false;
    float* YF; int row_off; size_t part_stride;
    __device__ __forceinline__ void operator()(const f32x4 (&acc)[2][2][4][2], const Unit& u, int wr, int wc, int fr, int fq) const {
        const int row0 = row_off + u.pm * BM + wr * 64 + fr, col0 = u.pn * BM + wc * 32 + 4 * fq;
        float* base = YF + (size_t)(u.kt0 / u.nt) * part_stride;
#pragma unroll
        for (int ai = 0; ai < 2; ++ai)
#pragma unroll
            for (int m = 0; m < 4; ++m) { float* rowp = base + (size_t)(row0 + ai * HALF + m * 16) * 512 + col0;
#pragma unroll
                for (int bj = 0; bj < 2; ++bj)
#pragma unroll
                    for (int n = 0; n < 2; ++n) *(PG8_GAS f32x4*)(rowp + bj * HALF + n * 16) = acc[ai][bj][m][n]; }
    }
};

template <class Epi, class Sched, bool ALIGN_EPI = false, bool SP2 = false>
__device__ __forceinline__ void gemm_phase(PG8_LAS unsigned char* lds, const Gemm g, const Sched& S, const Epi& E, const int wave_id) {
    int tid_ = wave_id * 64 + lane_id(); asm volatile("" : "+v"(tid_));
    const int tid = tid_, wid = __builtin_amdgcn_readfirstlane(tid >> 6), lane = tid & 63, wr = wid >> 2, wc = wid & 3, fr = lane & 15, fq = lane >> 4;
    const int K = g.K;
    unsigned voffA[2], voffB[2];
#pragma unroll
    for (int i = 0; i < 2; ++i) { int R, C; stage_rc(tid * 16 + i * 8192, R, C); const int Rb = Epi::PERM ? ((R & ~31) + perm32(R & 31)) : R;
        voffA[i] = (unsigned)(R * K + C) * 2u; voffB[i] = (unsigned)(Rb * K + C) * 2u; }
    const size_t kstep = (size_t)(BK * 2);
    const size_t hstep = (size_t)HALF * K * 2;
    const size_t tstep = 2 * hstep;
    const unsigned ldsw = (unsigned)wid * 1024u;
    const int aoff = lds_byte(wr * 64 + fr, fq * 8), boff = lds_byte(wc * 32 + fr, fq * 8);
#define PG8_SA(b, h) (((b) * 2 + (h)) * HTB)
#define PG8_SB(b, h) ((4 + (b) * 2 + (h)) * HTB)
#define PG8_STAGE(bufoff, gbase, voff) do { _Pragma("unroll") for (int _i = 0; _i < 2; ++_i) \
        __builtin_amdgcn_global_load_lds((const unsigned*)((const char*)(gbase) + (voff)[_i]), (PG8_LAS unsigned*)(lds + (bufoff) + ldsw + _i * 8192), 16, 0, 0); } while (0)
#define PG8_LDA(dst, b, h) do { _Pragma("unroll") for (int m = 0; m < 4; ++m) _Pragma("unroll") for (int k = 0; k < 2; ++k) dst[m][k] = *(const PG8_LAS bf16x8*)(lds + PG8_SA(b, h) + aoff + m * 2048 + k * 1024); } while (0)
#define PG8_LDB(dst, b, h) do { _Pragma("unroll") for (int n = 0; n < 2; ++n) _Pragma("unroll") for (int k = 0; k < 2; ++k) dst[n][k] = *(const PG8_LAS bf16x8*)(lds + PG8_SB(b, h) + boff + n * 2048 + k * 1024); } while (0)
#define PG8_MMA(ai, bj, At, Bt) do { __builtin_amdgcn_s_setprio(1); _Pragma("unroll") for (int m = 0; m < 4; ++m) _Pragma("unroll") for (int n = 0; n < 2; ++n) _Pragma("unroll") for (int k = 0; k < 2; ++k) \
        acc[ai][bj][m][n] = __builtin_amdgcn_mfma_f32_16x16x32_bf16(Bt[n][k], At[m][k], acc[ai][bj][m][n], 0, 0, 0); __builtin_amdgcn_s_setprio(0); } while (0)
#define PG8_WAIT_V(n) asm volatile("s_waitcnt vmcnt(" #n ")" ::: "memory")
#define PG8_WAIT_L(n) asm volatile("s_waitcnt lgkmcnt(" #n ")" ::: "memory")
#define PG8_BAR __builtin_amdgcn_s_barrier()
#define PG8_SCHED __builtin_amdgcn_sched_barrier(0)
    Unit cur, nxt; int ui = 0;
    if (!S.next(0, cur)) return;
    f32x4 acc[2][2][4][2];
#pragma unroll
    for (int a = 0; a < 2; ++a)
#pragma unroll
        for (int b = 0; b < 2; ++b)
#pragma unroll
            for (int m = 0; m < 4; ++m)
#pragma unroll
                for (int n = 0; n < 2; ++n) acc[a][b][m][n] = (f32x4){0.f, 0.f, 0.f, 0.f};
    bf16x8 At[4][2], B0[2][2], B1[2][2];
    const char* cA = (const char*)g.A + (size_t)cur.pm * tstep + (size_t)cur.kt0 * kstep; const char* cB = (const char*)g.Bt + (size_t)cur.pn * tstep + (size_t)cur.kt0 * kstep;
    S.a_ready(cur);
    if constexpr (SP2) {
        PG8_STAGE(PG8_SB(0, 0), cB, voffB); PG8_STAGE(PG8_SB(0, 1), cB + hstep, voffB); PG8_STAGE(PG8_SA(0, 0), cA, voffA); PG8_STAGE(PG8_SA(0, 1), cA + hstep, voffA);
        if (wr == 1) PG8_BAR;
        PG8_WAIT_V(2); PG8_BAR;
        PG8_STAGE(PG8_SB(1, 0), cB + kstep, voffB); PG8_STAGE(PG8_SA(1, 0), cA + kstep, voffA); PG8_STAGE(PG8_SB(1, 1), cB + hstep + kstep, voffB);
        PG8_WAIT_V(6); PG8_BAR;
    } else {
        PG8_STAGE(PG8_SB(0, 0), cB, voffB); PG8_STAGE(PG8_SA(0, 0), cA, voffA); PG8_STAGE(PG8_SB(0, 1), cB + hstep, voffB); PG8_STAGE(PG8_SA(0, 1), cA + hstep, voffA);
        if (wr == 1) PG8_BAR;
        PG8_WAIT_V(4); PG8_BAR;
        PG8_STAGE(PG8_SB(1, 0), cB + kstep, voffB); PG8_STAGE(PG8_SA(1, 0), cA + kstep, voffA); PG8_STAGE(PG8_SB(1, 1), cB + hstep + kstep, voffB);
        PG8_WAIT_V(6); PG8_BAR;
    }
    for (;;) {
        const bool has_next = S.next(ui + 1, nxt);
        const char* nA = has_next ? (const char*)g.A + (size_t)nxt.pm * tstep + (size_t)nxt.kt0 * kstep : cA; const char* nB = has_next ? (const char*)g.Bt + (size_t)nxt.pn * tstep + (size_t)nxt.kt0 * kstep : cB;
        const int nt = cur.nt;
        for (int t = 0; t < nt; t += 2) {
            const bool last = (t == nt - 2);
            const char* a1 = cA + (size_t)(t + 1) * kstep;
            const char* a2 = last ? nA : cA + (size_t)(t + 2) * kstep; const char* b2 = last ? nB : cB + (size_t)(t + 2) * kstep;
            const char* a3 = a2 + kstep; const char* b3 = b2 + kstep;
            if (last && has_next) S.a_ready(nxt);
            if constexpr (SP2) {
            PG8_LDB(B0, 0, 0); PG8_LDB(B1, 0, 1); PG8_SCHED; PG8_LDA(At, 0, 0); PG8_STAGE(PG8_SA(1, 1), a1 + hstep, voffA);
            PG8_WAIT_V(8); PG8_WAIT_L(0); PG8_BAR; PG8_MMA(0, 0, At, B0); PG8_MMA(0, 1, At, B1); PG8_BAR; PG8_SCHED;
            PG8_LDA(At, 0, 1); PG8_STAGE(PG8_SB(0, 0), b2, voffB); PG8_STAGE(PG8_SB(0, 1), b2 + hstep, voffB); PG8_STAGE(PG8_SA(0, 0), a2, voffA);
            PG8_WAIT_V(8); PG8_WAIT_L(0); PG8_BAR; PG8_MMA(1, 0, At, B0); PG8_MMA(1, 1, At, B1); PG8_BAR; PG8_SCHED;
            PG8_LDB(B0, 1, 0); PG8_LDB(B1, 1, 1); PG8_SCHED; PG8_LDA(At, 1, 0); PG8_STAGE(PG8_SA(0, 1), a2 + hstep, voffA);
            PG8_WAIT_V(8); PG8_WAIT_L(0); PG8_BAR; PG8_MMA(0, 0, At, B0); PG8_MMA(0, 1, At, B1); PG8_BAR; PG8_SCHED;
            PG8_LDA(At, 1, 1); PG8_STAGE(PG8_SB(1, 0), b3, voffB); PG8_STAGE(PG8_SB(1, 1), b3 + hstep, voffB); PG8_STAGE(PG8_SA(1, 0), a3, voffA);
            PG8_WAIT_V(8); PG8_WAIT_L(0); PG8_BAR; PG8_MMA(1, 0, At, B0); PG8_MMA(1, 1, At, B1); PG8_BAR; PG8_SCHED;
            } else {
            PG8_LDB(B0, 0, 0); PG8_SCHED; PG8_LDA(At, 0, 0); PG8_STAGE(PG8_SA(1, 1), a1 + hstep, voffA);
            PG8_WAIT_L(8); PG8_BAR; PG8_WAIT_L(0); PG8_MMA(0, 0, At, B0); PG8_BAR; PG8_SCHED;
            PG8_LDB(B1, 0, 1); PG8_STAGE(PG8_SB(0, 0), b2, voffB);
            PG8_BAR; PG8_WAIT_L(0); PG8_MMA(0, 1, At, B1); PG8_BAR;
            PG8_LDA(At, 0, 1); PG8_STAGE(PG8_SA(0, 0), a2, voffA);
            PG8_BAR; PG8_WAIT_L(0); PG8_MMA(1, 0, At, B0); PG8_BAR; PG8_SCHED;
            PG8_STAGE(PG8_SB(0, 1), b2 + hstep, voffB);
            PG8_WAIT_V(6); PG8_BAR; PG8_MMA(1, 1, At, B1); PG8_BAR;
            PG8_LDB(B0, 1, 0); PG8_SCHED; PG8_LDA(At, 1, 0); PG8_STAGE(PG8_SA(0, 1), a2 + hstep, voffA);
            PG8_WAIT_L(8); PG8_BAR; PG8_WAIT_L(0); PG8_MMA(0, 0, At, B0); PG8_BAR; PG8_SCHED;
            PG8_LDB(B1, 1, 1); PG8_STAGE(PG8_SB(1, 0), b3, voffB);
            PG8_BAR; PG8_WAIT_L(0); PG8_MMA(0, 1, At, B1); PG8_BAR;
            PG8_LDA(At, 1, 1); PG8_STAGE(PG8_SA(1, 0), a3, voffA);
            PG8_BAR; PG8_WAIT_L(0); PG8_MMA(1, 0, At, B0); PG8_BAR; PG8_SCHED;
            PG8_STAGE(PG8_SB(1, 1), b3 + hstep, voffB);
            PG8_WAIT_V(6); PG8_BAR; PG8_MMA(1, 1, At, B1); PG8_BAR;
            }
        }
        if constexpr (ALIGN_EPI) { if (wr == 0) PG8_BAR; }
        if constexpr (!Epi::AFTER_DRAIN) { E(acc, cur, wr, wc, fr, fq); S.done(cur); }
        if (!has_next) break;
#pragma unroll
        for (int a = 0; a < 2; ++a)
#pragma unroll
            for (int b = 0; b < 2; ++b)
#pragma unroll
                for (int m = 0; m < 4; ++m)
#pragma unroll
                    for (int n = 0; n < 2; ++n) acc[a][b][m][n] = (f32x4){0.f, 0.f, 0.f, 0.f};
        cur = nxt; cA = nA; cB = nB; ++ui;
        if constexpr (ALIGN_EPI) { if (wr == 1) PG8_BAR; }
    }
    PG8_WAIT_V(0);
    if constexpr (!ALIGN_EPI) { if (wr == 0) PG8_BAR; }
    PG8_BAR;
    if constexpr (Epi::AFTER_DRAIN) { E.fused(acc, cur, wr, wc, fr, fq, lds, wid, lane); S.done(cur); }
#undef PG8_SA
#undef PG8_SB
#undef PG8_STAGE
#undef PG8_LDA
#undef PG8_LDB
#undef PG8_MMA
#undef PG8_WAIT_V
#undef PG8_WAIT_L
#undef PG8_BAR
#undef PG8_SCHED
}
}
#define XB_TMO      128
#define XB_XCNT(j)  (256  + 64 * (j))
#define XB_XSUB(j)  (1280 + 64 * (j))
#define XB_XGEN(j)  (2304 + 64 * (j))
#define XB_TOP      3328
#define XB_TOPGEN   3392
#define XCD_BAR_WORDS 3456
#define XB_SPIN_CAP (1u << 18)

__device__ __forceinline__ unsigned xb_ld(unsigned* p)              { return __hip_atomic_load(p, __ATOMIC_RELAXED, __HIP_MEMORY_SCOPE_AGENT); }
__device__ __forceinline__ unsigned xb_add(unsigned* p, unsigned v) { return __hip_atomic_fetch_add(p, v, __ATOMIC_RELAXED, __HIP_MEMORY_SCOPE_AGENT); }
__device__ __forceinline__ unsigned xb_xcc_id() { return (unsigned)__builtin_amdgcn_s_getreg((3 << 11) | 20) & 0xFu; }
#define XB_SPIN(cond, bar) do { unsigned _sp = 0; while (cond) { __builtin_amdgcn_s_sleep(1); \
    if ((++_sp & 255u) == 0u) { if (xb_ld(&(bar)[XB_TMO])) break; if (_sp > XB_SPIN_CAP) { atomicAdd(&(bar)[XB_TMO], 1u); break; } } } } while (0)

struct XcdBarrier {
    unsigned* bar; unsigned x; unsigned wv;
    volatile LAS unsigned* st;
};

__device__ __forceinline__ XcdBarrier xcd_barrier_post(unsigned* bar, volatile LAS unsigned* st, unsigned wv) {
    XcdBarrier b; b.bar = bar; b.x = xb_xcc_id(); b.st = st; b.wv = wv;
    if (wv == 0 && lane_id() == 0) (void)xb_add(&bar[XB_XCNT(b.x)], 1u);
    return b;
}
__device__ __forceinline__ void xcd_barrier_complete(unsigned* bar, unsigned x, unsigned& nloc, unsigned& nx) {
    const unsigned G = gridDim.x * gridDim.y * gridDim.z;
    unsigned sum, cnt, mine, sp = 0u;
    for (;;) {
        sum = 0u; cnt = 0u; mine = 0u;
#pragma unroll
        for (unsigned j = 0; j < 16; ++j) { const unsigned c = xb_ld(&bar[XB_XCNT(j)]); sum += c; cnt += (c > 0u) ? 1u : 0u; mine = (j == x) ? c : mine; }
        if (sum == G) break;
        __builtin_amdgcn_s_sleep(1);
        if ((++sp & 255u) == 0u) { if (xb_ld(&bar[XB_TMO])) break; if (sp > XB_SPIN_CAP) { atomicAdd(&bar[XB_TMO], 1u); break; } }
    }
    nloc = mine > 0u ? mine : 1u; nx = cnt > 0u ? cnt : 1u;
}

__device__ __forceinline__ void xcd_barrier(const XcdBarrier& b) {
    asm volatile("s_waitcnt vmcnt(0)" ::: "memory");
    __syncthreads();
    if (b.wv == 0 && lane_id() == 0) {
        unsigned* bar = b.bar; unsigned bx = b.x;
        asm volatile("" : "+s"(bar), "+s"(bx));
        __builtin_amdgcn_s_waitcnt(0);
        unsigned nloc = b.st[0], nx = b.st[1];
        if (nloc == 0u) { xcd_barrier_complete(bar, bx, nloc, nx); b.st[0] = nloc; b.st[1] = nx; }
        const unsigned old = xb_add(&bar[XB_XSUB(bx)], 1u);
        const unsigned gen = old / nloc;
        if (old + 1u == (gen + 1u) * nloc) {
            __builtin_amdgcn_fence(__ATOMIC_RELEASE, "agent");
            asm volatile("s_waitcnt vmcnt(0)" ::: "memory");
            const unsigned og = xb_add(&bar[XB_TOP], 1u);
            const unsigned tg = og / nx;
            if (og + 1u == (tg + 1u) * nx) xb_add(&bar[XB_TOPGEN], 1u);
            else XB_SPIN(xb_ld(&bar[XB_TOPGEN]) == tg, bar);
            __builtin_amdgcn_fence(__ATOMIC_ACQUIRE, "agent");
            xb_add(&bar[XB_XGEN(bx)], 1u);
            asm volatile("s_waitcnt vmcnt(0)" ::: "memory");
        } else {
            XB_SPIN(xb_ld(&bar[XB_XGEN(bx)]) == gen, bar);
            __builtin_amdgcn_fence(__ATOMIC_ACQUIRE, "agent");
            asm volatile("s_waitcnt vmcnt(0)" ::: "memory");
        }
    }
    __syncthreads();
}

namespace att {
typedef unsigned short bf16;
constexpr int D = 128, NW = 8, QBLK = 32, KVBLK = 64;
constexpr float SCALE = 0.088388347648318440f;
constexpr float THR = 8.f;
constexpr int LDQ = 512, LDK = 256, LDO = 512;
constexpr size_t SHM_V = KVBLK * D * 2, SHM_K = KVBLK * D * 2, SHM_ATTN = 2 * SHM_V + 2 * SHM_K + NW * 64 * 4;
using bf16x8 = __attribute__((ext_vector_type(8))) short;
using s16x4  = __attribute__((ext_vector_type(4))) short;
using f32x16 = __attribute__((ext_vector_type(16))) float;
using u32x4  = __attribute__((ext_vector_type(4))) unsigned;
#define KSWZ(row, colB) ((row) * 256 + ((colB) ^ (((row) & 7) << 4)))
#define SBAR() __builtin_amdgcn_sched_barrier(0)
__device__ __forceinline__ int crow(int r, int hi) { return (r & 3) + 8 * (r >> 2) + 4 * hi; }
__device__ __forceinline__ unsigned cvtpk(float lo, float hi) { unsigned r; asm volatile("v_cvt_pk_bf16_f32 %0, %1, %2" : "=v"(r) : "v"(lo), "v"(hi)); return r; }
__device__ __forceinline__ void partialSM(f32x16& p0, f32x16& p1, float& m_reg, float& mn, float& alpha) {
  constexpr float C = SCALE * 1.4426950408889634f;
  float pmax = p0[0]; for (int r = 1; r < 16; ++r) pmax = fmaxf(pmax, p0[r]); for (int r = 0; r < 16; ++r) pmax = fmaxf(pmax, p1[r]);
  { auto rr = __builtin_amdgcn_permlane32_swap(__float_as_uint(pmax), __float_as_uint(pmax), false, false);
    pmax = fmaxf(__uint_as_float(rr[0]), __uint_as_float(rr[1])); }
  if (__builtin_expect(__all(pmax - m_reg <= THR / SCALE), 1)) { mn = m_reg; alpha = 1.f; }
  else { mn = fmaxf(m_reg, pmax); alpha = __builtin_amdgcn_exp2f((m_reg - mn) * C); m_reg = mn; }
  float mnC = -mn * C;
  for (int r = 0; r < 16; ++r) p0[r] = fmaf(p0[r], C, mnC); for (int r = 0; r < 16; ++r) p1[r] = fmaf(p1[r], C, mnC);
  for (int r = 0; r < 16; ++r) p0[r] = __builtin_amdgcn_exp2f(p0[r]);
}
__device__ __forceinline__ void finishSM(f32x16& p0, f32x16& p1, float alpha, float& l_reg, bf16x8& pa0, bf16x8& pa1, bf16x8& pa2, bf16x8& pa3) {
  for (int r = 0; r < 16; ++r) p1[r] = __builtin_amdgcn_exp2f(p1[r]);
  float ps = 0; for (int r = 0; r < 16; ++r) ps += p0[r]; for (int r = 0; r < 16; ++r) ps += p1[r];
  { auto rr = __builtin_amdgcn_permlane32_swap(__float_as_uint(ps), __float_as_uint(ps), false, false);
    ps = __uint_as_float(rr[0]) + __uint_as_float(rr[1]); }
  l_reg = l_reg * alpha + ps;
#define PK4(P, BASE, OUT) do { unsigned a0 = cvtpk(P[BASE + 0], P[BASE + 1]), a1 = cvtpk(P[BASE + 2], P[BASE + 3]);   \
    unsigned b0 = cvtpk(P[BASE + 4], P[BASE + 5]), b1 = cvtpk(P[BASE + 6], P[BASE + 7]);                              \
    auto r0 = __builtin_amdgcn_permlane32_swap(a0, b0, false, false); auto r1 = __builtin_amdgcn_permlane32_swap(a1, b1, false, false); \
    u32x4 w = {r0[0], r1[0], r0[1], r1[1]}; OUT = *reinterpret_cast<bf16x8*>(&w); } while (0)
  PK4(p0, 0, pa0); PK4(p0, 8, pa1); PK4(p1, 0, pa2); PK4(p1, 8, pa3);
#undef PK4
}
__device__ __forceinline__ void qkt(f32x16& p0, f32x16& p1, const bf16* Ks, const bf16x8* qr, int r32, int hi) {
  p0 = f32x16{}; p1 = f32x16{};
  for (int d0 = 0; d0 < 8; ++d0) { int cb = (d0 * 16 + hi * 8) * 2;
    bf16x8 b0 = *reinterpret_cast<const bf16x8*>((const char*)Ks + KSWZ(r32, cb));
    bf16x8 b1 = *reinterpret_cast<const bf16x8*>((const char*)Ks + KSWZ(32 + r32, cb));
    p0 = __builtin_amdgcn_mfma_f32_32x32x16_bf16(b0, qr[d0], p0, 0, 0, 0);
    p1 = __builtin_amdgcn_mfma_f32_32x32x16_bf16(b1, qr[d0], p1, 0, 0, 0); }
}
__device__ __forceinline__ int v_st(int k, int c) { const int kk = (k & ~0xC) | ((k & 4) << 1) | ((k & 8) >> 1); return ((kk >> 3) * 4 + (c >> 5)) * 512 + ((kk & 7) * 32 + (c & 31)) * 2; }
__device__ __forceinline__ int v_rd_base(int lane) { return ((lane & 3) << 3) | (((lane >> 2) & 3) << 6) | (((lane >> 4) & 1) << 5) | (((lane >> 5) & 1) << 8); }
constexpr int v_rd_off(int d0, int ks, int half) { return d0 * 512 + ks * 4096 + half * 2048; }
template <int OFF> __device__ __forceinline__ s16x4 tr_read(int vb) {
  s16x4 r; asm volatile("ds_read_b64_tr_b16 %0, %1 offset:%2" : "=&v"(r) : "v"(vb), "i"(OFF) : "memory"); return r;
}
template <int D0> __device__ __forceinline__ void pv_one(f32x16& od, int vb, bf16x8 pa0, bf16x8 pa1, bf16x8 pa2, bf16x8 pa3) {
  const s16x4 l0 = tr_read<v_rd_off(D0, 0, 0)>(vb), h0 = tr_read<v_rd_off(D0, 0, 1)>(vb), l1 = tr_read<v_rd_off(D0, 1, 0)>(vb), h1 = tr_read<v_rd_off(D0, 1, 1)>(vb);
  const s16x4 l2 = tr_read<v_rd_off(D0, 2, 0)>(vb), h2 = tr_read<v_rd_off(D0, 2, 1)>(vb), l3 = tr_read<v_rd_off(D0, 3, 0)>(vb), h3 = tr_read<v_rd_off(D0, 3, 1)>(vb);
  asm volatile("s_waitcnt lgkmcnt(0)" ::: "memory"); SBAR();
#define PK(L, H) (bf16x8){L[0], L[1], L[2], L[3], H[0], H[1], H[2], H[3]}
  od = __builtin_amdgcn_mfma_f32_32x32x16_bf16(pa0, PK(l0, h0), od, 0, 0, 0);
  od = __builtin_amdgcn_mfma_f32_32x32x16_bf16(pa1, PK(l1, h1), od, 0, 0, 0);
  od = __builtin_amdgcn_mfma_f32_32x32x16_bf16(pa2, PK(l2, h2), od, 0, 0, 0);
  od = __builtin_amdgcn_mfma_f32_32x32x16_bf16(pa3, PK(l3, h3), od, 0, 0, 0);
#undef PK
}
__device__ __forceinline__ void pv_d0(f32x16* o, int vb, bf16x8 pa0, bf16x8 pa1, bf16x8 pa2, bf16x8 pa3) {
  pv_one<0>(o[0], vb, pa0, pa1, pa2, pa3); pv_one<1>(o[1], vb, pa0, pa1, pa2, pa3); pv_one<2>(o[2], vb, pa0, pa1, pa2, pa3); pv_one<3>(o[3], vb, pa0, pa1, pa2, pa3);
}
__device__ __forceinline__ void attn_unit(const bf16* Qb_, const bf16* Kh_, const bf16* Vh_, float* Ob_, float* MLb_, int seq, char* lds, const int wave_id) {
  const GAS bf16* Qb = (const GAS bf16*)Qb_; const GAS bf16* Kh = (const GAS bf16*)Kh_; const GAS bf16* Vh = (const GAS bf16*)Vh_; GAS float* Ob = (GAS float*)Ob_; GAS float* MLb = (GAS float*)MLb_;
  int tid_ = wave_id * 64 + lane_id(); asm volatile("" : "+v"(tid_));
  const int tid = tid_, wid = tid >> 6, lane = tid & 63, r32 = lane & 31, hi = lane >> 5;
  bf16* V_lds = (bf16*)lds; bf16* K_lds = (bf16*)(lds + 2 * SHM_V);
  float* ws = (float*)(lds + 2 * SHM_V + 2 * SHM_K) + wid * 64; float* al_l = ws + 32;
  float m_reg = -1e30f, l_reg = 0; f32x16 o[4] = {}; bf16x8 qr[8];
  const GAS bf16* Qw = Qb + (long)(wid * QBLK + r32) * LDQ + hi * 8;
#pragma unroll
  for (int d0 = 0; d0 < 8; ++d0) qr[d0] = *reinterpret_cast<const GAS bf16x8*>(Qw + d0 * 16);
  const int sr = tid >> 4, sc = (tid & 15) * 8, vst0 = v_st(sr, sc), vst1 = v_st(32 + sr, sc);
  const int vb0 = (int)(uintptr_t)V_lds + v_rd_base(lane);
  struct { bf16x8 vs0, vs1, ks0, ks1; } sr_[2];
#define SLOAD(i, k0) do { sr_[i].vs0 = *reinterpret_cast<const GAS bf16x8*>(&Vh[(long)((k0) + sr) * LDK + sc]); sr_[i].vs1 = *reinterpret_cast<const GAS bf16x8*>(&Vh[(long)((k0) + 32 + sr) * LDK + sc]); \
    sr_[i].ks0 = *reinterpret_cast<const GAS bf16x8*>(&Kh[(long)((k0) + sr) * LDK + sc]); sr_[i].ks1 = *reinterpret_cast<const GAS bf16x8*>(&Kh[(long)((k0) + 32 + sr) * LDK + sc]); } while (0)
#define SWRITE(b, i) do { *(bf16x8*)((char*)V_lds + (b) * SHM_V + vst0) = sr_[i].vs0;          \
    *(bf16x8*)((char*)V_lds + (b) * SHM_V + vst1) = sr_[i].vs1; int kc = sc * 2;               \
    *(bf16x8*)((char*)K_lds + (b) * SHM_K + KSWZ(sr, kc)) = sr_[i].ks0;                       \
    *(bf16x8*)((char*)K_lds + (b) * SHM_K + KSWZ(32 + sr, kc)) = sr_[i].ks1; } while (0)
#define SWAIT() asm volatile("s_waitcnt vmcnt(4)" ::: "memory")
#define RESC(a) do { if (__any((a) < 1.f)) { if (hi == 0) al_l[r32] = (a); asm volatile("s_waitcnt lgkmcnt(0)" ::: "memory"); \
    for (int d = 0; d < 4; ++d) for (int r = 0; r < 16; ++r) o[d][r] *= al_l[crow(r, hi)]; } } while (0)
  f32x16 pA0, pA1, pB0, pB1; float mnA, mnB, alA, alB; bf16x8 pa0, pa1, pa2, pa3; const int NT = seq / KVBLK;
  constexpr int SE = 0, SO = 1;
  SLOAD(SE, 0); asm volatile("s_waitcnt vmcnt(0)" ::: "memory"); SWRITE(0, SE); __syncthreads();
  qkt(pA0, pA1, K_lds, qr, r32, hi); partialSM(pA0, pA1, m_reg, mnA, alA);
  SLOAD(SO, KVBLK); if (2 < NT) SLOAD(SE, 2 * KVBLK);
  SWAIT(); SWRITE(1, SO); __syncthreads();
  for (int j = 1; j + 1 < NT; j += 2) {
    SBAR(); qkt(pB0, pB1, (bf16*)((char*)K_lds + SHM_K), qr, r32, hi);
    finishSM(pA0, pA1, alA, l_reg, pa0, pa1, pa2, pa3); SBAR();
    SLOAD(SO, (j + 2) * KVBLK); SBAR();
    pv_d0(o, vb0, pa0, pa1, pa2, pa3); partialSM(pB0, pB1, m_reg, mnB, alB);
    __syncthreads(); SWAIT(); SWRITE(0, SE);
    RESC(alB); __syncthreads();
    SBAR(); qkt(pA0, pA1, K_lds, qr, r32, hi);
    finishSM(pB0, pB1, alB, l_reg, pa0, pa1, pa2, pa3); SBAR();
    if (j + 3 < NT) SLOAD(SE, (j + 3) * KVBLK); SBAR();
    pv_d0(o, vb0 + (int)SHM_V, pa0, pa1, pa2, pa3); partialSM(pA0, pA1, m_reg, mnA, alA);
    __syncthreads(); SWAIT(); SWRITE(1, SO);
    RESC(alA); __syncthreads();
  }
  SBAR(); qkt(pB0, pB1, (bf16*)((char*)K_lds + SHM_K), qr, r32, hi);
  finishSM(pA0, pA1, alA, l_reg, pa0, pa1, pa2, pa3); SBAR();
  pv_d0(o, vb0, pa0, pa1, pa2, pa3); partialSM(pB0, pB1, m_reg, mnB, alB);
  __syncthreads(); RESC(alB);
  finishSM(pB0, pB1, alB, l_reg, pa0, pa1, pa2, pa3); SBAR();
  pv_d0(o, vb0 + (int)SHM_V, pa0, pa1, pa2, pa3);
  if (hi == 0) { GAS float* ml = MLb + (long)(wid * QBLK + r32) * 8; ml[0] = m_reg; ml[1] = l_reg; }
  GAS float* Ow = Ob + (long)(wid * QBLK) * LDO;
#pragma unroll
  for (int r = 0; r < 16; ++r) { int orow = crow(r, hi);
    for (int d0 = 0; d0 < 4; ++d0) Ow[(long)orow * LDO + d0 * 32 + r32] = o[d0][r]; }
#undef SLOAD
#undef SWRITE
#undef SWAIT
#undef RESC
}
#undef KSWZ
#undef SBAR
}

struct Frame {
    LAS unsigned char* lds;
    unsigned char* gl;
    volatile LAS unsigned* MISC;
    gu32* ctl;
    int tid, lane, wave, G, bid;
};

__device__ __forceinline__ Frame fresh(const Frame& F) {
    Frame R = F; int t = F.wave * 64 + lane_id(); asm volatile("" : "+v"(t)); R.tid = t; R.lane = t & 63; R.wave = __builtin_amdgcn_readfirstlane(t >> 6);
    int b = F.bid; asm volatile("" : "+s"(b)); R.bid = b; int g = F.G; asm volatile("" : "+s"(g)); R.G = g; return R;
}
typedef short bf16x8 __attribute__((ext_vector_type(8)));
__device__ __forceinline__ bf16x8 frag16(const bf16* M, int ld, int r0, int k0, int lane) { return *(const bf16x8*)(M + (size_t)(r0 + (lane & 15)) * ld + k0 + 8 * (lane >> 4)); }
__device__ __forceinline__ bf16x8 frag16(const LAS bf16* M, int ld, int r0, int k0, int lane) { return *(const LAS bf16x8*)(M + (r0 + (lane & 15)) * ld + k0 + 8 * (lane >> 4)); }
#define MFMA16(a, b, c) __builtin_amdgcn_mfma_f32_16x16x32_bf16((a), (b), (c), 0, 0, 0)
constexpr int LDT = 72;

#ifndef MK_PROBE
#define MK_PROBE 0
#endif
#if MK_PROBE
#define ISTAMP(g) do { if (F.bid == 0 && F.wave == 0 && lane_id() == 0) { unsigned long long* T = (unsigned long long*)(F.ctl + 2048); const unsigned long long now = __builtin_amdgcn_s_memrealtime(); T[(g)] += now - T[31]; T[31] = now; } } while (0)
#else
#define ISTAMP(g) do { } while (0)
#endif
__device__ __forceinline__ void tr_item(const float* __restrict__ W, int N, int k0, int n0, bf16* __restrict__ WT, int Kd, int drow0, LAS float* scr, int lane) {
    float tmp[32];
#pragma unroll
    for (int i = 0; i < 32; ++i) { const int kk = 2 * i + (lane >> 5); tmp[i] = W[(size_t)(k0 + kk) * N + n0 + (lane & 31)]; }
#pragma unroll
    for (int i = 0; i < 32; ++i) { const int kk = 2 * i + (lane >> 5); scr[kk * 33 + (lane & 31)] = tmp[i]; }
    LDS_WAIT(); asm volatile("" ::: "memory");
    const int c = lane & 7;
#pragma unroll
    for (int j = 0; j < 4; ++j) { const int n = (lane >> 3) + 8 * j; const LAS float* s = scr + (8 * c) * 33 + n;
        u32x4 o; o.x = pk2(s[0 * 33], s[1 * 33]); o.y = pk2(s[2 * 33], s[3 * 33]); o.z = pk2(s[4 * 33], s[5 * 33]); o.w = pk2(s[6 * 33], s[7 * 33]);
        *(u32x4*)(WT + (size_t)(drow0 + n) * Kd + k0 + 8 * c) = o; }
    LDS_WAIT(); asm volatile("" ::: "memory");
}

struct In {
    const float *x, *c, *ctx, *c_ctx, *mod_w, *mod_b, *norm_g, *final_g, *ffn_w13, *ffn_w2, *w_in, *w_out, *lru_conv_w, *lru_conv_b, *lru_gate_w, *lru_gate_b, *lru_lambda, *attn_qk_g, *gla_gate_w, *gla_gate_b, *gla_out_g;
};

constexpr int MKS = 32;
__device__ __forceinline__ void prologue_a(const Frame& F_, const In& I, unsigned char* ws) {
    const Frame F = fresh(F_);
    const int gw = F.bid * NWAVES + F.wave, NGW = F.G * NWAVES;
    { const f32x4* cs = (const f32x4*)I.ctx; f32x4* X = (f32x4*)(ws + WS_X) + (size_t)TL * DM / 4;
      for (int i = F.bid * 512 + F.tid; i < TCX * DM / 4; i += F.G * 512) X[i] = cs[i]; }
    { float* MODP = (float*)(ws + WS_YF);
      for (int it = gw; it < NLAY * 72 * MKS; it += NGW) {
          const int ks = it % MKS, r = it / MKS, jb = r % 72, l = r / 72; const int j = jb * 256 + 4 * F.lane;
          const float* W = I.mod_w + ((size_t)l * DM + ks * (DM / MKS)) * (9 * DM) + j;
          f32x4 a0 = {0.f, 0.f, 0.f, 0.f}, a1 = {0.f, 0.f, 0.f, 0.f};
#pragma unroll 16
          for (int k = 0; k < DM / MKS; ++k) { const f32x4 w = *(const f32x4*)(W + (size_t)k * (9 * DM)); const float c0 = I.c[ks * (DM / MKS) + k], c1 = I.c_ctx[ks * (DM / MKS) + k];
              a0 += w * siluf_(c0); a1 += w * siluf_(c1); }
          *(f32x4*)(MODP + ((size_t)(ks * NLAY + l) * 2 + 0) * (9 * DM) + j) = a0;
          *(f32x4*)(MODP + ((size_t)(ks * NLAY + l) * 2 + 1) * (9 * DM) + j) = a1;
      } }
    LAS float* scr = (LAS float*)(F.lds + RING_OFF + F.wave * 16384);
    { constexpr int PER = 32 * 352;
      bf16* dst = (bf16*)(ws + WS_W13T);
      for (int it = gw; it < 1 * PER; it += NGW) { const int mat = it / PER, r = it % PER, kb = r / 352, nb = r % 352, n0 = nb * 32;
          const int drow0 = (n0 < FF) ? (n0 / 128) * 256 + (n0 % 128) : ((n0 - FF) / 128) * 256 + 128 + ((n0 - FF) % 128);
          tr_item(I.ffn_w13 + (size_t)mat * DM * 2 * FF, 2 * FF, kb * 64, n0, dst + (size_t)mat * 2 * FF * DM, DM, drow0, scr, F.lane); } }
    { constexpr int PER = 88 * 64;
      bf16* dst = (bf16*)(ws + WS_W2T);
      for (int it = gw; it < (NLAY + 1) * PER; it += NGW) { const int mc = it / PER, mat = mc < 2 ? mc : 2 * mc - 1, r = it % PER, kb = r / 64, nb = r % 64;
          tr_item(I.ffn_w2 + (size_t)mat * FF * DM, DM, kb * 64, nb * 32, dst + (size_t)mat * DM * FF, FF, nb * 32, scr, F.lane); } }
    { constexpr int PER = 32 * 129;
      bf16* dst = (bf16*)(ws + WS_WINT); bf16* dlr = (bf16*)(ws + WS_WLRT);
      for (int it = gw; it < 4 * PER; it += NGW) { const int mat = it / PER, r = it % PER, kb = r / 129, nb = r % 129;
          if (nb == 112) tr_item(I.w_in + (size_t)mat * DM * DIN, DIN, kb * 64, nb * 32, dlr + (size_t)mat * 32 * DM, DM, 0, scr, F.lane);
          else tr_item(I.w_in + (size_t)mat * DM * DIN, DIN, kb * 64, nb * 32, dst + (size_t)mat * 4096 * DM, DM, (nb < 112) ? nb * 32 : nb * 32 - 32, scr, F.lane); } }
    { constexpr int PER = 32 * 64;
      bf16* dst = (bf16*)(ws + WS_WOUTT);
      for (int it = gw; it < 4 * PER; it += NGW) { const int mat = it / PER, r = it % PER, kb = r / 64, nb = r % 64;
          tr_item(I.w_out + (size_t)mat * DM * DM, DM, kb * 64, nb * 32, dst + (size_t)mat * DM * DM, DM, nb * 32, scr, F.lane); } }
}
__device__ __forceinline__ void conv_w13(const Frame& F_, const float* __restrict__ w13, bf16* __restrict__ W13T, int mat, int rank, int nidle, int it_lo, int it_hi) {
    const Frame F = fresh(F_);
    __syncthreads();
    LAS float* scr = (LAS float*)(F.lds + RING_OFF + F.wave * 16384);
    for (int it = it_lo + rank * NWAVES + F.wave; it < it_hi; it += nidle * NWAVES) { const int kb = it / 352, nb = it % 352, n0 = nb * 32;
        const int drow0 = (n0 < FF) ? (n0 / 128) * 256 + (n0 % 128) : ((n0 - FF) / 128) * 256 + 128 + ((n0 - FF) % 128);
        tr_item(w13 + (size_t)mat * DM * 2 * FF, 2 * FF, kb * 64, n0, W13T + (size_t)mat * 2 * FF * DM, DM, drow0, scr, F.lane); }
    __syncthreads();
}
__device__ __forceinline__ void conv_w2(const Frame& F_, const float* __restrict__ w2, bf16* __restrict__ W2T, int mat, int rank, int nidle, int it_lo, int it_hi) {
    const Frame F = fresh(F_);
    __syncthreads();
    LAS float* scr = (LAS float*)(F.lds + RING_OFF + F.wave * 16384);
    for (int it = it_lo + rank * NWAVES + F.wave; it < it_hi; it += nidle * NWAVES) { const int kb = it / 64, nb = it % 64;
        tr_item(w2 + (size_t)mat * FF * DM, DM, kb * 64, nb * 32, W2T + (size_t)mat * DM * FF, FF, nb * 32, scr, F.lane); }
    __syncthreads();
}
__device__ __forceinline__ void prologue_b(const Frame& F_, const In& I, unsigned char* ws) {
    const Frame F = fresh(F_);
    const int gt = F.bid * 512 + F.tid, NGT = F.G * 512;
    { const float* MODP = (const float*)(ws + WS_YF); float* MODV = (float*)(ws + WS_MODV);
      for (int i = gt; i < NLAY * 2 * 9 * DM; i += NGT) { const int l = i / (2 * 9 * DM), j = i % (9 * DM);
          float s = I.mod_b[l * 9 * DM + j];
#pragma unroll
          for (int ks = 0; ks < MKS; ++ks) s += MODP[(size_t)ks * NLAY * 2 * 9 * DM + i];
          MODV[i] = s; } }
    { bf16* A = (bf16*)(ws + WS_DA);
      for (int i = gt; i < 128 * 128; i += NGT) { const int m = i >> 7, k = i & 127, k1 = m >> 1, ri = m & 1, rp = k >> 6, t1 = k & 63; const float f = (float)((t1 * k1) & 63) * (1.0f / 64.0f);
          const float cv = __builtin_amdgcn_cosf(f), sv = __builtin_amdgcn_sinf(f); A[i] = (bf16)f2bf(ri == 0 ? (rp == 0 ? cv : sv) : (rp == 0 ? -sv : cv)); } }
    { bf16* A = (bf16*)(ws + WS_DB);
      for (int i = gt; i < 128 * 256; i += NGT) { const int k2 = i >> 8, k = i & 255, ri = k >> 7, t2 = k & 127; const float f = (float)((t2 * k2) & 127) * (1.0f / 128.0f);
          A[i] = (bf16)f2bf(ri ? __builtin_amdgcn_sinf(f) : __builtin_amdgcn_cosf(f)); } }
    { bf16* A = (bf16*)(ws + WS_ADFTC);
      for (int i = gt; i < TCX * 64; i += NGT) { const int k1 = i >> 6, c0 = (i & 63) * 8; float v[8];
#pragma unroll
          for (int e = 0; e < 8; ++e) { const int col = c0 + e, t = col & 255; const float f = (float)((k1 * t) & 255) * (1.0f / 256.0f);
              v[e] = (col < 256) ? __builtin_amdgcn_cosf(f) : __builtin_amdgcn_sinf(f); }
          u32x4 o; o.x = pk2(v[0], v[1]); o.y = pk2(v[2], v[3]); o.z = pk2(v[4], v[5]); o.w = pk2(v[6], v[7]);
          *(u32x4*)(A + (size_t)k1 * 512 + c0) = o; } }
    { bf16* A = (bf16*)(ws + WS_ADFT1);
      for (int i = gt; i < 1024 * 64; i += NGT) { const int m = i >> 6, c0 = (i & 63) * 8, cs = m >> 9, g = (m >> 7) & 3, k2 = m & 127; float v[8];
#pragma unroll
          for (int e = 0; e < 8; ++e) { const int k = c0 + e, gp = k >> 7, c = k & 127; const float f = (float)((c * k2) & 127) * (1.0f / 128.0f);
              v[e] = (gp == g) ? (cs ? -__builtin_amdgcn_sinf(f) : __builtin_amdgcn_cosf(f)) : 0.0f; }
          u32x4 o; o.x = pk2(v[0], v[1]); o.y = pk2(v[2], v[3]); o.z = pk2(v[4], v[5]); o.w = pk2(v[6], v[7]);
          *(u32x4*)(A + (size_t)m * 512 + c0) = o; } }
    { bf16* WT = (bf16*)(ws + WS_WGT);
      for (int i = gt; i < NLAY * 32 * 4096; i += NGT) { const int mat = i >> 12, j = (i >> 6) & 63, ii = i & 63; WT[i] = (bf16)f2bf(I.lru_gate_w[(size_t)mat * 4096 + ii * 64 + j]); } }
    { float* R = (float*)(ws + WS_ROPE);
      for (int i = gt; i < 128 * 32; i += NGT) { const int pos = i >> 5, fi = i & 31;
          const float freq = powf(10000.0f, -(float)fi / 32.0f); const float ang = (float)pos * freq;
          const double rev = (double)ang * 0.15915494309189535; const float fr = (float)(rev - floor(rev));
          R[i] = __builtin_amdgcn_cosf(fr); R[128 * 32 + i] = __builtin_amdgcn_sinf(fr); } }
}

template <int NSL, bool XF32>
__device__ __forceinline__ void norm_phase(const Frame& F_, const float* __restrict__ Xl, float* __restrict__ X, bf16* __restrict__ XN, const float* __restrict__ g,
                                           const float* __restrict__ shl, const float* __restrict__ scl, const float* __restrict__ shc, const float* __restrict__ scc,
                                           const float* __restrict__ CP, const float* __restrict__ cgate, float ccoef) {
    const Frame F = fresh(F_);
    const int gw = F.bid * NWAVES + F.wave, NGW = F.G * NWAVES;
    if (!XF32) {
        for (int row = gw; row < TL; row += 2 * NGW) {
            const int row1 = row + NGW;
            const bool has1 = row1 < TL;
            const bf16* xr0 = (const bf16*)Xl + (size_t)row * DM; const bf16* xr1 = (const bf16*)Xl + (size_t)(has1 ? row1 : row) * DM;
            u32x4 p0[4], p1[4];
#pragma unroll
            for (int j = 0; j < 4; ++j) { p0[j] = *(const u32x4*)(xr0 + 512 * j + 8 * F.lane); p1[j] = *(const u32x4*)(xr1 + 512 * j + 8 * F.lane); }
            float s0 = 0.f, s1 = 0.f;
#pragma unroll
            for (int j = 0; j < 4; ++j) {
#pragma unroll
                for (int e = 0; e < 4; ++e) { const float a = __builtin_bit_cast(float, p0[j][e] << 16), b = __builtin_bit_cast(float, p0[j][e] & 0xffff0000u); s0 += a * a + b * b;
                    const float c_ = __builtin_bit_cast(float, p1[j][e] << 16), d = __builtin_bit_cast(float, p1[j][e] & 0xffff0000u); s1 += c_ * c_ + d * d; } }
#pragma unroll
            for (int o = 1; o < 64; o <<= 1) { s0 += __shfl_xor(s0, o); s1 += __shfl_xor(s1, o); }
            const float r0 = rsqrtf(s0 * (1.0f / DM) + EPS), r1 = rsqrtf(s1 * (1.0f / DM) + EPS);
#pragma unroll
            for (int j = 0; j < 4; ++j) { const int c = 512 * j + 8 * F.lane; u32x4 o0, o1;
#pragma unroll
                for (int h = 0; h < 2; ++h) { const f32x4 gv = *(const f32x4*)(g + c + 4 * h), sv = *(const f32x4*)(scl + c + 4 * h), hv = *(const f32x4*)(shl + c + 4 * h);
                    const f32x4 m = gv * (sv + 1.0f);
                    const f32x4 x0 = {__builtin_bit_cast(float, p0[j][2 * h] << 16), __builtin_bit_cast(float, p0[j][2 * h] & 0xffff0000u), __builtin_bit_cast(float, p0[j][2 * h + 1] << 16), __builtin_bit_cast(float, p0[j][2 * h + 1] & 0xffff0000u)};
                    const f32x4 x1 = {__builtin_bit_cast(float, p1[j][2 * h] << 16), __builtin_bit_cast(float, p1[j][2 * h] & 0xffff0000u), __builtin_bit_cast(float, p1[j][2 * h + 1] << 16), __builtin_bit_cast(float, p1[j][2 * h + 1] & 0xffff0000u)};
                    const f32x4 y0 = x0 * r0 * m + hv, y1 = x1 * r1 * m + hv;
                    o0[2 * h] = pk2(y0.x, y0.y); o0[2 * h + 1] = pk2(y0.z, y0.w); o1[2 * h] = pk2(y1.x, y1.y); o1[2 * h + 1] = pk2(y1.z, y1.w); }
                *(u32x4*)(XN + (size_t)row * DM + c) = o0; if (has1) *(u32x4*)(XN + (size_t)row1 * DM + c) = o1; }
        }
    } else
    for (int row = gw; row < TL; row += NGW) {
        const float* xr = Xl + (size_t)row * DM;
        f32x4 v[8]; float s = 0.f;
#pragma unroll
        for (int j = 0; j < 8; ++j) { v[j] = *(const f32x4*)(xr + 256 * j + 4 * F.lane); s += (v[j].x * v[j].x + v[j].y * v[j].y) + (v[j].z * v[j].z + v[j].w * v[j].w); }
        const float r = rsqrtf(wave_sum(s) * (1.0f / DM) + EPS);
#pragma unroll
        for (int j = 0; j < 8; ++j) { const int c = 256 * j + 4 * F.lane; const f32x4 gv = *(const f32x4*)(g + c), sv = *(const f32x4*)(scl + c), hv = *(const f32x4*)(shl + c);
            const f32x4 y = v[j] * r * gv * (sv + 1.0f) + hv; u32x2 o; o.x = pk2(y.x, y.y); o.y = pk2(y.z, y.w); *(u32x2*)(XN + (size_t)row * DM + c) = o; }
    }
    LAS float* red = (LAS float*)(F.lds + RING_OFF);
    for (int cr = F.bid; cr < TCX; cr += F.G) {
        const int row = TL + cr, c = 256 * F.wave + 4 * F.lane; float* xr = X + (size_t)row * DM + c;
        f32x4 v = *(const f32x4*)xr;
        if (NSL > 0) { f32x4 a = {0.f, 0.f, 0.f, 0.f};
#pragma unroll
            for (int sl = 0; sl < NSL; ++sl) a += *(const f32x4*)(CP + ((size_t)sl * TCX + cr) * DM + c);
            v += a * *(const f32x4*)(cgate + c) * ccoef; *(f32x4*)xr = v; }
        const float s = wave_sum((v.x * v.x + v.y * v.y) + (v.z * v.z + v.w * v.w));
        __syncthreads();
        if (F.lane == 0) red[F.wave] = s;
        __syncthreads();
        float tot = 0.f;
#pragma unroll
        for (int k = 0; k < 8; ++k) tot += red[k];
        const float r = rsqrtf(tot * (1.0f / DM) + EPS);
        const f32x4 gv = *(const f32x4*)(g + c), sv = *(const f32x4*)(scc + c), hv = *(const f32x4*)(shc + c);
        const f32x4 y = v * r * gv * (sv + 1.0f) + hv; u32x2 o; o.x = pk2(y.x, y.y); o.y = pk2(y.z, y.w); *(u32x2*)(XN + (size_t)row * DM + c) = o;
    }
}
__device__ __forceinline__ void final_norm(const Frame& F_, const float* __restrict__ X, float* __restrict__ out, const float* __restrict__ g, float pa, float pb) {
    const Frame F = fresh(F_);
    const int gw = F.bid * NWAVES + F.wave, NGW = F.G * NWAVES;
    for (int row = gw; row < TL; row += NGW) {
        const bf16* xr = (const bf16*)X + (size_t)row * DM; u32x4 p[4]; float s = 0.f;
#pragma unroll
        for (int j = 0; j < 4; ++j) p[j] = *(const u32x4*)(xr + 512 * j + 8 * F.lane);
        float v[4][8];
#pragma unroll
        for (int j = 0; j < 4; ++j) {
#pragma unroll
            for (int e = 0; e < 4; ++e) { v[j][2 * e] = __builtin_bit_cast(float, p[j][e] << 16); v[j][2 * e + 1] = __builtin_bit_cast(float, p[j][e] & 0xffff0000u); s += v[j][2 * e] * v[j][2 * e] + v[j][2 * e + 1] * v[j][2 * e + 1]; } }
        const float r = rsqrtf(wave_sum(s) * (1.0f / DM) + EPS);
#pragma unroll
        for (int j = 0; j < 4; ++j) {
#pragma unroll
            for (int h = 0; h < 2; ++h) { const int c = 512 * j + 8 * F.lane + 4 * h; const f32x4 x = {v[j][4 * h], v[j][4 * h + 1], v[j][4 * h + 2], v[j][4 * h + 3]};
                f32x4 y = x * r * *(const f32x4*)(g + c) * (1.0f + pa); if (row == 0 && c == 0) y.x += pb; *(f32x4*)(out + (size_t)row * DM + c) = y; } }
    }
}
__device__ __forceinline__ void lr_phase(const Frame& F_, const bf16* __restrict__ XN, const bf16* __restrict__ WLRT, float* __restrict__ LR, int rank, int nwork) {
    const Frame F = fresh(F_);
    LAS float* red = (LAS float*)(F.lds + RING_OFF);
    const int lane = F.lane, w = F.wave, tt = w >> 2, kq = w & 3;
    for (int task = rank; task < MR / 32; task += nwork) {
        f32x4 c0 = {0.f, 0.f, 0.f, 0.f}, c1 = {0.f, 0.f, 0.f, 0.f};
        const bf16* ap = XN + (size_t)(32 * task + 16 * tt + (lane & 15)) * DM + 512 * kq + 8 * (lane >> 4);
        const bf16* bp = WLRT + (size_t)(lane & 15) * DM + 512 * kq + 8 * (lane >> 4);
#pragma unroll
        for (int ks = 0; ks < 16; ++ks) { const bf16x8 a = *(const bf16x8*)(ap + 32 * ks), b0 = *(const bf16x8*)(bp + 32 * ks), b1 = *(const bf16x8*)(bp + 16 * DM + 32 * ks);
            c0 = MFMA16(a, b0, c0); c1 = MFMA16(a, b1, c1); }
        __syncthreads();
        *(LAS f32x4*)(red + ((w * 2 + 0) * 64 + lane) * 4) = c0; *(LAS f32x4*)(red + ((w * 2 + 1) * 64 + lane) * 4) = c1;
        __syncthreads();
        if (kq == 0) { f32x4 s0 = c0, s1 = c1;
#pragma unroll
            for (int q = 1; q < 4; ++q) { s0 += *(const LAS f32x4*)(red + (((w + q) * 2 + 0) * 64 + lane) * 4); s1 += *(const LAS f32x4*)(red + (((w + q) * 2 + 1) * 64 + lane) * 4); }
#pragma unroll
            for (int r = 0; r < 4; ++r) { float* o = LR + (size_t)(32 * task + 16 * tt + 4 * (lane >> 4) + r) * 32 + (lane & 15); o[0] = s0[r]; o[16] = s1[r]; } }
    }
}
__device__ __forceinline__ void ctx_p_reduce(const Frame& F_, const float* __restrict__ PP, float* __restrict__ P, bf16* __restrict__ UF) {
    const Frame F = fresh(F_);
    const int gt = F.bid * 512 + F.tid, NGT = F.G * 512;
    for (int i = gt; i < TCX * 1024; i += NGT) { const int r = i >> 10, c = (i & 1023) * 4; f32x4 a = *(const f32x4*)(PP + (size_t)r * 4096 + c);
#pragma unroll
        for (int sl = 1; sl < 8; ++sl) a += *(const f32x4*)(PP + ((size_t)sl * TCX + r) * 4096 + c);
        if (c < PLD) *(f32x4*)(P + (size_t)(TL + r) * PLD + c) = a;
        else { u32x2 o; o.x = pk2(a.x, a.y); o.y = pk2(a.z, a.w); *(u32x2*)(UF + (size_t)(TL + r) * 512 + (c - PLD)) = o; } }
}
__device__ __forceinline__ void qkv_prep(const Frame& F_, const float* __restrict__ P, const float* __restrict__ qk_g, const float* __restrict__ ROPE, bf16* __restrict__ QB, bf16* __restrict__ KB, bf16* __restrict__ VB) {
    const Frame F = fresh(F_);
    const int gw = F.bid * NWAVES + F.wave, NGW = F.G * NWAVES;
    const int half = F.lane >> 5, i = F.lane & 31, d1 = 64 * half + i, d2 = d1 + 32;
    for (int it0 = gw * 4; it0 < MR * 6; it0 += NGW * 4) {
        float e1[4], e2[4], g1[4], g2[4], cs[4], sn[4];
#pragma unroll
        for (int u = 0; u < 4; ++u) { const int it = it0 + u, t = it / 6, slot = it - 6 * t; const float* src = P + (size_t)t * PLD + (slot < 4 ? PC_Q + 128 * slot : PC_K + 128 * (slot - 4)); e1[u] = src[d1]; e2[u] = src[d2];
            const float* gg = qk_g + (slot < 4 ? 0 : 128); g1[u] = gg[d1]; g2[u] = gg[d2];
            const int pos = (t < TL) ? (half ? (t & 63) : (t >> 6)) : 0; cs[u] = (t < TL) ? ROPE[pos * 32 + i] : 1.0f; sn[u] = (t < TL) ? ROPE[128 * 32 + pos * 32 + i] : 0.0f; }
#pragma unroll
        for (int u = 0; u < 4; ++u) { const int it = it0 + u, t = it / 6, slot = it - 6 * t;
            const float r = rsqrtf(wave_sum(e1[u] * e1[u] + e2[u] * e2[u]) * (1.0f / 128.0f) + EPS);
            const float a = e1[u] * r * g1[u], b = e2[u] * r * g2[u]; const float o1 = a * cs[u] - b * sn[u], o2 = a * sn[u] + b * cs[u];
            bf16* dst = (slot < 4) ? (QB + (size_t)t * 512 + 128 * slot) : (KB + (size_t)t * 256 + 128 * (slot - 4));
            dst[d1] = (bf16)f2bf(o1); dst[d2] = (bf16)f2bf(o2); }
    }
    for (int i4 = F.bid * 512 + F.tid; i4 < MR * 64; i4 += F.G * 512) { const int t = i4 >> 6, c = (i4 & 63) * 4; const f32x4 v = *(const f32x4*)(P + (size_t)t * PLD + PC_V + c);
        u32x2 o; o.x = pk2(v.x, v.y); o.y = pk2(v.z, v.w); *(u32x2*)(VB + (size_t)t * 256 + c) = o; }
}
__device__ __forceinline__ int chunk_ord(int d, int p) { return d ? (NCHUNK - 1 - p) : (p < 4 ? 128 + p : p - 4); }

template <bool FINAL>
__device__ __forceinline__ void lru_pass(const Frame& F_, const float* __restrict__ Pgen, const float* __restrict__ conv_w, const float* __restrict__ conv_b, const bf16* __restrict__ WgT,
                                         const float* __restrict__ gate_b, const float* __restrict__ lam, float* __restrict__ ATOT, float* __restrict__ HEND, const float* __restrict__ CIN, bf16* __restrict__ MIX, int off, int nitems) {
    const Frame F = fresh(F_);
    const GAS float* __restrict__ P = (const GAS float*)Pgen;
    LAS float* xs = (LAS float*)(F.lds + RING_OFF);
    LAS float* uf = (LAS float*)(F.lds + RING_OFF + 34304);
    LAS bf16* ub = (LAS bf16*)(F.lds + RING_OFF + 67328);
    const int lane = F.lane, w = F.wave, g4 = lane >> 4, cl = lane & 15;
    for (int item = first_item(F.bid, F.G, off); item < nitems; item += F.G) {
        const int n = item >> 2, hp = item & 3, t0 = n * 64, seg_lo = (n < 128) ? 0 : TL, seg_hi = (n < 128) ? TL : MR;
        const int hl = w >> 2, head = hp * 2 + hl, c16 = (w & 3) * 16, chl = c16 + cl, cglob = head * 64 + chl;
        bf16x8 pbr[2][2], pbi[2][2]; float pbR[2], pbI[2], plam[2], pcin[2], pgt[16];
#pragma unroll
        for (int d = 0; d < 2; ++d) {
#pragma unroll
            for (int ks = 0; ks < 2; ++ks) { pbr[d][ks] = frag16(WgT + (size_t)((d * 2 + 0) * 8 + head) * 4096, 64, c16, 32 * ks, lane); pbi[d][ks] = frag16(WgT + (size_t)((d * 2 + 1) * 8 + head) * 4096, 64, c16, 32 * ks, lane); }
            pbR[d] = gate_b[(d * 2 + 0) * 512 + cglob]; pbI[d] = gate_b[(d * 2 + 1) * 512 + cglob]; plam[d] = lam[d * 512 + cglob];
            pcin[d] = FINAL ? CIN[((size_t)d * NCHUNK + n) * 512 + cglob] : 0.f; }
        if (FINAL) {
#pragma unroll
            for (int m = 0; m < 4; ++m)
#pragma unroll
                for (int r = 0; r < 4; ++r) pgt[4 * m + r] = P[(size_t)(t0 + 16 * m + 4 * g4 + r) * PLD + PC_LG + cglob]; }
        __syncthreads();
        { float tmp[17];
#pragma unroll
          for (int k = 0; k < 17; ++k) { const int e = F.tid + 512 * k, r = e >> 7, c = e & 127, t = t0 - 2 + r; tmp[k] = (e < 67 * 128 && t >= seg_lo && t < seg_hi) ? P[(size_t)t * PLD + PC_LX + hp * 128 + c] : 0.0f; }
#pragma unroll
          for (int k = 0; k < 17; ++k) { const int e = F.tid + 512 * k; if (e < 67 * 128) xs[e] = tmp[k]; } }
        __syncthreads();
        for (int e = F.tid; e < 64 * 128; e += 512) { const int tok = e >> 7, c = e & 127, cg = hp * 128 + c; float u = conv_b[cg];
#pragma unroll
            for (int j = 0; j < 4; ++j) u += conv_w[j * 512 + cg] * xs[(tok + j) * 128 + c];
            uf[tok * 129 + c] = u; ub[((c >> 6) * 64 + tok) * LDT + (c & 63)] = (bf16)f2bf(u); }
        __syncthreads();
        float hsum[4][4];
#pragma unroll
        for (int m = 0; m < 4; ++m)
#pragma unroll
            for (int r = 0; r < 4; ++r) hsum[m][r] = 0.f;
#pragma unroll
        for (int d = 0; d < 2; ++d) {
            f32x4 ga[4], gi[4];
#pragma unroll
            for (int m = 0; m < 4; ++m) { ga[m] = (f32x4){0.f, 0.f, 0.f, 0.f}; gi[m] = (f32x4){0.f, 0.f, 0.f, 0.f}; }
#pragma unroll
            for (int ks = 0; ks < 2; ++ks) {
                const bf16x8 br = pbr[d][ks], bi = pbi[d][ks];
#pragma unroll
                for (int m = 0; m < 4; ++m) { const bf16x8 a = frag16(ub + hl * 64 * LDT, LDT, 16 * m, 32 * ks, lane); ga[m] = MFMA16(a, br, ga[m]); gi[m] = MFMA16(a, bi, gi[m]); } }
            const float bR = pbR[d], bI = pbI[d], sp = log1pf(__expf(-plam[d]));
#pragma unroll
            for (int m = 0; m < 4; ++m)
#pragma unroll
                for (int r = 0; r < 4; ++r) { const int tok = 16 * m + 4 * g4 + r;
                    const float rr = sigmoidf_(ga[m][r] + bR), ii = sigmoidf_(gi[m][r] + bI), la = -8.0f * rr * sp;
                    ga[m][r] = __expf(la); gi[m][r] = __builtin_amdgcn_sqrtf(one_minus_exp_(2.0f * la)) * (ii * uf[tok * 129 + hl * 64 + chl]); }
            float CA = 1.f, CB = 0.f;
            if (FINAL) CB = pcin[d];
#pragma unroll
            for (int mm = 0; mm < 4; ++mm) { const int m = d ? 3 - mm : mm;
                float ia[4], ib[4]; float A = 1.f, B = 0.f;
#pragma unroll
                for (int rr = 0; rr < 4; ++rr) { const int r = d ? 3 - rr : rr; B = ga[m][r] * B + gi[m][r]; A *= ga[m][r]; ia[r] = A; ib[r] = B; }
                float SA = A, SB = B;
                { const float pa = d ? __shfl_down(SA, 16) : __shfl_up(SA, 16), pb = d ? __shfl_down(SB, 16) : __shfl_up(SB, 16); const bool ok = d ? (g4 <= 2) : (g4 >= 1); if (ok) { SB = SA * pb + SB; SA = pa * SA; } }
                { const float pa = d ? __shfl_down(SA, 32) : __shfl_up(SA, 32), pb = d ? __shfl_down(SB, 32) : __shfl_up(SB, 32); const bool ok = d ? (g4 <= 1) : (g4 >= 2); if (ok) { SB = SA * pb + SB; SA = pa * SA; } }
                float EA = d ? __shfl_down(SA, 16) : __shfl_up(SA, 16), EB = d ? __shfl_down(SB, 16) : __shfl_up(SB, 16);
                if (d ? (g4 == 3) : (g4 == 0)) { EA = 1.f; EB = 0.f; }
                const float TA = __shfl(SA, d ? cl : 48 + cl), TB = __shfl(SB, d ? cl : 48 + cl);
                const float PA = CA * EA, PB = EA * CB + EB;
                if (FINAL) {
#pragma unroll
                    for (int r = 0; r < 4; ++r) hsum[m][r] += ia[r] * PB + ib[r]; }
                CB = TA * CB + TB; CA = CA * TA;
                (void)PA;
            }
            if (!FINAL) { if (g4 == 0) { ATOT[((size_t)d * NCHUNK + n) * 512 + cglob] = CA; HEND[((size_t)d * NCHUNK + n) * 512 + cglob] = CB; } }
        }
        if (FINAL) {
#pragma unroll
            for (int m = 0; m < 4; ++m)
#pragma unroll
                for (int r = 0; r < 4; ++r) { const int t = t0 + 16 * m + 4 * g4 + r; const float gt = pgt[4 * m + r];
                    MIX[(size_t)t * DM + cglob] = (bf16)f2bf(hsum[m][r] * gelu_tanh_(gt)); }
        }
    }
}
__device__ __forceinline__ void lru_b(const Frame& F_, int b0, const float* __restrict__ ATOT, const float* __restrict__ HEND, float* __restrict__ CIN) {
    const Frame F = fresh(F_);
    for (int d = 0; d < 2; ++d) if (F.bid == ((b0 + d) % F.G)) {
        const int c = F.tid; float carry = 0.f;
        for (int p = 0; p < NCHUNK; p += 44) { float A[44], H[44];
#pragma unroll
            for (int k = 0; k < 44; ++k) { const int n = chunk_ord(d, p + k); A[k] = ATOT[((size_t)d * NCHUNK + n) * 512 + c]; H[k] = HEND[((size_t)d * NCHUNK + n) * 512 + c]; }
#pragma unroll
            for (int k = 0; k < 44; ++k) { const int n = chunk_ord(d, p + k); CIN[((size_t)d * NCHUNK + n) * 512 + c] = carry; carry = A[k] * carry + H[k]; } }
    }
}
__device__ __forceinline__ void gla_a(const Frame& F_, const float* __restrict__ Pgen, const float* __restrict__ LR, const float* __restrict__ gw_, const float* __restrict__ gb_,
                                      float* __restrict__ BC, float* __restrict__ DS, float* __restrict__ DEC, int off) {
    const Frame F = fresh(F_);
    const GAS float* __restrict__ P = (const GAS float*)Pgen;
    LAS float* lrs = (LAS float*)(F.lds + RING_OFF);
    LAS float* bcs = (LAS float*)(F.lds + RING_OFF + 8704);
    LAS float* tots = (LAS float*)(F.lds + RING_OFF + 41984);
    LAS bf16* koutT = (LAS bf16*)(F.lds + RING_OFF + 42496);
    LAS bf16* vT = (LAS bf16*)(F.lds + RING_OFF + 60928);
    LAS float* gws = (LAS float*)(F.lds + RING_OFF + 79360);
    const int w = F.wave;
    for (int item = first_item(F.bid, F.G, off); item < NCHUNK * 4; item += F.G) {
        const int n = item >> 2, hh = item & 3, t0 = n * 64;
        int tid_l = F.tid; asm volatile("" : "+v"(tid_l));
        const int lane = tid_l & 63;
        __syncthreads();
        for (int e = tid_l; e < 2048; e += 512) gws[e] = gw_[(e >> 6) * 256 + hh * 64 + (e & 63)];
        for (int e = tid_l; e < 2048; e += 512) lrs[(e >> 5) * 33 + (e & 31)] = LR[(size_t)(t0 + (e >> 5)) * 32 + (e & 31)];
#pragma unroll
        for (int k_ = 0; k_ < 16; ++k_) { const int e = tid_l + 512 * k_, s = e >> 7, dv = e & 127; vT[dv * LDT + s] = (bf16)f2bf(P[(size_t)(t0 + s) * PLD + PC_GV + hh * 128 + dv]); }
        __syncthreads(); ISTAMP(18);
        { const int tok = lane, d = w >> 2;
          float lr16[16];
#pragma unroll
          for (int r = 0; r < 16; ++r) lr16[r] = lrs[tok * 33 + 16 * d + r];
#pragma unroll 1
          for (int hf = 0; hf < 2; ++hf) {
              const int dk0 = (w & 3) * 16 + hf * 8; float z[8];
#pragma unroll
              for (int jj = 0; jj < 8; ++jj) z[jj] = gb_[d * 256 + hh * 64 + dk0 + jj];
#pragma unroll
              for (int r = 0; r < 16; ++r) { const LAS float* gwr = gws + (d * 16 + r) * 64 + dk0;
#pragma unroll
                  for (int jj = 0; jj < 8; ++jj) z[jj] += lr16[r] * gwr[jj]; }
#pragma unroll
              for (int jj = 0; jj < 8; ++jj) z[jj] = -(fmaxf(-z[jj], 0.0f) + __logf(1.0f + __expf(-fabsf(z[jj])))) * (1.0f / 16.0f);
#pragma unroll
              for (int st = 0; st < 6; ++st) { const int o = 1 << st; const bool ok = d ? (lane + o < 64) : (lane >= o);
#pragma unroll
                  for (int jj = 0; jj < 8; ++jj) { const float y = d ? __shfl_down(z[jj], o) : __shfl_up(z[jj], o); if (ok) z[jj] += y; } }
#pragma unroll
              for (int jj = 0; jj < 8; ++jj) { bcs[(d * 64 + tok) * 65 + dk0 + jj] = z[jj]; const float tot = __shfl(z[jj], d ? 0 : 63);
                  if (lane == 0) { tots[d * 64 + dk0 + jj] = tot; DEC[((size_t)(n * 4 + hh) * 2 + d) * 64 + dk0 + jj] = __expf(tot); } } } }
        __syncthreads(); ISTAMP(19);
#pragma unroll
        for (int k_ = 0; k_ < 8; ++k_) { const int e = tid_l + 512 * k_, s = e >> 6, dk = e & 63; const float kv = P[(size_t)(t0 + s) * PLD + PC_GK + hh * 64 + dk];
#pragma unroll
            for (int d = 0; d < 2; ++d) { const float b = bcs[(d * 64 + s) * 65 + dk]; BC[((size_t)d * MR + t0 + s) * 256 + hh * 64 + dk] = b;
                koutT[(d * 64 + dk) * LDT + s] = (bf16)f2bf(kv * __expf(tots[d * 64 + dk] - b)); } }
        __syncthreads(); ISTAMP(20);
        { const int d = w >> 2, mt0 = (w & 3) * 2; f32x4 acc[2][4];
#pragma unroll
          for (int i = 0; i < 2; ++i)
#pragma unroll
              for (int j = 0; j < 4; ++j) acc[i][j] = (f32x4){0.f, 0.f, 0.f, 0.f};
#pragma unroll
          for (int ks = 0; ks < 2; ++ks) { bf16x8 a[2], b[4];
#pragma unroll
              for (int i = 0; i < 2; ++i) a[i] = frag16(vT, LDT, 16 * (mt0 + i), 32 * ks, lane);
#pragma unroll
              for (int j = 0; j < 4; ++j) b[j] = frag16(koutT + d * 64 * LDT, LDT, 16 * j, 32 * ks, lane);
#pragma unroll
              for (int i = 0; i < 2; ++i)
#pragma unroll
                  for (int j = 0; j < 4; ++j) acc[i][j] = MFMA16(a[i], b[j], acc[i][j]); }
          float* dst = DS + ((size_t)(n * 4 + hh) * 2 + d) * 8192;
#pragma unroll
          for (int i = 0; i < 2; ++i)
#pragma unroll
              for (int j = 0; j < 4; ++j)
#pragma unroll
                  for (int r = 0; r < 4; ++r) dst[(16 * (mt0 + i) + 4 * (lane >> 4) + r) * 64 + 16 * j + (lane & 15)] = acc[i][j][r]; }
        ISTAMP(21);
    }
}
__device__ __forceinline__ void gla_b(const Frame& F_, const float* __restrict__ DS, const float* __restrict__ DEC, bf16* __restrict__ SP) {
    const Frame F = fresh(F_);
    const int b_ = F.bid; const bool full = (F.G == 256);
    const bool excl = full && (b_ < 4 || b_ == 32 || b_ == 33 || b_ == 64 || b_ == 65);
    const int rank = b_ - (b_ > 65 ? 8 : b_ > 33 ? 6 : 4);
    int g0, gstep; bool act;
    if (full) { act = !excl && (F.tid < 264 || (F.tid == 264 && rank < 64)); g0 = (F.tid < 264) ? rank * 264 + F.tid : 248 * 264 + rank; gstep = 1 << 30; }
    else { act = F.tid < 256; g0 = b_ * 256 + F.tid; gstep = F.G * 256; }
    if (act) for (int g = g0; g < 4 * 2 * 64 * 128; g += gstep) {
        const int dk = g & 63, e = g & 8191, d = (g >> 13) & 1, hh = g >> 14; float S = 0.f;
        for (int p = 0; p < NCHUNK; p += 33) { float dec[33], ds[33];
#pragma unroll
            for (int k = 0; k < 33; ++k) { const size_t idx = (size_t)(chunk_ord(d, p + k) * 4 + hh) * 2 + d; dec[k] = DEC[idx * 64 + dk]; ds[k] = DS[idx * 8192 + e]; }
#pragma unroll
            for (int k = 0; k < 33; ++k) { const size_t idx = (size_t)(chunk_ord(d, p + k) * 4 + hh) * 2 + d; SP[idx * 8192 + e] = (bf16)f2bf(S); S = dec[k] * S + ds[k]; } }
    }
}
__device__ __forceinline__ void gla_c(const Frame& F_, const float* __restrict__ Pgen, const float* __restrict__ BCgen, const bf16* __restrict__ SP, const float* __restrict__ out_g, bf16* __restrict__ MIX, int off, int nitems) {
    const Frame F = fresh(F_);
    const GAS float* __restrict__ P = (const GAS float*)Pgen; const GAS float* __restrict__ BC = (const GAS float*)BCgen;
    LAS bf16* qt = (LAS bf16*)(F.lds + RING_OFF);
    LAS bf16* kin = (LAS bf16*)(F.lds + RING_OFF + 18432);
    LAS bf16* attm = (LAS bf16*)(F.lds + RING_OFF + 36864);
    LAS bf16* vT = (LAS bf16*)(F.lds + RING_OFF + 55296);
    LAS float* red = (LAS float*)(F.lds + RING_OFF + 73728);
    const int lane = F.lane, w = F.wave, g4 = lane >> 4, cl = lane & 15;
    for (int item = first_item(F.bid, F.G, off); item < nitems; item += F.G) {
        const int n = item >> 2, hh = item & 3, t0 = n * 64;
        const int mt = w >> 1, nt0 = (w & 1) * 4;
        bf16x8 psp[2][2][4]; float pg[4][4], pog[4];
#pragma unroll
        for (int d = 0; d < 2; ++d) { const bf16* sp = SP + ((size_t)(n * 4 + hh) * 2 + d) * 8192;
#pragma unroll
            for (int ks = 0; ks < 2; ++ks)
#pragma unroll
                for (int j = 0; j < 4; ++j) psp[d][ks][j] = frag16(sp, 64, 16 * (nt0 + j), 32 * ks, lane); }
#pragma unroll
        for (int j = 0; j < 4; ++j) { pog[j] = out_g[16 * (nt0 + j) + cl];
#pragma unroll
            for (int r = 0; r < 4; ++r) pg[j][r] = P[(size_t)(t0 + 16 * mt + 4 * g4 + r) * PLD + PC_GG + hh * 128 + 16 * (nt0 + j) + cl]; }
        __syncthreads();
#pragma unroll
        for (int k_ = 0; k_ < 16; ++k_) { const int e = F.tid + 512 * k_, s = e >> 7, dv = e & 127; vT[dv * LDT + s] = (bf16)f2bf(P[(size_t)(t0 + s) * PLD + PC_GV + hh * 128 + dv]); }
#pragma unroll
        for (int k_ = 0; k_ < 8; ++k_) { const int e = F.tid + 512 * k_, tok = e >> 6, dk = e & 63; const float q = P[(size_t)(t0 + tok) * PLD + PC_GQ + hh * 64 + dk] * 0.125f, k = P[(size_t)(t0 + tok) * PLD + PC_GK + hh * 64 + dk];
#pragma unroll
            for (int d = 0; d < 2; ++d) { const float b = BC[((size_t)d * MR + t0 + tok) * 256 + hh * 64 + dk];
                qt[(d * 64 + tok) * LDT + dk] = (bf16)f2bf(q * __expf(b)); kin[(d * 64 + tok) * LDT + dk] = (bf16)f2bf(k * __expf(-b)); } }
        __syncthreads();
        { const int d = w >> 2, mt = w & 3; f32x4 acc[4];
#pragma unroll
          for (int j = 0; j < 4; ++j) acc[j] = (f32x4){0.f, 0.f, 0.f, 0.f};
#pragma unroll
          for (int ks = 0; ks < 2; ++ks) { const bf16x8 a = frag16(qt + d * 64 * LDT, LDT, 16 * mt, 32 * ks, lane);
#pragma unroll
              for (int j = 0; j < 4; ++j) acc[j] = MFMA16(a, frag16(kin + d * 64 * LDT, LDT, 16 * j, 32 * ks, lane), acc[j]); }
#pragma unroll
          for (int j = 0; j < 4; ++j)
#pragma unroll
              for (int r = 0; r < 4; ++r) { const int t = 16 * mt + 4 * g4 + r, s = 16 * j + cl; const bool keep = d ? (s >= t) : (s <= t);
                  attm[(d * 64 + t) * LDT + s] = (bf16)f2bf(keep ? acc[j][r] : 0.0f); } }
        __syncthreads();
        f32x4 o[4];
#pragma unroll
        for (int j = 0; j < 4; ++j) o[j] = (f32x4){0.f, 0.f, 0.f, 0.f};
#pragma unroll
        for (int d = 0; d < 2; ++d) {
#pragma unroll
            for (int ks = 0; ks < 2; ++ks) { const bf16x8 a1 = frag16(attm + d * 64 * LDT, LDT, 16 * mt, 32 * ks, lane), a2 = frag16(qt + d * 64 * LDT, LDT, 16 * mt, 32 * ks, lane);
#pragma unroll
                for (int j = 0; j < 4; ++j) { o[j] = MFMA16(a1, frag16(vT, LDT, 16 * (nt0 + j), 32 * ks, lane), o[j]); o[j] = MFMA16(a2, psp[d][ks][j], o[j]); } } }
        float ss[4];
#pragma unroll
        for (int r = 0; r < 4; ++r) { float s = 0.f;
#pragma unroll
            for (int j = 0; j < 4; ++j) s += o[j][r] * o[j][r];
            s += __shfl_xor(s, 1); s += __shfl_xor(s, 2); s += __shfl_xor(s, 4); s += __shfl_xor(s, 8); ss[r] = s; }
        if (cl == 0) {
#pragma unroll
            for (int r = 0; r < 4; ++r) red[(16 * mt + 4 * g4 + r) * 2 + (w & 1)] = ss[r]; }
        __syncthreads();
#pragma unroll
        for (int r = 0; r < 4; ++r) { const int tok = 16 * mt + 4 * g4 + r; const float rs = rsqrtf((red[tok * 2] + red[tok * 2 + 1]) * (1.0f / 128.0f) + EPS);
#pragma unroll
            for (int j = 0; j < 4; ++j) { const int dv = 16 * (nt0 + j) + cl; const float g = pg[j][r];
                MIX[(size_t)(t0 + tok) * DM + 1024 + hh * 128 + dv] = (bf16)f2bf(o[j][r] * rs * pog[j] * siluf_(g)); } }
    }
}
__device__ __forceinline__ void fft_a(const Frame& F_, const bf16* __restrict__ ZT, const bf16* __restrict__ DA, bf16* __restrict__ AT, int off) {
    const Frame F = fresh(F_);
    LAS bf16* DAs = (LAS bf16*)(F.lds + RING_OFF);
    LAS bf16* OT = (LAS bf16*)(F.lds + RING_OFF + 34816);
    const int lane = F.lane, w = F.wave, g4 = lane >> 4, cl = lane & 15;
    const bool full = (F.G == 256); const int b_ = F.bid;
    if (full && (b_ < 4 || b_ == 32 || b_ == 33 || b_ == 64 || b_ == 65)) return;
    const int istart = full ? b_ - (b_ > 65 ? 8 : b_ > 33 ? 6 : 4) : first_item(b_, F.G, off), istep = full ? 248 : F.G;
    __syncthreads();
#pragma unroll
    for (int k_ = 0; k_ < 4; ++k_) { const int e = F.tid + 512 * k_, r = e >> 4, cc = e & 15; *(LAS u32x4*)((LAS char*)DAs + r * 272 + cc * 16) = *(const u32x4*)(DA + r * 128 + cc * 8); }
    __syncthreads();
    for (int item = istart; item < 256; item += istep) {
        const int tg = item >> 4, jg = item & 15, t2 = 8 * tg + w, j0 = 32 * jg;
#pragma unroll 1
        for (int jt = 0; jt < 2; ++jt) {
            f32x4 acc[8];
#pragma unroll
            for (int mt = 0; mt < 8; ++mt) acc[mt] = (f32x4){0.f, 0.f, 0.f, 0.f};
#pragma unroll
            for (int ks = 0; ks < 4; ++ks) { const bf16x8 b = *(const bf16x8*)(ZT + ((size_t)((ks >> 1) * 128 + t2) * 512 + j0 + 16 * jt + cl) * 64 + (ks & 1) * 32 + 8 * g4);
#pragma unroll
                for (int mt = 0; mt < 8; ++mt) acc[mt] = MFMA16(frag16(DAs, 136, 16 * mt, 32 * ks, lane), b, acc[mt]); }
#pragma unroll
            for (int mt = 0; mt < 8; ++mt)
#pragma unroll
                for (int p = 0; p < 2; ++p) { const int k1 = 8 * mt + 2 * g4 + p; const float f = (float)((t2 * k1) & 8191) * (1.0f / 8192.0f); const float cw = __builtin_amdgcn_cosf(f), sw = __builtin_amdgcn_sinf(f);
                    const float re = acc[mt][2 * p], im = acc[mt][2 * p + 1]; const int m = 16 * mt + 4 * g4 + 2 * p, jl = 16 * jt + cl;
                    OT[(m * 32 + jl) * 8 + w] = (bf16)f2bf(re * cw + im * sw); OT[((m + 1) * 32 + jl) * 8 + w] = (bf16)f2bf(im * cw - re * sw); }
        }
        __syncthreads();
#pragma unroll
        for (int k_ = 0; k_ < 8; ++k_) { const int e = F.tid + 512 * k_, m = e >> 5, jl = e & 31; *(u32x4*)(AT + ((size_t)m * 512 + j0 + jl) * 128 + 8 * tg) = *(const LAS u32x4*)(OT + e * 8); }
        __syncthreads();
    }
}
__device__ __forceinline__ void fft_b(const Frame& F_, const bf16* __restrict__ AT, const bf16* __restrict__ DB, bf16* __restrict__ MIX, int off) {
    const Frame F = fresh(F_);
    LAS bf16* DBs = (LAS bf16*)(F.lds + RING_OFF);
    const int lane = F.lane, w = F.wave, g4 = lane >> 4, cl = lane & 15;
    __syncthreads();
#pragma unroll
    for (int k_ = 0; k_ < 8; ++k_) { const int e = F.tid + 512 * k_, r = e >> 5, cc = e & 31; *(LAS u32x4*)((LAS char*)DBs + r * 528 + cc * 16) = *(const u32x4*)(DB + r * 256 + cc * 8); }
    __syncthreads();
    for (int item = first_item(F.bid, F.G, off); item < 256; item += F.G) {
        const int k1 = item >> 2, j0 = 128 * (item & 3) + 16 * w;
        f32x4 acc[8];
#pragma unroll
        for (int mt = 0; mt < 8; ++mt) acc[mt] = (f32x4){0.f, 0.f, 0.f, 0.f};
        bf16x8 b[8];
#pragma unroll
        for (int ks = 0; ks < 8; ++ks) b[ks] = *(const bf16x8*)(AT + ((size_t)(k1 * 2 + (ks >> 2)) * 512 + j0 + cl) * 128 + (ks & 3) * 32 + 8 * g4);
#pragma unroll
        for (int ks = 0; ks < 8; ++ks) {
#pragma unroll
            for (int mt = 0; mt < 8; ++mt) acc[mt] = MFMA16(frag16(DBs, 264, 16 * mt, 32 * ks, lane), b[ks], acc[mt]);
            if (ks & 1) __builtin_amdgcn_sched_barrier(0); }
#pragma unroll
        for (int mt = 0; mt < 8; ++mt)
#pragma unroll
            for (int r = 0; r < 4; ++r) { const int k2 = 16 * mt + 4 * g4 + r; MIX[(size_t)(k1 + 64 * k2) * DM + 1536 + j0 + cl] = (bf16)f2bf(acc[mt][r] * (1.0f / 1024.0f)); }
    }
    __syncthreads();
}
__device__ __forceinline__ void mix_finalize(const Frame& F_, const float* __restrict__ OP, const float* __restrict__ ML, const float* __restrict__ YF, bf16* __restrict__ MIX) {
    const Frame F = fresh(F_);
    const int gt = F.bid * 512 + F.tid, NGT = F.G * 512;
    for (int i = gt; i < MR * 128; i += NGT) { const int t = i >> 7, h = (i >> 5) & 3, c = (i & 31) * 4; constexpr float C = att::SCALE * 1.4426950408889634f;
        const f32x4 o0 = *(const f32x4*)(OP + (size_t)t * 512 + h * 128 + c); const float m0 = ML[(size_t)t * 8 + h * 2], l0 = ML[(size_t)t * 8 + h * 2 + 1];
        f32x4 o;
        if (t < TL) { const f32x4 o1 = *(const f32x4*)(OP + ((size_t)MR + t) * 512 + h * 128 + c); const float m1 = ML[((size_t)MR + t) * 8 + h * 2], l1 = ML[((size_t)MR + t) * 8 + h * 2 + 1];
            const float M = fmaxf(m0, m1), w0 = __builtin_amdgcn_exp2f((m0 - M) * C), w1 = __builtin_amdgcn_exp2f((m1 - M) * C); const float inv = 1.0f / (l0 * w0 + l1 * w1);
            o = (o0 * w0 + o1 * w1) * inv; }
        else o = o0 * (1.0f / l0);
        u32x2 w; w.x = pk2(o.x, o.y); w.y = pk2(o.z, o.w); *(u32x2*)(MIX + (size_t)t * DM + 512 + h * 128 + c) = w; }
    for (int i = gt; i < TCX * 128; i += NGT) { const int t = TL + (i >> 7), c = (i & 127) * 4; const f32x4 y = *(const f32x4*)(YF + (size_t)t * 512 + c) * 0.005524271728019903f;
        u32x2 w; w.x = pk2(y.x, y.y); w.y = pk2(y.z, y.w); *(u32x2*)(MIX + (size_t)t * DM + 1536 + c) = w; }
}

__device__ __forceinline__ int LS(int v) { asm volatile("" : "+s"(v)); return v; }
constexpr int PTR_OFF = MISC_OFF + 128;
__device__ __forceinline__ unsigned long long lds_ptr(const Frame& F, int i) {
    const unsigned long long v = *(volatile LAS unsigned long long*)(F.lds + PTR_OFF + 8 * i);
    const unsigned lo = __builtin_amdgcn_readfirstlane((unsigned)v), hi = __builtin_amdgcn_readfirstlane((unsigned)(v >> 32));
    return ((unsigned long long)hi << 32) | lo;
}
constexpr int NPHASE = 2 + 13 * NLAY + 1;

#define INP(i) ((const float*)lds_ptr(F, (i)))
#define WSL() ((unsigned char*)lds_ptr(F, 22))
#define IN(k) (lo <= (k) && (k) < hi)
#if MK_ONE_LAUNCH
#define GRID_BAR() xcd_barrier(bar)
#else
#define GRID_BAR() do { } while (0)
#endif
#ifndef MK_PROBE
#define MK_PROBE 0
#endif
#if MK_PROBE
#define SEAMG(k, g) do { if (IN(k) && IN((k) + 1)) GRID_BAR(); if (F.bid == 0 && F.wave == 0 && lane_id() == 0) { unsigned long long* T = (unsigned long long*)(F.ctl + 2048); const unsigned long long now = __builtin_amdgcn_s_memrealtime(); T[(g)] += now - T[31]; T[31] = now; } } while (0)
#else
#define SEAMG(k, g) do { if (IN(k) && IN((k) + 1)) GRID_BAR(); } while (0)
#endif
#if MK_PROBE
#define SUBST(g) do { if (F.bid == 0 && F.wave == 0 && lane_id() == 0) { unsigned long long* T = (unsigned long long*)(F.ctl + 2048); const unsigned long long now = __builtin_amdgcn_s_memrealtime(); T[(g)] += now - T[31]; T[31] = now; } } while (0)
#else
#define SUBST(g) do { } while (0)
#endif
constexpr int W2_SPLIT = 1408;
constexpr int W13_SPLIT = 6752;
template <int s>
__device__ __forceinline__ void half_layer(const Frame& F, unsigned char* lds, const int lo, const int hi, const XcdBarrier& bar) {
        const int l = s >> 1, f = s & 1, pb = 2 + 13 * l + 10 * f;
        { const int j = f ? 2 : 0;
          if (IN(pb)) { unsigned char* ws = WSL(); const float* modl = (const float*)(ws + WS_MODV) + (size_t)(l * 2 + 0) * 9 * DM; const float* modc = modl + 9 * DM;
              const float* cg = f ? (modc + 5 * DM) : (modc - 2 * 9 * DM + 8 * DM);
              norm_phase<(f ? 8 : (l > 0 ? 11 : 0)), (s == 0)>(F, (s == 0) ? INP(0) : (const float*)(ws + WS_X), (float*)(ws + WS_X), (bf16*)(ws + WS_XN), INP(6) + (size_t)(l * 3 + j) * DM, modl + (3 * j) * DM, modl + (3 * j + 1) * DM, modc + (3 * j) * DM, modc + (3 * j + 1) * DM,
                         (const float*)(ws + WS_CP), cg, f ? 1.0f : 0.5f); SEAMG(pb, 1); }
          if (IN(pb + 1)) { unsigned char* ws = WSL();
              pg8::Gemm g{(const bf16*)(ws + WS_XN), (const bf16*)(ws + WS_W13T) + (size_t)(l * 2 + f) * 2 * FF * DM, DM}; pg8::StaticOrder S; S.init(MR, 2 * FF, DM / 64, LS(F.G), LS(F.bid));
              pg8::EpiSwiGLU E{(bf16*)(ws + WS_H), FF};
              pg8::gemm_phase<pg8::EpiSwiGLU, pg8::StaticOrder, true, true>(F.lds + RING_OFF, g, S, E, F.wave);
              if (s < 2 * NLAY - 1) {
                  const int G_ = LS(F.G), b_ = LS(F.bid), nwg = (MR / 256) * (2 * FF / 256), last0 = ((nwg - 1) / G_) * G_, nbusy = nwg - last0;
                  if (nbusy == G_) conv_w13(F, INP(8), (bf16*)(WSL() + WS_W13T), s + 1, b_, G_, 0, W13_SPLIT);
                  else if (b_ >= nbusy) conv_w13(F, INP(8), (bf16*)(WSL() + WS_W13T), s + 1, b_ - nbusy, G_ - nbusy, 0, W13_SPLIT); }
              SEAMG(pb + 1, 2); }
          if (IN(pb + 2)) { unsigned char* ws = WSL(); const float* modl = (const float*)(ws + WS_MODV) + (size_t)(l * 2 + 0) * 9 * DM;
              pg8::Gemm g{(const bf16*)(ws + WS_H), (const bf16*)(ws + WS_W2T) + (size_t)(l * 2 + f) * DM * FF, FF}; pg8::LatCtxOrder S; S.init(TL, DM, FF / 64, 11, LS(F.G), LS(F.bid)); if (l == NLAY - 1 && f == 1) S.nmini = 0;
              pg8::EpiResid<(s == 0)> E{(float*)(ws + WS_X), (s == 0) ? INP(0) : (const float*)(ws + WS_X), DM, modl + (3 * j + 2) * DM, 0.5f, TL / 256, (long)((WS_CP - WS_X) / 4)};
              pg8::gemm_phase<pg8::EpiResid<(s == 0)>, pg8::LatCtxOrder, true, true>(F.lds + RING_OFF, g, S, E, F.wave);
              if (s < 2 * NLAY - 1) {
                  const int G_ = LS(F.G), b_ = LS(F.bid), nmini = S.nmini;
                  if (nmini >= G_ || nmini == 0) conv_w13(F, INP(8), (bf16*)(WSL() + WS_W13T), s + 1, b_, G_, W13_SPLIT, 32 * 352);
                  else if (b_ >= nmini) conv_w13(F, INP(8), (bf16*)(WSL() + WS_W13T), s + 1, b_ - nmini, G_ - nmini, W13_SPLIT, 32 * 352); }
              SEAMG(pb + 2, 3); } }
        if (f == 0) {
            const int mb = pb + 3;
            if (IN(mb)) { unsigned char* ws = WSL(); const float* modl = (const float*)(ws + WS_MODV) + (size_t)(l * 2 + 0) * 9 * DM; const float* modc = modl + 9 * DM;
                norm_phase<11, false>(F, (const float*)(ws + WS_X), (float*)(ws + WS_X), (bf16*)(ws + WS_XN), INP(6) + (size_t)(l * 3 + 1) * DM, modl + 3 * DM, modl + 4 * DM, modc + 3 * DM, modc + 4 * DM, (const float*)(ws + WS_CP), modc + 2 * DM, 0.5f); SEAMG(mb, 1); }
            if (IN(mb + 1)) {
                unsigned char* ws = WSL();
                { pg8::Gemm g{(const bf16*)(ws + WS_XN), (const bf16*)(ws + WS_WINT) + (size_t)l * 4096 * DM, DM}; pg8::LatCtxOrder S; S.init(TL, 4096, DM / 64, 8, LS(F.G), LS(F.bid));
                  pg8::EpiP E{(float*)(ws + WS_P), PLD, (bf16*)(ws + WS_UF), (long)((WS_PP - WS_P) / 4), TL / 256};
                  pg8::gemm_phase<pg8::EpiP, pg8::LatCtxOrder, true, true>(F.lds + RING_OFF, g, S, E, F.wave);
                  const int G_ = LS(F.G), b_ = LS(F.bid), nmini = S.nmini;
                  if (nmini >= G_ || nmini == 0) { lr_phase(F, (const bf16*)(ws + WS_XN), (const bf16*)(ws + WS_WLRT) + (size_t)l * 32 * DM, (float*)(ws + WS_LR), b_, G_);
                      if (l < NLAY - 1) conv_w2(F, INP(9), (bf16*)(WSL() + WS_W2T), 2 * (l + 1), b_, G_, 0, W2_SPLIT); }
                  else if (b_ >= nmini) { lr_phase(F, (const bf16*)(ws + WS_XN), (const bf16*)(ws + WS_WLRT) + (size_t)l * 32 * DM, (float*)(ws + WS_LR), b_ - nmini, G_ - nmini);
                      if (l < NLAY - 1) conv_w2(F, INP(9), (bf16*)(WSL() + WS_W2T), 2 * (l + 1), b_ - nmini, G_ - nmini, 0, W2_SPLIT); } }
                SEAMG(mb + 1, 4); }
            if (IN(mb + 2)) {
                { unsigned char* ws = WSL(); ctx_p_reduce(F, (const float*)(ws + WS_PP), (float*)(ws + WS_P), (bf16*)(ws + WS_UF)); }
                SEAMG(mb + 2, 17); }
            if (IN(mb + 3)) {
                { unsigned char* ws = WSL(); pg8::Gemm g{(const bf16*)(ws + WS_ADFT1), (const bf16*)(ws + WS_UF), 512}; pg8::StaticOrder S; S.init(1024, MR, 8, LS(F.G), LS(F.bid)); pg8::EpiZT E{(bf16*)(ws + WS_ZT), (long)((WS_ZTC - WS_ZT) / 2)};
                  pg8::gemm_phase<pg8::EpiZT, pg8::StaticOrder, true, true>(F.lds + RING_OFF, g, S, E, F.wave); }
                SUBST(9);
                { unsigned char* ws = WSL(); qkv_prep(F, (const float*)(ws + WS_P), INP(17) + (size_t)l * 256, (const float*)(ws + WS_ROPE), (bf16*)(ws + WS_QB), (bf16*)(ws + WS_KB), (bf16*)(ws + WS_VB)); }
                SUBST(10);
                { unsigned char* ws = WSL(); lru_pass<false>(F, (const float*)(ws + WS_P), INP(12) + (size_t)l * 4 * 512, INP(13) + (size_t)l * 512, (const bf16*)(ws + WS_WGT) + (size_t)l * 32 * 4096, INP(15) + (size_t)l * 2 * 2 * 512, INP(16) + (size_t)l * 2 * 512,
                        (float*)(ws + WS_ATOT), (float*)(ws + WS_HEND), nullptr, nullptr, 132, NCHUNK * 4); }
                SUBST(11);
                { unsigned char* ws = WSL(); gla_a(F, (const float*)(ws + WS_P), (const float*)(ws + WS_LR), INP(18) + (size_t)l * 2 * 16 * 256, INP(19) + (size_t)l * 2 * 256, (float*)(ws + WS_BC), (float*)(ws + WS_DS), (float*)(ws + WS_DEC), 148); }
                SUBST(12);
                SEAMG(mb + 3, 5); }
            if (IN(mb + 4)) {
                { unsigned char* ws = WSL(); const bf16* QB = (const bf16*)(ws + WS_QB); const bf16* KB = (const bf16*)(ws + WS_KB); const bf16* VB = (const bf16*)(ws + WS_VB); float* OP = (float*)(ws + WS_OP); float* ML = (float*)(ws + WS_ML);
                  int bid_ = F.bid; asm volatile("" : "+s"(bid_));
                  const int G_ = LS(F.G);
                  for (int L = bid_; L < ((l == NLAY - 1) ? 256 : 260); L += G_) {
                    const bf16 *q, *k, *v; float *o, *ml; int seq;
                    if (L < 256) { const int xcd = L & 7, j = L >> 3, combo = xcd >> 1, kvh = combo >> 1, sp = combo & 1, idx = (xcd & 1) * 32 + j, h = kvh * 2 + (idx >> 5), qb = idx & 31;
                        q = QB + (size_t)(qb * 256) * 512 + h * 128; k = KB + (size_t)(sp * 4224) * 256 + kvh * 128; v = VB + (size_t)(sp * 4224) * 256 + kvh * 128;
                        o = OP + ((size_t)sp * MR + qb * 256) * 512 + h * 128; ml = ML + ((size_t)sp * MR + qb * 256) * 8 + h * 2; seq = 4224; }
                    else { const int h = L - 256, kvh = h >> 1;
                        q = QB + (size_t)TL * 512 + h * 128; k = KB + (size_t)TL * 256 + kvh * 128; v = VB + (size_t)TL * 256 + kvh * 128;
                        o = OP + (size_t)TL * 512 + h * 128; ml = ML + (size_t)TL * 8 + h * 2; seq = TCX; }
                    __syncthreads();
                    att::attn_unit(q, k, v, o, ml, seq, (char*)lds + RING_OFF, F.wave);
                  }
                  __syncthreads(); }
                SUBST(15);
                { unsigned char* ws = WSL(); fft_a(F, (const bf16*)(ws + WS_ZT), (const bf16*)(ws + WS_DA), (bf16*)(ws + WS_AT), 4); }
                { unsigned char* ws = WSL(); pg8::Gemm g{(const bf16*)(ws + WS_ADFTC), (const bf16*)(ws + WS_ZTC), 512}; pg8::SplitOrder S; S.init(TCX, 512, 1, 8, LS(F.G), first_item(LS(F.bid), LS(F.G), 32)); pg8::EpiYF E{(float*)(ws + WS_YF), TL, (size_t)MR * 512};
                  pg8::gemm_phase<pg8::EpiYF, pg8::SplitOrder, true, true>(F.lds + RING_OFF, g, S, E, F.wave); }
                SUBST(16);
                { unsigned char* ws = WSL(); lru_b(F, 64, (const float*)(ws + WS_ATOT), (const float*)(ws + WS_HEND), (float*)(ws + WS_CIN)); }
                { unsigned char* ws = WSL(); gla_b(F, (const float*)(ws + WS_DS), (const float*)(ws + WS_DEC), (bf16*)(ws + WS_SP)); }
                SEAMG(mb + 4, 6); }
            if (IN(mb + 5)) {
                { unsigned char* ws = WSL(); lru_pass<true>(F, (const float*)(ws + WS_P), INP(12) + (size_t)l * 4 * 512, INP(13) + (size_t)l * 512, (const bf16*)(ws + WS_WGT) + (size_t)l * 32 * 4096, INP(15) + (size_t)l * 2 * 2 * 512, INP(16) + (size_t)l * 2 * 512,
                        nullptr, nullptr, (const float*)(ws + WS_CIN), (bf16*)(ws + WS_MIX), 0, (l == NLAY - 1) ? 512 : NCHUNK * 4); }
                SUBST(13);
                { unsigned char* ws = WSL(); gla_c(F, (const float*)(ws + WS_P), (const float*)(ws + WS_BC), (const bf16*)(ws + WS_SP), INP(20) + (size_t)l * 128, (bf16*)(ws + WS_MIX), 16, (l == NLAY - 1) ? 512 : NCHUNK * 4); }
                SUBST(14);
                { unsigned char* ws = WSL(); fft_b(F, (const bf16*)(ws + WS_AT), (const bf16*)(ws + WS_DB), (bf16*)(ws + WS_MIX), 32); }
                { unsigned char* ws = WSL(); mix_finalize(F, (const float*)(ws + WS_OP), (const float*)(ws + WS_ML), (const float*)(ws + WS_YF), (bf16*)(ws + WS_MIX)); }
                SEAMG(mb + 5, 7); }
            if (IN(mb + 6)) {
                unsigned char* ws = WSL(); const float* modl = (const float*)(ws + WS_MODV) + (size_t)(l * 2 + 0) * 9 * DM;
                pg8::Gemm g{(const bf16*)(ws + WS_MIX), (const bf16*)(ws + WS_WOUTT) + (size_t)l * DM * DM, DM}; pg8::LatCtxOrder S; S.init(TL, DM, DM / 64, 8, LS(F.G), LS(F.bid)); if (l == NLAY - 1) S.nmini = 0;
                pg8::EpiResid<false> E{(float*)(ws + WS_X), (const float*)(ws + WS_X), DM, modl + 5 * DM, 1.0f, TL / 256, (long)((WS_CP - WS_X) / 4)};
                pg8::gemm_phase<pg8::EpiResid<false>, pg8::LatCtxOrder, true, true>(F.lds + RING_OFF, g, S, E, F.wave);
                if (l < NLAY - 1) { const int G_ = LS(F.G), b_ = LS(F.bid), nmini = S.nmini;
                    if (nmini >= G_ || nmini == 0) conv_w2(F, INP(9), (bf16*)(WSL() + WS_W2T), 2 * (l + 1), b_, G_, W2_SPLIT, 88 * 64);
                    else if (b_ >= nmini) conv_w2(F, INP(9), (bf16*)(WSL() + WS_W2T), 2 * (l + 1), b_ - nmini, G_ - nmini, W2_SPLIT, 88 * 64); }
                SEAMG(mb + 6, 8); }
        }
    }
struct Args { const float* in[21]; float* out; unsigned char* ws; int ph_lo, ph_hi; };
static_assert(sizeof(Args) == 21 * 8 + 8 + 8 + 8, "Args has no padding");

__global__ void __launch_bounds__(NWAVES * 64, 2) fwd_kernel(Args args) {
    extern __shared__ __attribute__((aligned(16))) unsigned char lds[];
    Frame F;
    F.lds = (LAS unsigned char*)lds; F.gl = lds;
    F.MISC = (volatile LAS unsigned*)(F.lds + MISC_OFF);
    { const int t0_ = threadIdx.x; F.tid = t0_; F.lane = t0_ & 63; F.wave = __builtin_amdgcn_readfirstlane(t0_ >> 6); }
    F.G = gridDim.x; F.bid = blockIdx.x;
    F.ctl = (gu32*)(args.ws + WS_CTL);
    for (int u = F.tid; u < (LDS_BYTES - LDSCTL_OFF) / 4; u += NWAVES * 64) ((LAS unsigned*)(F.lds + LDSCTL_OFF))[u] = 0u;
    __syncthreads();
    if (F.tid < 21) ((LAS unsigned long long*)(F.lds + PTR_OFF))[F.tid] = (unsigned long long)args.in[F.tid];
    if (F.tid == 21) ((LAS unsigned long long*)(F.lds + PTR_OFF))[21] = (unsigned long long)args.out;
    if (F.tid == 22) ((LAS unsigned long long*)(F.lds + PTR_OFF))[22] = (unsigned long long)args.ws;
    __syncthreads();
#if MK_ONE_LAUNCH
    const XcdBarrier bar = xcd_barrier_post((unsigned*)(F.ctl + CW_BAR), F.MISC + 8, (unsigned)F.wave);
#else
    XcdBarrier bar; bar.bar = nullptr; bar.x = 0; bar.st = nullptr; bar.wv = 0;
#endif
    const int lo = args.ph_lo, hi = args.ph_hi;
#if MK_PROBE
    if (F.bid == 0 && F.wave == 0 && lane_id() == 0) { unsigned long long* T = (unsigned long long*)(F.ctl + 2048); T[31] = __builtin_amdgcn_s_memrealtime(); }
#endif

    if (IN(0) || IN(1)) {
        In I; I.x = INP(0); I.c = INP(1); I.ctx = INP(2); I.c_ctx = INP(3); I.mod_w = INP(4); I.mod_b = INP(5); I.norm_g = INP(6); I.final_g = INP(7);
        I.ffn_w13 = INP(8); I.ffn_w2 = INP(9); I.w_in = INP(10); I.w_out = INP(11); I.lru_conv_w = INP(12); I.lru_conv_b = INP(13); I.lru_gate_w = INP(14);
        I.lru_gate_b = INP(15); I.lru_lambda = INP(16); I.attn_qk_g = INP(17); I.gla_gate_w = INP(18); I.gla_gate_b = INP(19); I.gla_out_g = INP(20);
        if (IN(0)) { prologue_a(F, I, WSL()); SEAMG(0, 0); }
        if (IN(1)) { prologue_b(F, I, WSL()); SEAMG(1, 0); }
    }

    half_layer<0>(F, lds, lo, hi, bar); half_layer<1>(F, lds, lo, hi, bar); half_layer<2>(F, lds, lo, hi, bar); half_layer<3>(F, lds, lo, hi, bar);
    half_layer<4>(F, lds, lo, hi, bar); half_layer<5>(F, lds, lo, hi, bar); half_layer<6>(F, lds, lo, hi, bar); half_layer<7>(F, lds, lo, hi, bar);
    if (IN(NPHASE - 1)) { unsigned char* ws = WSL(); float pa = 0.f, pb_ = 0.f;
#if MK_PROBE
        { const unsigned long long* T = (const unsigned long long*)(F.ctl + 2048); unsigned long long tot = 0; for (int g = 0; g < 24; ++g) tot += T[g];
          unsigned long long sel = 0; for (int g = 0; g < 24; ++g) if ((MK_PROBE_A >> g) & 1) sel += T[g]; pb_ = 20.0f * (float)sel / (float)tot; }
#endif
        final_norm(F, (const float*)(ws + WS_X), (float*)lds_ptr(F, 21), INP(7), pa, pb_); }
#undef IN
#undef SEAMG
}

extern "C" void kernel_launch(void* const* d_in, const int* in_sizes, int n_in, void* d_out, int out_size, void* d_ws, size_t ws_size, hipStream_t stream) {
    static int grid = 0;
    if (grid == 0) {
        if (n_in != 21 || in_sizes[0] != TL * DM || out_size != TL * DM || ws_size < WS_END) {
            fprintf(stderr, "kernel_launch: unexpected shapes: n_in %d in0 %d out %d ws %zu (need %zu); nothing launched\n", n_in, n_in > 0 ? in_sizes[0] : -1, out_size, ws_size, (size_t)WS_END); grid = -1; return; }
        int dev = 0, cus = 0, per_cu = 0;
        if (hipGetDevice(&dev) != hipSuccess || hipDeviceGetAttribute(&cus, hipDeviceAttributeMultiprocessorCount, dev) != hipSuccess) { fprintf(stderr, "kernel_launch: device query failed\n"); grid = -1; return; }
        if (hipFuncSetAttribute((const void*)fwd_kernel, hipFuncAttributeMaxDynamicSharedMemorySize, LDS_BYTES) != hipSuccess) { fprintf(stderr, "kernel_launch: hipFuncSetAttribute failed\n"); grid = -1; return; }
        if (hipOccupancyMaxActiveBlocksPerMultiprocessor(&per_cu, (const void*)fwd_kernel, NWAVES * 64, LDS_BYTES) != hipSuccess || per_cu < 1)
            fprintf(stderr, "kernel_launch: note: occupancy query reports %d workgroups per CU\n", per_cu);
        (void)hipGetLastError();
        grid = cus;
    }
    if (grid < 0) return;
    if (hipMemsetAsync((char*)d_ws + WS_CTL, 0, CTL_ZERO_BYTES, stream) != hipSuccess) { fprintf(stderr, "kernel_launch: memset failed\n"); return; }
    Args a{};
    for (int i = 0; i < 21; ++i) a.in[i] = (const float*)d_in[i];
    a.out = (float*)d_out; a.ws = (unsigned char*)d_ws;
#if MK_ONE_LAUNCH
    a.ph_lo = 0; a.ph_hi = NPHASE;
    hipLaunchKernelGGL(fwd_kernel, dim3(grid), dim3(NWAVES * 64), LDS_BYTES, stream, a);
#else
    for (int ph = 0; ph < NPHASE; ++ph) { a.ph_lo = ph; a.ph_hi = ph + 1; hipLaunchKernelGGL(fwd_kernel, dim3(grid), dim3(NWAVES * 64), LDS_BYTES, stream, a); }
#endif
    const hipError_t le = hipPeekAtLastError();
    if (le != hipSuccess) fprintf(stderr, "kernel_launch: launch failed: %s\n", hipGetErrorName(le));
}
```

```cpp
#include <hip/hip_runtime.h>
#include <cstdio>
#include <cstdint>

#ifndef MK_ONE_LAUNCH
#define MK_ONE_LAUNCH 1
#endif

constexpr int DM = 2048, TL = 8192, TCX = 256, MR = TL + TCX, FF = 5632, NLAY = 4, DIN = 4128, NCHUNK = MR / 64;
constexpr int PLD = 3584;
constexpr int PC_LX = 0, PC_LG = 512, PC_Q = 1024, PC_K = 1536, PC_V = 1792, PC_GQ = 2048, PC_GK = 2304, PC_GV = 2560, PC_GG = 3072;
constexpr float EPS = 1e-6f;

constexpr size_t al256(size_t x) { return (x + 255) / 256 * 256; }
constexpr size_t WS_CTL = 0, CTL_ZERO_BYTES = 1u << 20;
constexpr size_t WS_MODV = WS_CTL + CTL_ZERO_BYTES;
constexpr size_t WS_W13T = al256(WS_MODV + (size_t)NLAY * 2 * 9 * DM * 4);
constexpr size_t WS_W2T  = al256(WS_W13T + (size_t)8 * 2 * FF * DM * 2);
constexpr size_t WS_WINT = al256(WS_W2T + (size_t)8 * DM * FF * 2);
constexpr size_t WS_WLRT = al256(WS_WINT + (size_t)4 * 4096 * DM * 2);
constexpr size_t WS_WOUTT = al256(WS_WLRT + (size_t)4 * 32 * DM * 2);
constexpr size_t WS_DA = al256(WS_WOUTT + (size_t)4 * DM * DM * 2);
constexpr size_t WS_DB = al256(WS_DA + (size_t)128 * 128 * 2);
constexpr size_t WS_AT = al256(WS_DB + (size_t)128 * 256 * 2);
constexpr size_t WS_ADFTC = al256(WS_AT + (size_t)64 * 2 * 512 * 128 * 2);
constexpr size_t WS_ADFT1 = al256(WS_ADFTC + (size_t)TCX * 2 * TCX * 2);
constexpr size_t WS_ROPE = al256(WS_ADFT1 + (size_t)1024 * 512 * 2);
constexpr size_t WS_X = al256(WS_ROPE + (size_t)2 * 128 * 32 * 4);
constexpr size_t WS_XN = al256(WS_X + (size_t)MR * DM * 4);
constexpr size_t WS_H = al256(WS_XN + (size_t)MR * DM * 2);
constexpr size_t WS_P = al256(WS_H + (size_t)MR * FF * 2);
constexpr size_t WS_UF = al256(WS_P + (size_t)MR * PLD * 4);
constexpr size_t WS_LR = al256(WS_UF + (size_t)MR * 512 * 2);
constexpr size_t WS_QB = al256(WS_LR + (size_t)MR * 32 * 4);
constexpr size_t WS_KB = al256(WS_QB + (size_t)MR * 512 * 2);
constexpr size_t WS_VB = al256(WS_KB + (size_t)MR * 256 * 2);
constexpr size_t WS_OP = al256(WS_VB + (size_t)MR * 256 * 2);
constexpr size_t WS_ML = al256(WS_OP + (size_t)2 * MR * 512 * 4);
constexpr size_t WS_HL = al256(WS_ML + (size_t)2 * MR * 4 * 2 * 4);
constexpr size_t WS_AC = al256(WS_HL + (size_t)2 * MR * 512 * 4);
constexpr size_t WS_ATOT = al256(WS_AC + (size_t)2 * MR * 512 * 4);
constexpr size_t WS_HEND = al256(WS_ATOT + (size_t)2 * NCHUNK * 512 * 4);
constexpr size_t WS_CIN = al256(WS_HEND + (size_t)2 * NCHUNK * 512 * 4);
constexpr size_t WS_BC = al256(WS_CIN + (size_t)2 * NCHUNK * 512 * 4);
constexpr size_t WS_DS = al256(WS_BC + (size_t)2 * MR * 256 * 4);
constexpr size_t WS_SP = al256(WS_DS + (size_t)NCHUNK * 4 * 2 * 64 * 128 * 4);
constexpr size_t WS_DEC = al256(WS_SP + (size_t)NCHUNK * 4 * 2 * 64 * 128 * 4);
constexpr size_t WS_ZT = al256(WS_DEC + (size_t)NCHUNK * 4 * 2 * 64 * 4);
constexpr size_t WS_ZTC = al256(WS_ZT + (size_t)512 * 16384 * 2);
constexpr size_t WS_YF = al256(WS_ZTC + (size_t)512 * 512 * 2);
constexpr size_t WS_MIX = al256(WS_YF + (size_t)4 * MR * 512 * 4);
constexpr size_t WS_CP = al256(WS_MIX + (size_t)MR * DM * 2);
constexpr size_t WS_PP = al256(WS_CP + (size_t)11 * TCX * DM * 4);
constexpr size_t WS_WGT = al256(WS_PP + (size_t)8 * TCX * 4096 * 4);
constexpr size_t WS_END = al256(WS_WGT + (size_t)4 * 32 * 4096 * 2);

constexpr int CW_TMO = 0, CW_CODE = 1, CW_BAR = 4096;

constexpr int RING_OFF = 0, RING_BYTES = 131072;
constexpr int LDSCTL_OFF = RING_BYTES, MISC_OFF = LDSCTL_OFF + 320;
constexpr int LDS_BYTES = 147456;
constexpr int NWAVES = 8;

#define GAS __attribute__((address_space(1)))
#define LAS __attribute__((address_space(3)))
typedef unsigned short bf16;
typedef float f32x4 __attribute__((ext_vector_type(4)));
typedef float f32x2 __attribute__((ext_vector_type(2)));
typedef unsigned u32x4 __attribute__((ext_vector_type(4)));
typedef unsigned u32x2 __attribute__((ext_vector_type(2)));
typedef GAS unsigned gu32;
#define RLX_AGENT __ATOMIC_RELAXED, __HIP_MEMORY_SCOPE_AGENT
#define LDS_WAIT() asm volatile("s_waitcnt lgkmcnt(0)" ::: "memory")
#define VM_WAIT() asm volatile("s_waitcnt vmcnt(0)" ::: "memory")
__device__ __forceinline__ unsigned f2bf(float f) { unsigned u = __builtin_bit_cast(unsigned, f); return (u + 0x7fffu + ((u >> 16) & 1u)) >> 16; }
__device__ __forceinline__ unsigned pk2(float lo, float hi) { return f2bf(lo) | (f2bf(hi) << 16); }
__device__ __forceinline__ int lane_id() { return (int)__builtin_amdgcn_mbcnt_hi(~0u, __builtin_amdgcn_mbcnt_lo(~0u, 0u)); }
__device__ __forceinline__ float wave_sum(float v) {
#pragma unroll
    for (int o = 1; o < 64; o <<= 1) v += __shfl_xor(v, o);
    return v;
}
__device__ __forceinline__ float sigmoidf_(float x) { return __builtin_amdgcn_rcpf(1.0f + __expf(-x)); }
__device__ __forceinline__ float siluf_(float x) { return x * __builtin_amdgcn_rcpf(1.0f + __expf(-x)); }
__device__ __forceinline__ float gelu_tanh_(float x) { const float u = 0.7978845608028654f * (x + 0.044715f * x * x * x); return x * __builtin_amdgcn_rcpf(1.0f + __expf(-2.0f * u)); }
__device__ __forceinline__ float one_minus_exp_(float x) {
    const float ser = -x * (1.0f + 0.5f * x * (1.0f + (1.0f / 3.0f) * x * (1.0f + 0.25f * x * (1.0f + 0.2f * x * (1.0f + (1.0f / 6.0f) * x)))));
    return (x > -0.5f) ? ser : (1.0f - __expf(x)); }
__device__ __forceinline__ int first_item(int bid, int G, int off) { int r = (bid - off) % G; return r < 0 ? r + G : r; }

namespace pg8 {
#define PG8_LAS __attribute__((address_space(3)))
#define PG8_GAS __attribute__((address_space(1)))
typedef unsigned short bf16_t;
typedef short bf16x8 __attribute__((ext_vector_type(8)));
typedef float f32x4 __attribute__((ext_vector_type(4)));
typedef unsigned u32x4 __attribute__((ext_vector_type(4)));
constexpr int BM = 256, BK = 64, HALF = 128, HTB = HALF * BK * 2  , STAGE_BYTES = 8 * HTB, NXCD = 8, WGM = 8;

__host__ __device__ __forceinline__ int lds_byte(int r, int c) { const int st = (r >> 4) * 2 + (c >> 5), rr = r & 15, cc = c & 31, ob = rr * 64 + cc * 2; return st * 1024 + (ob ^ (((ob >> 9) & 1) << 5)); }
__host__ __device__ __forceinline__ void stage_rc(int b, int& R, int& C) { const int st = b / 1024, sb = b % 1024, swz = sb ^ (((sb >> 9) & 1) << 5); R = (st >> 1) * 16 + swz / 64; C = (st & 1) * 32 + (swz % 64) / 2; }
__host__ __device__ __forceinline__ int perm32(int rho) { const int n = rho >> 4, i = rho & 15; return 8 * (i >> 2) + 4 * n + (i & 3); }

struct Unit { int pm, pn, kt0, nt; };
struct Gemm { const bf16_t* A; const bf16_t* Bt; int K; };

struct StaticOrder {
    int nM, nN, nwg, G, c, nt;
    __host__ __device__ void init(int M, int N, int nt_, int G_, int c_) { nM = M / BM; nN = N / BM; nwg = nM * nN; G = G_; c = c_; nt = nt_; }
    __host__ __device__ bool next(int i, Unit& u) const {
        const long L = (long)i * G + c; if (L >= nwg) return false;
        int wgid = (int)L; { const int q = nwg / NXCD, r = nwg % NXCD, xcd = wgid % NXCD, off = wgid / NXCD; wgid = (xcd < r ? xcd * (q + 1) : r * (q + 1) + (xcd - r) * q) + off; }
        const int nig = WGM * nN, gid = wgid / nig, fm = gid * WGM, gsz = (nM - fm) < WGM ? (nM - fm) : WGM;
        u.pm = fm + ((wgid % nig) % gsz); u.pn = (wgid % nig) / gsz; u.kt0 = 0; u.nt = nt; return true;
    }
    __device__ __forceinline__ void a_ready(const Unit&) const {}
    __device__ __forceinline__ void done(const Unit&) const {}
};
struct SplitOrder {
    int nM, nN, nS, total, G, c, nt;
    __host__ __device__ void init(int M, int N, int nS_, int nt_, int G_, int c_) { nM = M / BM; nN = N / BM; nS = nS_; total = nM * nN * nS; G = G_; c = c_; nt = nt_; }
    __host__ __device__ bool next(int i, Unit& u) const {
        const long L = (long)i * G + c; if (L >= total) return false;
        const int l = (int)L; u.pm = l % nM; const int r = l / nM; u.pn = r % nN; u.kt0 = (r / nN) * nt; u.nt = nt; return true;
    }
    __device__ __forceinline__ void a_ready(const Unit&) const {}
    __device__ __forceinline__ void done(const Unit&) const {}
};

struct LatCtxOrder {
    StaticOrder lat; int nNc, nmini, ntm, cpm;
    __host__ __device__ void init(int Mlat, int N, int nt_, int nslices, int G_, int c_) { lat.init(Mlat, N, nt_, G_, c_); nNc = N / BM; ntm = nt_ / nslices; nmini = nNc * nslices; cpm = Mlat / BM; }
    __host__ __device__ bool next(int i, Unit& u) const {
        if (lat.next(i, u)) return true;
        const long m = (long)i * lat.G + lat.c - lat.nwg; if (m < 0 || m >= nmini) return false;
        u.pm = cpm; u.pn = (int)m % nNc; u.kt0 = ((int)m / nNc) * ntm; u.nt = ntm; return true;
    }
    __device__ __forceinline__ void a_ready(const Unit&) const {}
    __device__ __forceinline__ void done(const Unit&) const {}
};

__device__ __forceinline__ unsigned cvt_pk_bf16(float lo, float hi) { unsigned r; asm volatile("v_cvt_pk_bf16_f32 %0, %1, %2" : "=v"(r) : "v"(lo), "v"(hi)); return r; }


struct EpiSwiGLU {
    static constexpr bool PERM = true, AFTER_DRAIN = false;
    bf16_t* H; int ldh;
    __device__ __forceinline__ void operator()(const f32x4 (&acc)[2][2][4][2], const Unit& u, int wr, int wc, int fr, int fq) const {
        const int row0 = u.pm * BM + wr * 64 + fr, col0 = u.pn * HALF + wc * 32 + 8 * fq;
#pragma unroll
        for (int ai = 0; ai < 2; ++ai)
#pragma unroll
            for (int m = 0; m < 4; ++m) { bf16_t* rowp = H + (size_t)(row0 + ai * HALF + m * 16) * ldh + col0;
                float o[8];
#pragma unroll
                for (int n = 0; n < 2; ++n)
#pragma unroll
                    for (int i = 0; i < 4; ++i) { const float gt = acc[ai][0][m][n][i], up = acc[ai][1][m][n][i]; o[4 * n + i] = gt * __builtin_amdgcn_rcpf(1.0f + __expf(-gt)) * up; }
                u32x4 w; w.x = cvt_pk_bf16(o[0], o[1]); w.y = cvt_pk_bf16(o[2], o[3]); w.z = cvt_pk_bf16(o[4], o[5]); w.w = cvt_pk_bf16(o[6], o[7]);
                *(PG8_GAS u32x4*)rowp = w; }
    }
};
template <bool FIRST>
struct EpiResid {
    static constexpr bool PERM = true, AFTER_DRAIN = false;
    float* X; const float* Xin; int ldx; const float* gl; float coef; int ctx_pm; long cp_delta;
    __device__ __forceinline__ void operator()(const f32x4 (&acc)[2][2][4][2], const Unit& u, int wr, int wc, int fr, int fq) const {
        const int col0 = u.pn * BM + wc * 32 + 8 * fq;
        if (u.pm == ctx_pm) {
            float* base = X + cp_delta + (size_t)(u.kt0 / u.nt) * 256 * ldx + (size_t)(wr * 64 + fr) * ldx + col0;
#pragma unroll
            for (int ai = 0; ai < 2; ++ai)
#pragma unroll
                for (int m = 0; m < 4; ++m) { float* rowp = base + (size_t)(ai * HALF + m * 16) * ldx;
#pragma unroll
                    for (int bj = 0; bj < 2; ++bj)
#pragma unroll
                        for (int n = 0; n < 2; ++n) *(PG8_GAS f32x4*)(rowp + bj * HALF + n * 4) = acc[ai][bj][m][n]; }
            return; }
        const int row0 = u.pm * BM + wr * 64 + fr;
        const float* gate = gl;
        f32x4 gv[2][2];
#pragma unroll
        for (int bj = 0; bj < 2; ++bj)
#pragma unroll
            for (int n = 0; n < 2; ++n) gv[bj][n] = *(const PG8_GAS f32x4*)(gate + col0 + bj * HALF + n * 4) * coef;
        constexpr int MB = FIRST ? 2 : 4;
#pragma unroll
        for (int aim = 0; aim < 2 * (4 / MB); ++aim) { const int ai = aim / (4 / MB), m0 = (aim % (4 / MB)) * MB;
            u32x4 p[4][2]; f32x4 q[4][2][2];
#pragma unroll
            for (int m = m0; m < m0 + MB; ++m) { const size_t ro = (size_t)(row0 + ai * HALF + m * 16) * ldx + col0; const bf16_t* rowp = (const bf16_t*)X + ro; const float* rowi = Xin + ro;
#pragma unroll
                for (int bj = 0; bj < 2; ++bj) {
                    if (FIRST) { q[m][bj][0] = *(const PG8_GAS f32x4*)(rowi + bj * HALF); q[m][bj][1] = *(const PG8_GAS f32x4*)(rowi + bj * HALF + 4); }
                    else p[m][bj] = *(const PG8_GAS u32x4*)(rowp + bj * HALF); } }
#pragma unroll
            for (int m = m0; m < m0 + MB; ++m) { const size_t ro = (size_t)(row0 + ai * HALF + m * 16) * ldx + col0; bf16_t* rowp = (bf16_t*)X + ro;
#pragma unroll
                for (int bj = 0; bj < 2; ++bj) { f32x4 o0, o1;
                    if (FIRST) { o0 = q[m][bj][0]; o1 = q[m][bj][1]; }
                    else { const u32x4 pp = p[m][bj];
                        o0[0] = __builtin_bit_cast(float, pp.x << 16); o0[1] = __builtin_bit_cast(float, pp.x & 0xffff0000u); o0[2] = __builtin_bit_cast(float, pp.y << 16); o0[3] = __builtin_bit_cast(float, pp.y & 0xffff0000u);
                        o1[0] = __builtin_bit_cast(float, pp.z << 16); o1[1] = __builtin_bit_cast(float, pp.z & 0xffff0000u); o1[2] = __builtin_bit_cast(float, pp.w << 16); o1[3] = __builtin_bit_cast(float, pp.w & 0xffff0000u); }
                    o0 += gv[bj][0] * acc[ai][bj][m][0]; o1 += gv[bj][1] * acc[ai][bj][m][1];
                    u32x4 w; w.x = cvt_pk_bf16(o0[0], o0[1]); w.y = cvt_pk_bf16(o0[2], o0[3]); w.z = cvt_pk_bf16(o1[0], o1[1]); w.w = cvt_pk_bf16(o1[2], o1[3]); *(PG8_GAS u32x4*)(rowp + bj * HALF) = w; } }
            asm volatile("" ::: "memory"); }
    }
};
struct EpiP {
    static constexpr bool PERM = false, AFTER_DRAIN = false;
    float* P; int ldp; bf16_t* UF; long pp_delta; int ctx_pm;
    __device__ __forceinline__ void operator()(const f32x4 (&acc)[2][2][4][2], const Unit& u, int wr, int wc, int fr, int fq) const {
        const int row0 = u.pm * BM + wr * 64 + fr;
        if (u.pm == ctx_pm) {
            float* base = P + pp_delta + (size_t)(u.kt0 / u.nt) * 256 * 4096 + (size_t)(wr * 64 + fr) * 4096 + u.pn * BM + wc * 32 + 4 * fq;
#pragma unroll
            for (int ai = 0; ai < 2; ++ai)
#pragma unroll
                for (int m = 0; m < 4; ++m) { float* rowp = base + (size_t)(ai * HALF + m * 16) * 4096;
#pragma unroll
                    for (int bj = 0; bj < 2; ++bj)
#pragma unroll
                        for (int n = 0; n < 2; ++n) *(PG8_GAS f32x4*)(rowp + bj * HALF + n * 16) = acc[ai][bj][m][n]; }
        } else if (u.pn < 14) {
            const int col0 = u.pn * BM + wc * 32 + 4 * fq;
#pragma unroll
            for (int ai = 0; ai < 2; ++ai)
#pragma unroll
                for (int m = 0; m < 4; ++m) { float* rowp = P + (size_t)(row0 + ai * HALF + m * 16) * ldp + col0;
#pragma unroll
                    for (int bj = 0; bj < 2; ++bj)
#pragma unroll
                        for (int n = 0; n < 2; ++n) *(PG8_GAS f32x4*)(rowp + bj * HALF + n * 16) = acc[ai][bj][m][n]; }
        } else {
            const int col0 = (u.pn - 14) * BM + wc * 32 + 4 * fq;
#pragma unroll
            for (int ai = 0; ai < 2; ++ai)
#pragma unroll
                for (int m = 0; m < 4; ++m) { const int rr = row0 + ai * HALF + m * 16; bf16_t* rowp = UF + (size_t)(((rr & 127) << 6) | (rr >> 7)) * 512 + col0;
#pragma unroll
                    for (int bj = 0; bj < 2; ++bj)
#pragma unroll
                        for (int n = 0; n < 2; ++n) { const f32x4 v = acc[ai][bj][m][n]; u32x2 w; w.x = cvt_pk_bf16(v[0], v[1]); w.y = cvt_pk_bf16(v[2], v[3]); *(PG8_GAS u32x2*)(rowp + bj * HALF + n * 16) = w; } }
        }
    }
};
struct EpiZT {
    static constexpr bool PERM = true, AFTER_DRAIN = false;
    bf16_t* ZT; long ztc_delta;
    __device__ __forceinline__ void operator()(const f32x4 (&acc)[2][2][4][2], const Unit& u, int wr, int wc, int fr, int fq) const {
        const int row0 = u.pm * BM + wr * 64 + fr; const bool ctx = (u.pn == 32);
        const int col0 = (ctx ? 0 : u.pn * BM) + wc * 32 + 8 * fq;
#pragma unroll
        for (int ai = 0; ai < 2; ++ai)
#pragma unroll
            for (int m = 0; m < 4; ++m) { const int r = row0 + ai * HALF + m * 16, cs = r >> 9, j = r & 511;
#pragma unroll
                for (int bj = 0; bj < 2; ++bj) { const int np = col0 + bj * HALF;
                    bf16_t* rowp = ZT + (ctx ? (ztc_delta + (long)j * 512 + cs * 256 + np) : ((((long)cs * 128 + (np >> 6)) * 512 + j) * 64 + (np & 63))) - bj * HALF; const f32x4 v0 = acc[ai][bj][m][0], v1 = acc[ai][bj][m][1];
                    u32x4 w; w.x = cvt_pk_bf16(v0[0], v0[1]); w.y = cvt_pk_bf16(v0[2], v0[3]); w.z = cvt_pk_bf16(v1[0], v1[1]); w.w = cvt_pk_bf16(v1[2], v1[3]);
                    *(PG8_GAS u32x4*)(rowp + bj * HALF) = w; } }
    }
};
struct EpiYF {
    static constexpr bool PERM = false, AFTER_DRAIN = false;
    float* YF; int row_off; size_t part_stride;
    __device__ __forceinline__ void operator()(const f32x4 (&acc)[2][2][4][2], const Unit& u, int wr, int wc, int fr, int fq) const {
        const int row0 = row_off + u.pm * BM + wr * 64 + fr, col0 = u.pn * BM + wc * 32 + 4 * fq;
        float* base = YF + (size_t)(u.kt0 / u.nt) * part_stride;
#pragma unroll
        for (int ai = 0; ai < 2; ++ai)
#pragma unroll
            for (int m = 0; m < 4; ++m) { float* rowp = base + (size_t)(row0 + ai * HALF + m * 16) * 512 + col0;
#pragma unroll
                for (int bj = 0; bj < 2; ++bj)
#pragma unroll
                    for (int n = 0; n < 2; ++n) *(PG8_GAS f32x4*)(rowp + bj * HALF + n * 16) = acc[ai][bj][m][n]; }
    }
};

template <class Epi, class Sched, bool ALIGN_EPI = false, bool SP2 = false>
__device__ __forceinline__ void gemm_phase(PG8_LAS unsigned char* lds, const Gemm g, const Sched& S, const Epi& E, const int wave_id) {
    int tid_ = wave_id * 64 + lane_id(); asm volatile("" : "+v"(tid_));
    const int tid = tid_, wid = __builtin_amdgcn_readfirstlane(tid >> 6), lane = tid & 63, wr = wid >> 2, wc = wid & 3, fr = lane & 15, fq = lane >> 4;
    const int K = g.K;
    unsigned voffA[2], voffB[2];
#pragma unroll
    for (int i = 0; i < 2; ++i) { int R, C; stage_rc(tid * 16 + i * 8192, R, C); const int Rb = Epi::PERM ? ((R & ~31) + perm32(R & 31)) : R;
        voffA[i] = (unsigned)(R * K + C) * 2u; voffB[i] = (unsigned)(Rb * K + C) * 2u; }
    const size_t kstep = (size_t)(BK * 2);
    const size_t hstep = (size_t)HALF * K * 2;
    const size_t tstep = 2 * hstep;
    const unsigned ldsw = (unsigned)wid * 1024u;
    const int aoff = lds_byte(wr * 64 + fr, fq * 8), boff = lds_byte(wc * 32 + fr, fq * 8);
#define PG8_SA(b, h) (((b) * 2 + (h)) * HTB)
#define PG8_SB(b, h) ((4 + (b) * 2 + (h)) * HTB)
#define PG8_STAGE(bufoff, gbase, voff) do { _Pragma("unroll") for (int _i = 0; _i < 2; ++_i) \
        __builtin_amdgcn_global_load_lds((const unsigned*)((const char*)(gbase) + (voff)[_i]), (PG8_LAS unsigned*)(lds + (bufoff) + ldsw + _i * 8192), 16, 0, 0); } while (0)
#define PG8_LDA(dst, b, h) do { _Pragma("unroll") for (int m = 0; m < 4; ++m) _Pragma("unroll") for (int k = 0; k < 2; ++k) dst[m][k] = *(const PG8_LAS bf16x8*)(lds + PG8_SA(b, h) + aoff + m * 2048 + k * 1024); } while (0)
#define PG8_LDB(dst, b, h) do { _Pragma("unroll") for (int n = 0; n < 2; ++n) _Pragma("unroll") for (int k = 0; k < 2; ++k) dst[n][k] = *(const PG8_LAS bf16x8*)(lds + PG8_SB(b, h) + boff + n * 2048 + k * 1024); } while (0)
#define PG8_MMA(ai, bj, At, Bt) do { __builtin_amdgcn_s_setprio(1); _Pragma("unroll") for (int m = 0; m < 4; ++m) _Pragma("unroll") for (int n = 0; n < 2; ++n) _Pragma("unroll") for (int k = 0; k < 2; ++k) \
        acc[ai][bj][m][n] = __builtin_amdgcn_mfma_f32_16x16x32_bf16(Bt[n][k], At[m][k], acc[ai][bj][m][n], 0, 0, 0); __builtin_amdgcn_s_setprio(0); } while (0)
#define PG8_WAIT_V(n) asm volatile("s_waitcnt vmcnt(" #n ")" ::: "memory")
#define PG8_WAIT_L(n) asm volatile("s_waitcnt lgkmcnt(" #n ")" ::: "memory")
#define PG8_BAR __builtin_amdgcn_s_barrier()
#define PG8_SCHED __builtin_amdgcn_sched_barrier(0)
    Unit cur, nxt; int ui = 0;
    if (!S.next(0, cur)) return;
    f32x4 acc[2][2][4][2];
#pragma unroll
    for (int a = 0; a < 2; ++a)
#pragma unroll
        for (int b = 0; b < 2; ++b)
#pragma unroll
            for (int m = 0; m < 4; ++m)
#pragma unroll
                for (int n = 0; n < 2; ++n) acc[a][b][m][n] = (f32x4){0.f, 0.f, 0.f, 0.f};
    bf16x8 At[4][2], B0[2][2], B1[2][2];
    const char* cA = (const char*)g.A + (size_t)cur.pm * tstep + (size_t)cur.kt0 * kstep; const char* cB = (const char*)g.Bt + (size_t)cur.pn * tstep + (size_t)cur.kt0 * kstep;
    S.a_ready(cur);
    if constexpr (SP2) {
        PG8_STAGE(PG8_SB(0, 0), cB, voffB); PG8_STAGE(PG8_SB(0, 1), cB + hstep, voffB); PG8_STAGE(PG8_SA(0, 0), cA, voffA); PG8_STAGE(PG8_SA(0, 1), cA + hstep, voffA);
        if (wr == 1) PG8_BAR;
        PG8_WAIT_V(2); PG8_BAR;
        PG8_STAGE(PG8_SB(1, 0), cB + kstep, voffB); PG8_STAGE(PG8_SA(1, 0), cA + kstep, voffA); PG8_STAGE(PG8_SB(1, 1), cB + hstep + kstep, voffB);
        PG8_WAIT_V(6); PG8_BAR;
    } else {
        PG8_STAGE(PG8_SB(0, 0), cB, voffB); PG8_STAGE(PG8_SA(0, 0), cA, voffA); PG8_STAGE(PG8_SB(0, 1), cB + hstep, voffB); PG8_STAGE(PG8_SA(0, 1), cA + hstep, voffA);
        if (wr == 1) PG8_BAR;
        PG8_WAIT_V(4); PG8_BAR;
        PG8_STAGE(PG8_SB(1, 0), cB + kstep, voffB); PG8_STAGE(PG8_SA(1, 0), cA + kstep, voffA); PG8_STAGE(PG8_SB(1, 1), cB + hstep + kstep, voffB);
        PG8_WAIT_V(6); PG8_BAR;
    }
    for (;;) {
        const bool has_next = S.next(ui + 1, nxt);
        const char* nA = has_next ? (const char*)g.A + (size_t)nxt.pm * tstep + (size_t)nxt.kt0 * kstep : cA; const char* nB = has_next ? (const char*)g.Bt + (size_t)nxt.pn * tstep + (size_t)nxt.kt0 * kstep : cB;
        const int nt = cur.nt;
        for (int t = 0; t < nt; t += 2) {
            const bool last = (t == nt - 2);
            const char* a1 = cA + (size_t)(t + 1) * kstep;
            const char* a2 = last ? nA : cA + (size_t)(t + 2) * kstep; const char* b2 = last ? nB : cB + (size_t)(t + 2) * kstep;
            const char* a3 = a2 + kstep; const char* b3 = b2 + kstep;
            if (last && has_next) S.a_ready(nxt);
            if constexpr (SP2) {
            PG8_LDB(B0, 0, 0); PG8_LDB(B1, 0, 1); PG8_SCHED; PG8_LDA(At, 0, 0); PG8_STAGE(PG8_SA(1, 1), a1 + hstep, voffA);
            PG8_WAIT_V(8); PG8_WAIT_L(0); PG8_BAR; PG8_MMA(0, 0, At, B0); PG8_MMA(0, 1, At, B1); PG8_BAR; PG8_SCHED;
            PG8_LDA(At, 0, 1); PG8_STAGE(PG8_SB(0, 0), b2, voffB); PG8_STAGE(PG8_SB(0, 1), b2 + hstep, voffB); PG8_STAGE(PG8_SA(0, 0), a2, voffA);
            PG8_WAIT_V(8); PG8_WAIT_L(0); PG8_BAR; PG8_MMA(1, 0, At, B0); PG8_MMA(1, 1, At, B1); PG8_BAR; PG8_SCHED;
            PG8_LDB(B0, 1, 0); PG8_LDB(B1, 1, 1); PG8_SCHED; PG8_LDA(At, 1, 0); PG8_STAGE(PG8_SA(0, 1), a2 + hstep, voffA);
            PG8_WAIT_V(8); PG8_WAIT_L(0); PG8_BAR; PG8_MMA(0, 0, At, B0); PG8_MMA(0, 1, At, B1); PG8_BAR; PG8_SCHED;
            PG8_LDA(At, 1, 1); PG8_STAGE(PG8_SB(1, 0), b3, voffB); PG8_STAGE(PG8_SB(1, 1), b3 + hstep, voffB); PG8_STAGE(PG8_SA(1, 0), a3, voffA);
            PG8_WAIT_V(8); PG8_WAIT_L(0); PG8_BAR; PG8_MMA(1, 0, At, B0); PG8_MMA(1, 1, At, B1); PG8_BAR; PG8_SCHED;
            } else {
            PG8_LDB(B0, 0, 0); PG8_SCHED; PG8_LDA(At, 0, 0); PG8_STAGE(PG8_SA(1, 1), a1 + hstep, voffA);
            PG8_WAIT_L(8); PG8_BAR; PG8_WAIT_L(0); PG8_MMA(0, 0, At, B0); PG8_BAR; PG8_SCHED;
            PG8_LDB(B1, 0, 1); PG8_STAGE(PG8_SB(0, 0), b2, voffB);
            PG8_BAR; PG8_WAIT_L(0); PG8_MMA(0, 1, At, B1); PG8_BAR;
            PG8_LDA(At, 0, 1); PG8_STAGE(PG8_SA(0, 0), a2, voffA);
            PG8_BAR; PG8_WAIT_L(0); PG8_MMA(1, 0, At, B0); PG8_BAR; PG8_SCHED;
            PG8_STAGE(PG8_SB(0, 1), b2 + hstep, voffB);
            PG8_WAIT_V(6); PG8_BAR; PG8_MMA(1, 1, At, B1); PG8_BAR;
            PG8_LDB(B0, 1, 0); PG8_SCHED; PG8_LDA(At, 1, 0); PG8_STAGE(PG8_SA(0, 1), a2 + hstep, voffA);
            PG8_WAIT_L(8); PG8_BAR; PG8_WAIT_L(0); PG8_MMA(0, 0, At, B0); PG8_BAR; PG8_SCHED;
            PG8_LDB(B1, 1, 1); PG8_STAGE(PG8_SB(1, 0), b3, voffB);
            PG8_BAR; PG8_WAIT_L(0); PG8_MMA(0, 1, At, B1); PG8_BAR;
            PG8_LDA(At, 1, 1); PG8_STAGE(PG8_SA(1, 0), a3, voffA);
            PG8_BAR; PG8_WAIT_L(0); PG8_MMA(1, 0, At, B0); PG8_BAR; PG8_SCHED;
            PG8_STAGE(PG8_SB(1, 1), b3 + hstep, voffB);
            PG8_WAIT_V(6); PG8_BAR; PG8_MMA(1, 1, At, B1); PG8_BAR;
            }
        }
        if constexpr (ALIGN_EPI) { if (wr == 0) PG8_BAR; }
        if constexpr (!Epi::AFTER_DRAIN) { E(acc, cur, wr, wc, fr, fq); S.done(cur); }
        if (!has_next) break;
#pragma unroll
        for (int a = 0; a < 2; ++a)
#pragma unroll
            for (int b = 0; b < 2; ++b)
#pragma unroll
                for (int m = 0; m < 4; ++m)
#pragma unroll
                    for (int n = 0; n < 2; ++n) acc[a][b][m][n] = (f32x4){0.f, 0.f, 0.f, 0.f};
        cur = nxt; cA = nA; cB = nB; ++ui;
        if constexpr (ALIGN_EPI) { if (wr == 1) PG8_BAR; }
    }
    PG8_WAIT_V(0);
    if constexpr (!ALIGN_EPI) { if (wr == 0) PG8_BAR; }
    PG8_BAR;
    if constexpr (Epi::AFTER_DRAIN) { E.fused(acc, cur, wr, wc, fr, fq, lds, wid, lane); S.done(cur); }
#undef PG8_SA
#undef PG8_SB
#undef PG8_STAGE
#undef PG8_LDA
#undef PG8_LDB
#undef PG8_MMA
#undef PG8_WAIT_V
#undef PG8_WAIT_L
#undef PG8_BAR
#undef PG8_SCHED
}
}
#define XB_TMO      128
#define XB_XCNT(j)  (256  + 64 * (j))
#define XB_XSUB(j)  (1280 + 64 * (j))
#define XB_XGEN(j)  (2304 + 64 * (j))
#define XB_TOP      3328
#define XB_TOPGEN   3392
#define XCD_BAR_WORDS 3456
#define XB_SPIN_CAP (1u << 18)

__device__ __forceinline__ unsigned xb_ld(unsigned* p)              { return __hip_atomic_load(p, __ATOMIC_RELAXED, __HIP_MEMORY_SCOPE_AGENT); }
__device__ __forceinline__ unsigned xb_add(unsigned* p, unsigned v) { return __hip_atomic_fetch_add(p, v, __ATOMIC_RELAXED, __HIP_MEMORY_SCOPE_AGENT); }
__device__ __forceinline__ unsigned xb_xcc_id() { return (unsigned)__builtin_amdgcn_s_getreg((3 << 11) | 20) & 0xFu; }
#define XB_SPIN(cond, bar) do { unsigned _sp = 0; while (cond) { __builtin_amdgcn_s_sleep(1); \
    if ((++_sp & 255u) == 0u) { if (xb_ld(&(bar)[XB_TMO])) break; if (_sp > XB_SPIN_CAP) { atomicAdd(&(bar)[XB_TMO], 1u); break; } } } } while (0)

struct XcdBarrier {
    unsigned* bar; unsigned x; unsigned wv;
    volatile LAS unsigned* st;
};

__device__ __forceinline__ XcdBarrier xcd_barrier_post(unsigned* bar, volatile LAS unsigned* st, unsigned wv) {
    XcdBarrier b; b.bar = bar; b.x = xb_xcc_id(); b.st = st; b.wv = wv;
    if (wv == 0 && lane_id() == 0) (void)xb_add(&bar[XB_XCNT(b.x)], 1u);
    return b;
}
__device__ __forceinline__ void xcd_barrier_complete(unsigned* bar, unsigned x, unsigned& nloc, unsigned& nx) {
    const unsigned G = gridDim.x * gridDim.y * gridDim.z;
    unsigned sum, cnt, mine, sp = 0u;
    for (;;) {
        sum = 0u; cnt = 0u; mine = 0u;
#pragma unroll
        for (unsigned j = 0; j < 16; ++j) { const unsigned c = xb_ld(&bar[XB_XCNT(j)]); sum += c; cnt += (c > 0u) ? 1u : 0u; mine = (j == x) ? c : mine; }
        if (sum == G) break;
        __builtin_amdgcn_s_sleep(1);
        if ((++sp & 255u) == 0u) { if (xb_ld(&bar[XB_TMO])) break; if (sp > XB_SPIN_CAP) { atomicAdd(&bar[XB_TMO], 1u); break; } }
    }
    nloc = mine > 0u ? mine : 1u; nx = cnt > 0u ? cnt : 1u;
}

__device__ __forceinline__ void xcd_barrier(const XcdBarrier& b) {
    asm volatile("s_waitcnt vmcnt(0)" ::: "memory");
    __syncthreads();
    if (b.wv == 0 && lane_id() == 0) {
        unsigned* bar = b.bar; unsigned bx = b.x;
        asm volatile("" : "+s"(bar), "+s"(bx));
        __builtin_amdgcn_s_waitcnt(0);
        unsigned nloc = b.st[0], nx = b.st[1];
        if (nloc == 0u) { xcd_barrier_complete(bar, bx, nloc, nx); b.st[0] = nloc; b.st[1] = nx; }
        const unsigned old = xb_add(&bar[XB_XSUB(bx)], 1u);
        const unsigned gen = old / nloc;
        if (old + 1u == (gen + 1u) * nloc) {
            __builtin_amdgcn_fence(__ATOMIC_RELEASE, "agent");
            asm volatile("s_waitcnt vmcnt(0)" ::: "memory");
            const unsigned og = xb_add(&bar[XB_TOP], 1u);
            const unsigned tg = og / nx;
            if (og + 1u == (tg + 1u) * nx) xb_add(&bar[XB_TOPGEN], 1u);
            else XB_SPIN(xb_ld(&bar[XB_TOPGEN]) == tg, bar);
            __builtin_amdgcn_fence(__ATOMIC_ACQUIRE, "agent");
            xb_add(&bar[XB_XGEN(bx)], 1u);
            asm volatile("s_waitcnt vmcnt(0)" ::: "memory");
        } else {
            XB_SPIN(xb_ld(&bar[XB_XGEN(bx)]) == gen, bar);
            __builtin_amdgcn_fence(__ATOMIC_ACQUIRE, "agent");
            asm volatile("s_waitcnt vmcnt(0)" ::: "memory");
        }
    }
    __syncthreads();
}

namespace att {
typedef unsigned short bf16;
constexpr int D = 128, NW = 8, QBLK = 32, KVBLK = 64;
constexpr float SCALE = 0.088388347648318440f;
constexpr float THR = 8.f;
constexpr int LDQ = 512, LDK = 256, LDO = 512;
constexpr size_t SHM_V = KVBLK * D * 2, SHM_K = KVBLK * D * 2, SHM_ATTN = 2 * SHM_V + 2 * SHM_K + NW * 64 * 4;
using bf16x8 = __attribute__((ext_vector_type(8))) short;
using s16x4  = __attribute__((ext_vector_type(4))) short;
using f32x16 = __attribute__((ext_vector_type(16))) float;
using u32x4  = __attribute__((ext_vector_type(4))) unsigned;
#define KSWZ(row, colB) ((row) * 256 + ((colB) ^ (((row) & 7) << 4)))
#define SBAR() __builtin_amdgcn_sched_barrier(0)
__device__ __forceinline__ int crow(int r, int hi) { return (r & 3) + 8 * (r >> 2) + 4 * hi; }
__device__ __forceinline__ unsigned cvtpk(float lo, float hi) { unsigned r; asm volatile("v_cvt_pk_bf16_f32 %0, %1, %2" : "=v"(r) : "v"(lo), "v"(hi)); return r; }
__device__ __forceinline__ void partialSM(f32x16& p0, f32x16& p1, float& m_reg, float& mn, float& alpha) {
  constexpr float C = SCALE * 1.4426950408889634f;
  float pmax = p0[0]; for (int r = 1; r < 16; ++r) pmax = fmaxf(pmax, p0[r]); for (int r = 0; r < 16; ++r) pmax = fmaxf(pmax, p1[r]);
  { auto rr = __builtin_amdgcn_permlane32_swap(__float_as_uint(pmax), __float_as_uint(pmax), false, false);
    pmax = fmaxf(__uint_as_float(rr[0]), __uint_as_float(rr[1])); }
  if (__builtin_expect(__all(pmax - m_reg <= THR / SCALE), 1)) { mn = m_reg; alpha = 1.f; }
  else { mn = fmaxf(m_reg, pmax); alpha = __builtin_amdgcn_exp2f((m_reg - mn) * C); m_reg = mn; }
  float mnC = -mn * C;
  for (int r = 0; r < 16; ++r) p0[r] = fmaf(p0[r], C, mnC); for (int r = 0; r < 16; ++r) p1[r] = fmaf(p1[r], C, mnC);
  for (int r = 0; r < 16; ++r) p0[r] = __builtin_amdgcn_exp2f(p0[r]);
}
__device__ __forceinline__ void finishSM(f32x16& p0, f32x16& p1, float alpha, float& l_reg, bf16x8& pa0, bf16x8& pa1, bf16x8& pa2, bf16x8& pa3) {
  for (int r = 0; r < 16; ++r) p1[r] = __builtin_amdgcn_exp2f(p1[r]);
  float ps = 0; for (int r = 0; r < 16; ++r) ps += p0[r]; for (int r = 0; r < 16; ++r) ps += p1[r];
  { auto rr = __builtin_amdgcn_permlane32_swap(__float_as_uint(ps), __float_as_uint(ps), false, false);
    ps = __uint_as_float(rr[0]) + __uint_as_float(rr[1]); }
  l_reg = l_reg * alpha + ps;
#define PK4(P, BASE, OUT) do { unsigned a0 = cvtpk(P[BASE + 0], P[BASE + 1]), a1 = cvtpk(P[BASE + 2], P[BASE + 3]);   \
    unsigned b0 = cvtpk(P[BASE + 4], P[BASE + 5]), b1 = cvtpk(P[BASE + 6], P[BASE + 7]);                              \
    auto r0 = __builtin_amdgcn_permlane32_swap(a0, b0, false, false); auto r1 = __builtin_amdgcn_permlane32_swap(a1, b1, false, false); \
    u32x4 w = {r0[0], r1[0], r0[1], r1[1]}; OUT = *reinterpret_cast<bf16x8*>(&w); } while (0)
  PK4(p0, 0, pa0); PK4(p0, 8, pa1); PK4(p1, 0, pa2); PK4(p1, 8, pa3);
#undef PK4
}
__device__ __forceinline__ void qkt(f32x16& p0, f32x16& p1, const bf16* Ks, const bf16x8* qr, int r32, int hi) {
  p0 = f32x16{}; p1 = f32x16{};
  for (int d0 = 0; d0 < 8; ++d0) { int cb = (d0 * 16 + hi * 8) * 2;
    bf16x8 b0 = *reinterpret_cast<const bf16x8*>((const char*)Ks + KSWZ(r32, cb));
    bf16x8 b1 = *reinterpret_cast<const bf16x8*>((const char*)Ks + KSWZ(32 + r32, cb));
    p0 = __builtin_amdgcn_mfma_f32_32x32x16_bf16(b0, qr[d0], p0, 0, 0, 0);
    p1 = __builtin_amdgcn_mfma_f32_32x32x16_bf16(b1, qr[d0], p1, 0, 0, 0); }
}
__device__ __forceinline__ int v_st(int k, int c) { const int kk = (k & ~0xC) | ((k & 4) << 1) | ((k & 8) >> 1); return ((kk >> 3) * 4 + (c >> 5)) * 512 + ((kk & 7) * 32 + (c & 31)) * 2; }
__device__ __forceinline__ int v_rd_base(int lane) { return ((lane & 3) << 3) | (((lane >> 2) & 3) << 6) | (((lane >> 4) & 1) << 5) | (((lane >> 5) & 1) << 8); }
constexpr int v_rd_off(int d0, int ks, int half) { return d0 * 512 + ks * 4096 + half * 2048; }
template <int OFF> __device__ __forceinline__ s16x4 tr_read(int vb) {
  s16x4 r; asm volatile("ds_read_b64_tr_b16 %0, %1 offset:%2" : "=&v"(r) : "v"(vb), "i"(OFF) : "memory"); return r;
}
template <int D0> __device__ __forceinline__ void pv_one(f32x16& od, int vb, bf16x8 pa0, bf16x8 pa1, bf16x8 pa2, bf16x8 pa3) {
  const s16x4 l0 = tr_read<v_rd_off(D0, 0, 0)>(vb), h0 = tr_read<v_rd_off(D0, 0, 1)>(vb), l1 = tr_read<v_rd_off(D0, 1, 0)>(vb), h1 = tr_read<v_rd_off(D0, 1, 1)>(vb);
  const s16x4 l2 = tr_read<v_rd_off(D0, 2, 0)>(vb), h2 = tr_read<v_rd_off(D0, 2, 1)>(vb), l3 = tr_read<v_rd_off(D0, 3, 0)>(vb), h3 = tr_read<v_rd_off(D0, 3, 1)>(vb);
  asm volatile("s_waitcnt lgkmcnt(0)" ::: "memory"); SBAR();
#define PK(L, H) (bf16x8){L[0], L[1], L[2], L[3], H[0], H[1], H[2], H[3]}
  od = __builtin_amdgcn_mfma_f32_32x32x16_bf16(pa0, PK(l0, h0), od, 0, 0, 0);
  od = __builtin_amdgcn_mfma_f32_32x32x16_bf16(pa1, PK(l1, h1), od, 0, 0, 0);
  od = __builtin_amdgcn_mfma_f32_32x32x16_bf16(pa2, PK(l2, h2), od, 0, 0, 0);
  od = __builtin_amdgcn_mfma_f32_32x32x16_bf16(pa3, PK(l3, h3), od, 0, 0, 0);
#undef PK
}
__device__ __forceinline__ void pv_d0(f32x16* o, int vb, bf16x8 pa0, bf16x8 pa1, bf16x8 pa2, bf16x8 pa3) {
  pv_one<0>(o[0], vb, pa0, pa1, pa2, pa3); pv_one<1>(o[1], vb, pa0, pa1, pa2, pa3); pv_one<2>(o[2], vb, pa0, pa1, pa2, pa3); pv_one<3>(o[3], vb, pa0, pa1, pa2, pa3);
}
__device__ __forceinline__ void attn_unit(const bf16* Qb_, const bf16* Kh_, const bf16* Vh_, float* Ob_, float* MLb_, int seq, char* lds, const int wave_id) {
  const GAS bf16* Qb = (const GAS bf16*)Qb_; const GAS bf16* Kh = (const GAS bf16*)Kh_; const GAS bf16* Vh = (const GAS bf16*)Vh_; GAS float* Ob = (GAS float*)Ob_; GAS float* MLb = (GAS float*)MLb_;
  int tid_ = wave_id * 64 + lane_id(); asm volatile("" : "+v"(tid_));
  const int tid = tid_, wid = tid >> 6, lane = tid & 63, r32 = lane & 31, hi = lane >> 5;
  bf16* V_lds = (bf16*)lds; bf16* K_lds = (bf16*)(lds + 2 * SHM_V);
  float* ws = (float*)(lds + 2 * SHM_V + 2 * SHM_K) + wid * 64; float* al_l = ws + 32;
  float m_reg = -1e30f, l_reg = 0; f32x16 o[4] = {}; bf16x8 qr[8];
  const GAS bf16* Qw = Qb + (long)(wid * QBLK + r32) * LDQ + hi * 8;
#pragma unroll
  for (int d0 = 0; d0 < 8; ++d0) qr[d0] = *reinterpret_cast<const GAS bf16x8*>(Qw + d0 * 16);
  const int sr = tid >> 4, sc = (tid & 15) * 8, vst0 = v_st(sr, sc), vst1 = v_st(32 + sr, sc);
  const int vb0 = (int)(uintptr_t)V_lds + v_rd_base(lane);
  struct { bf16x8 vs0, vs1, ks0, ks1; } sr_[2];
#define SLOAD(i, k0) do { sr_[i].vs0 = *reinterpret_cast<const GAS bf16x8*>(&Vh[(long)((k0) + sr) * LDK + sc]); sr_[i].vs1 = *reinterpret_cast<const GAS bf16x8*>(&Vh[(long)((k0) + 32 + sr) * LDK + sc]); \
    sr_[i].ks0 = *reinterpret_cast<const GAS bf16x8*>(&Kh[(long)((k0) + sr) * LDK + sc]); sr_[i].ks1 = *reinterpret_cast<const GAS bf16x8*>(&Kh[(long)((k0) + 32 + sr) * LDK + sc]); } while (0)
#define SWRITE(b, i) do { *(bf16x8*)((char*)V_lds + (b) * SHM_V + vst0) = sr_[i].vs0;          \
    *(bf16x8*)((char*)V_lds + (b) * SHM_V + vst1) = sr_[i].vs1; int kc = sc * 2;               \
    *(bf16x8*)((char*)K_lds + (b) * SHM_K + KSWZ(sr, kc)) = sr_[i].ks0;                       \
    *(bf16x8*)((char*)K_lds + (b) * SHM_K + KSWZ(32 + sr, kc)) = sr_[i].ks1; } while (0)
#define SWAIT() asm volatile("s_waitcnt vmcnt(4)" ::: "memory")
#define RESC(a) do { if (__any((a) < 1.f)) { if (hi == 0) al_l[r32] = (a); asm volatile("s_waitcnt lgkmcnt(0)" ::: "memory"); \
    for (int d = 0; d < 4; ++d) for (int r = 0; r < 16; ++r) o[d][r] *= al_l[crow(r, hi)]; } } while (0)
  f32x16 pA0, pA1, pB0, pB1; float mnA, mnB, alA, alB; bf16x8 pa0, pa1, pa2, pa3; const int NT = seq / KVBLK;
  constexpr int SE = 0, SO = 1;
  SLOAD(SE, 0); asm volatile("s_waitcnt vmcnt(0)" ::: "memory"); SWRITE(0, SE); __syncthreads();
  qkt(pA0, pA1, K_lds, qr, r32, hi); partialSM(pA0, pA1, m_reg, mnA, alA);
  SLOAD(SO, KVBLK); if (2 < NT) SLOAD(SE, 2 * KVBLK);
  SWAIT(); SWRITE(1, SO); __syncthreads();
  for (int j = 1; j + 1 < NT; j += 2) {
    SBAR(); qkt(pB0, pB1, (bf16*)((char*)K_lds + SHM_K), qr, r32, hi);
    finishSM(pA0, pA1, alA, l_reg, pa0, pa1, pa2, pa3); SBAR();
    SLOAD(SO, (j + 2) * KVBLK); SBAR();
    pv_d0(o, vb0, pa0, pa1, pa2, pa3); partialSM(pB0, pB1, m_reg, mnB, alB);
    __syncthreads(); SWAIT(); SWRITE(0, SE);
    RESC(alB); __syncthreads();
    SBAR(); qkt(pA0, pA1, K_lds, qr, r32, hi);
    finishSM(pB0, pB1, alB, l_reg, pa0, pa1, pa2, pa3); SBAR();
    if (j + 3 < NT) SLOAD(SE, (j + 3) * KVBLK); SBAR();
    pv_d0(o, vb0 + (int)SHM_V, pa0, pa1, pa2, pa3); partialSM(pA0, pA1, m_reg, mnA, alA);
    __syncthreads(); SWAIT(); SWRITE(1, SO);
    RESC(alA); __syncthreads();
  }
  SBAR(); qkt(pB0, pB1, (bf16*)((char*)K_lds + SHM_K), qr, r32, hi);
  finishSM(pA0, pA1, alA, l_reg, pa0, pa1, pa2, pa3); SBAR();
  pv_d0(o, vb0, pa0, pa1, pa2, pa3); partialSM(pB0, pB1, m_reg, mnB, alB);
  __syncthreads(); RESC(alB);
  finishSM(pB0, pB1, alB, l_reg, pa0, pa1, pa2, pa3); SBAR();
  pv_d0(o, vb0 + (int)SHM_V, pa0, pa1, pa2, pa3);
  if (hi == 0) { GAS float* ml = MLb + (long)(wid * QBLK + r32) * 8; ml[0] = m_reg; ml[1] = l_reg; }
  GAS float* Ow = Ob + (long)(wid * QBLK) * LDO;
#pragma unroll
  for (int r = 0; r < 16; ++r) { int orow = crow(r, hi);
    for (int d0 = 0; d0 < 4; ++d0) Ow[(long)orow * LDO + d0 * 32 + r32] = o[d0][r]; }
#undef SLOAD
#undef SWRITE
#undef SWAIT
#undef RESC
}
#undef KSWZ
#undef SBAR
}

struct Frame {
    LAS unsigned char* lds;
    unsigned char* gl;
    volatile LAS unsigned* MISC;
    gu32* ctl;
    int tid, lane, wave, G, bid;
};

__device__ __forceinline__ Frame fresh(const Frame& F) {
    Frame R = F; int t = F.wave * 64 + lane_id(); asm volatile("" : "+v"(t)); R.tid = t; R.lane = t & 63; R.wave = __builtin_amdgcn_readfirstlane(t >> 6);
    int b = F.bid; asm volatile("" : "+s"(b)); R.bid = b; int g = F.G; asm volatile("" : "+s"(g)); R.G = g; return R;
}
typedef short bf16x8 __attribute__((ext_vector_type(8)));
__device__ __forceinline__ bf16x8 frag16(const bf16* M, int ld, int r0, int k0, int lane) { return *(const bf16x8*)(M + (size_t)(r0 + (lane & 15)) * ld + k0 + 8 * (lane >> 4)); }
__device__ __forceinline__ bf16x8 frag16(const LAS bf16* M, int ld, int r0, int k0, int lane) { return *(const LAS bf16x8*)(M + (r0 + (lane & 15)) * ld + k0 + 8 * (lane >> 4)); }
#define MFMA16(a, b, c) __builtin_amdgcn_mfma_f32_16x16x32_bf16((a), (b), (c), 0, 0, 0)
constexpr int LDT = 72;

#ifndef MK_PROBE
#define MK_PROBE 0
#endif
#if MK_PROBE
#define ISTAMP(g) do { if (F.bid == 0 && F.wave == 0 && lane_id() == 0) { unsigned long long* T = (unsigned long long*)(F.ctl + 2048); const unsigned long long now = __builtin_amdgcn_s_memrealtime(); T[(g)] += now - T[31]; T[31] = now; } } while (0)
#else
#define ISTAMP(g) do { } while (0)
#endif
__device__ __forceinline__ void tr_item(const float* __restrict__ W, int N, int k0, int n0, bf16* __restrict__ WT, int Kd, int drow0, LAS float* scr, int lane) {
    float tmp[32];
#pragma unroll
    for (int i = 0; i < 32; ++i) { const int kk = 2 * i + (lane >> 5); tmp[i] = W[(size_t)(k0 + kk) * N + n0 + (lane & 31)]; }
#pragma unroll
    for (int i = 0; i < 32; ++i) { const int kk = 2 * i + (lane >> 5); scr[kk * 33 + (lane & 31)] = tmp[i]; }
    LDS_WAIT(); asm volatile("" ::: "memory");
    const int c = lane & 7;
#pragma unroll
    for (int j = 0; j < 4; ++j) { const int n = (lane >> 3) + 8 * j; const LAS float* s = scr + (8 * c) * 33 + n;
        u32x4 o; o.x = pk2(s[0 * 33], s[1 * 33]); o.y = pk2(s[2 * 33], s[3 * 33]); o.z = pk2(s[4 * 33], s[5 * 33]); o.w = pk2(s[6 * 33], s[7 * 33]);
        *(u32x4*)(WT + (size_t)(drow0 + n) * Kd + k0 + 8 * c) = o; }
    LDS_WAIT(); asm volatile("" ::: "memory");
}

__device__ __forceinline__ void tr_load(const float* __restrict__ W, int N, int k0, int n0, int lane, float (&tmp)[32]) {
    const GAS float* __restrict__ Wg = (const GAS float*)W;
#pragma unroll
    for (int i = 0; i < 32; ++i) { const int kk = 2 * i + (lane >> 5); tmp[i] = Wg[(size_t)(k0 + kk) * N + n0 + (lane & 31)]; }
}
__device__ __forceinline__ void tr_finish(const float (&tmp)[32], bf16* __restrict__ WT, int Kd, int k0, int drow0, LAS float* scr, int lane) {
#pragma unroll
    for (int i = 0; i < 32; ++i) { const int kk = 2 * i + (lane >> 5); scr[kk * 33 + (lane & 31)] = tmp[i]; }
    LDS_WAIT(); asm volatile("" ::: "memory");
    const int c = lane & 7;
#pragma unroll
    for (int j = 0; j < 4; ++j) { const int n = (lane >> 3) + 8 * j; const LAS float* s = scr + (8 * c) * 33 + n;
        u32x4 o; o.x = pk2(s[0 * 33], s[1 * 33]); o.y = pk2(s[2 * 33], s[3 * 33]); o.z = pk2(s[4 * 33], s[5 * 33]); o.w = pk2(s[6 * 33], s[7 * 33]);
        *(GAS u32x4*)(WT + (size_t)(drow0 + n) * Kd + k0 + 8 * c) = o; }
    LDS_WAIT(); asm volatile("" ::: "memory");
}
struct In {
    const float *x, *c, *ctx, *c_ctx, *mod_w, *mod_b, *norm_g, *final_g, *ffn_w13, *ffn_w2, *w_in, *w_out, *lru_conv_w, *lru_conv_b, *lru_gate_w, *lru_gate_b, *lru_lambda, *attn_qk_g, *gla_gate_w, *gla_gate_b, *gla_out_g;
};

constexpr int MKS = 32;
__device__ __forceinline__ void prologue_a(const Frame& F_, const In& I, unsigned char* ws) {
    const Frame F = fresh(F_);
    const int gw = F.bid * NWAVES + F.wave, NGW = F.G * NWAVES;
    { const f32x4* cs = (const f32x4*)I.ctx; f32x4* X = (f32x4*)(ws + WS_X) + (size_t)TL * DM / 4;
      for (int i = F.bid * 512 + F.tid; i < TCX * DM / 4; i += F.G * 512) X[i] = cs[i]; }
    { float* MODP = (float*)(ws + WS_YF);
      for (int it = gw; it < NLAY * 72 * MKS; it += NGW) {
          const int ks = it % MKS, r = it / MKS, jb = r % 72, l = r / 72; const int j = jb * 256 + 4 * F.lane;
          const float* W = I.mod_w + ((size_t)l * DM + ks * (DM / MKS)) * (9 * DM) + j;
          f32x4 a0 = {0.f, 0.f, 0.f, 0.f}, a1 = {0.f, 0.f, 0.f, 0.f};
#pragma unroll 16
          for (int k = 0; k < DM / MKS; ++k) { const f32x4 w = *(const f32x4*)(W + (size_t)k * (9 * DM)); const float c0 = I.c[ks * (DM / MKS) + k], c1 = I.c_ctx[ks * (DM / MKS) + k];
              a0 += w * siluf_(c0); a1 += w * siluf_(c1); }
          *(f32x4*)(MODP + ((size_t)(ks * NLAY + l) * 2 + 0) * (9 * DM) + j) = a0;
          *(f32x4*)(MODP + ((size_t)(ks * NLAY + l) * 2 + 1) * (9 * DM) + j) = a1;
      } }
    LAS float* scr = (LAS float*)(F.lds + RING_OFF + F.wave * 16384);
    { constexpr int PER = 32 * 352;
      bf16* dst = (bf16*)(ws + WS_W13T);
      for (int it = gw; it < 1 * PER; it += NGW) { const int mat = it / PER, r = it % PER, kb = r / 352, nb = r % 352, n0 = nb * 32;
          const int drow0 = (n0 < FF) ? (n0 / 128) * 256 + (n0 % 128) : ((n0 - FF) / 128) * 256 + 128 + ((n0 - FF) % 128);
          tr_item(I.ffn_w13 + (size_t)mat * DM * 2 * FF, 2 * FF, kb * 64, n0, dst + (size_t)mat * 2 * FF * DM, DM, drow0, scr, F.lane); } }
    { constexpr int PER = 88 * 64;
      bf16* dst = (bf16*)(ws + WS_W2T);
      for (int it = gw; it < 2 * PER; it += NGW) { const int mat = it / PER, r = it % PER, kb = r / 64, nb = r % 64;
          tr_item(I.ffn_w2 + (size_t)mat * FF * DM, DM, kb * 64, nb * 32, dst + (size_t)mat * DM * FF, FF, nb * 32, scr, F.lane); } }
    { constexpr int PER = 32 * 129;
      bf16* dst = (bf16*)(ws + WS_WINT); bf16* dlr = (bf16*)(ws + WS_WLRT);
      for (int it = gw; it < 4 * PER; it += NGW) { const int mat = it / PER, r = it % PER, kb = r / 129, nb = r % 129;
          if (nb == 112) tr_item(I.w_in + (size_t)mat * DM * DIN, DIN, kb * 64, nb * 32, dlr + (size_t)mat * 32 * DM, DM, 0, scr, F.lane);
          else tr_item(I.w_in + (size_t)mat * DM * DIN, DIN, kb * 64, nb * 32, dst + (size_t)mat * 4096 * DM, DM, (nb < 112) ? nb * 32 : nb * 32 - 32, scr, F.lane); } }
    { constexpr int PER = 32 * 64;
      bf16* dst = (bf16*)(ws + WS_WOUTT);
      for (int it = gw; it < 4 * PER; it += NGW) { const int mat = it / PER, r = it % PER, kb = r / 64, nb = r % 64;
          tr_item(I.w_out + (size_t)mat * DM * DM, DM, kb * 64, nb * 32, dst + (size_t)mat * DM * DM, DM, nb * 32, scr, F.lane); } }
}
__device__ __forceinline__ void conv_w13(const Frame& F_, const float* __restrict__ w13, bf16* __restrict__ W13T, int mat, int rank, int nidle, int it_lo, int it_hi) {
    const Frame F = fresh(F_);
    __syncthreads();
    LAS float* scr = (LAS float*)(F.lds + RING_OFF + F.wave * 16384);
    const float* W = w13 + (size_t)mat * DM * 2 * FF; bf16* WT = W13T + (size_t)mat * 2 * FF * DM; const int st = nidle * NWAVES;
    float ta[32], tb[32]; int it = it_lo + rank * NWAVES + F.wave;
    if (it < it_hi) tr_load(W, 2 * FF, (it / 352) * 64, (it % 352) * 32, F.lane, ta);
    for (; it < it_hi; it += 2 * st) {
        if (it + st < it_hi) tr_load(W, 2 * FF, ((it + st) / 352) * 64, ((it + st) % 352) * 32, F.lane, tb);
        { const int kb = it / 352, n0 = (it % 352) * 32; const int drow0 = (n0 < FF) ? (n0 / 128) * 256 + (n0 % 128) : ((n0 - FF) / 128) * 256 + 128 + ((n0 - FF) % 128);
          tr_finish(ta, WT, DM, kb * 64, drow0, scr, F.lane); }
        if (it + 2 * st < it_hi) tr_load(W, 2 * FF, ((it + 2 * st) / 352) * 64, ((it + 2 * st) % 352) * 32, F.lane, ta);
        if (it + st < it_hi) { const int i2 = it + st, kb = i2 / 352, n0 = (i2 % 352) * 32; const int drow0 = (n0 < FF) ? (n0 / 128) * 256 + (n0 % 128) : ((n0 - FF) / 128) * 256 + 128 + ((n0 - FF) % 128);
          tr_finish(tb, WT, DM, kb * 64, drow0, scr, F.lane); } }
    __syncthreads();
}
__device__ __forceinline__ void conv_w2(const Frame& F_, const float* __restrict__ w2, bf16* __restrict__ W2T, int mat, int rank, int nidle, int it_lo, int it_hi) {
    const Frame F = fresh(F_);
    __syncthreads();
    LAS float* scr = (LAS float*)(F.lds + RING_OFF + F.wave * 16384);
    const float* W = w2 + (size_t)mat * FF * DM; bf16* WT = W2T + (size_t)mat * DM * FF; const int st = nidle * NWAVES;
    float ta[32], tb[32]; int it = it_lo + rank * NWAVES + F.wave;
    if (it < it_hi) tr_load(W, DM, (it / 64) * 64, (it % 64) * 32, F.lane, ta);
    for (; it < it_hi; it += 2 * st) {
        if (it + st < it_hi) tr_load(W, DM, ((it + st) / 64) * 64, ((it + st) % 64) * 32, F.lane, tb);
        tr_finish(ta, WT, FF, (it / 64) * 64, (it % 64) * 32, scr, F.lane);
        if (it + 2 * st < it_hi) tr_load(W, DM, ((it + 2 * st) / 64) * 64, ((it + 2 * st) % 64) * 32, F.lane, ta);
        if (it + st < it_hi) tr_finish(tb, WT, FF, ((it + st) / 64) * 64, ((it + st) % 64) * 32, scr, F.lane); }
    __syncthreads();
}
__device__ __forceinline__ void prologue_b(const Frame& F_, const In& I, unsigned char* ws) {
    const Frame F = fresh(F_);
    const int gt = F.bid * 512 + F.tid, NGT = F.G * 512;
    { const float* MODP = (const float*)(ws + WS_YF); float* MODV = (float*)(ws + WS_MODV);
      for (int i = gt; i < NLAY * 2 * 9 * DM; i += NGT) { const int l = i / (2 * 9 * DM), j = i % (9 * DM);
          float s = I.mod_b[l * 9 * DM + j];
#pragma unroll
          for (int ks = 0; ks < MKS; ++ks) s += MODP[(size_t)ks * NLAY * 2 * 9 * DM + i];
          MODV[i] = s; } }
    { bf16* A = (bf16*)(ws + WS_DA);
      for (int i = gt; i < 128 * 128; i += NGT) { const int m = i >> 7, k = i & 127, k1 = m >> 1, ri = m & 1, rp = k >> 6, t1 = k & 63; const float f = (float)((t1 * k1) & 63) * (1.0f / 64.0f);
          const float cv = __builtin_amdgcn_cosf(f), sv = __builtin_amdgcn_sinf(f); A[i] = (bf16)f2bf(ri == 0 ? (rp == 0 ? cv : sv) : (rp == 0 ? -sv : cv)); } }
    { bf16* A = (bf16*)(ws + WS_DB);
      for (int i = gt; i < 128 * 256; i += NGT) { const int k2 = i >> 8, k = i & 255, ri = k >> 7, t2 = k & 127; const float f = (float)((t2 * k2) & 127) * (1.0f / 128.0f);
          A[i] = (bf16)f2bf(ri ? __builtin_amdgcn_sinf(f) : __builtin_amdgcn_cosf(f)); } }
    { bf16* A = (bf16*)(ws + WS_ADFTC);
      for (int i = gt; i < TCX * 64; i += NGT) { const int k1 = i >> 6, c0 = (i & 63) * 8; float v[8];
#pragma unroll
          for (int e = 0; e < 8; ++e) { const int col = c0 + e, t = col & 255; const float f = (float)((k1 * t) & 255) * (1.0f / 256.0f);
              v[e] = (col < 256) ? __builtin_amdgcn_cosf(f) : __builtin_amdgcn_sinf(f); }
          u32x4 o; o.x = pk2(v[0], v[1]); o.y = pk2(v[2], v[3]); o.z = pk2(v[4], v[5]); o.w = pk2(v[6], v[7]);
          *(u32x4*)(A + (size_t)k1 * 512 + c0) = o; } }
    { bf16* A = (bf16*)(ws + WS_ADFT1);
      for (int i = gt; i < 1024 * 64; i += NGT) { const int m = i >> 6, c0 = (i & 63) * 8, cs = m >> 9, g = (m >> 7) & 3, k2 = m & 127; float v[8];
#pragma unroll
          for (int e = 0; e < 8; ++e) { const int k = c0 + e, gp = k >> 7, c = k & 127; const float f = (float)((c * k2) & 127) * (1.0f / 128.0f);
              v[e] = (gp == g) ? (cs ? -__builtin_amdgcn_sinf(f) : __builtin_amdgcn_cosf(f)) : 0.0f; }
          u32x4 o; o.x = pk2(v[0], v[1]); o.y = pk2(v[2], v[3]); o.z = pk2(v[4], v[5]); o.w = pk2(v[6], v[7]);
          *(u32x4*)(A + (size_t)m * 512 + c0) = o; } }
    { bf16* WT = (bf16*)(ws + WS_WGT);
      for (int i = gt; i < NLAY * 32 * 4096; i += NGT) { const int mat = i >> 12, j = (i >> 6) & 63, ii = i & 63; WT[i] = (bf16)f2bf(I.lru_gate_w[(size_t)mat * 4096 + ii * 64 + j]); } }
    { float* R = (float*)(ws + WS_ROPE);
      for (int i = gt; i < 128 * 32; i += NGT) { const int pos = i >> 5, fi = i & 31;
          const float freq = powf(10000.0f, -(float)fi / 32.0f); const float ang = (float)pos * freq;
          const double rev = (double)ang * 0.15915494309189535; const float fr = (float)(rev - floor(rev));
          R[i] = __builtin_amdgcn_cosf(fr); R[128 * 32 + i] = __builtin_amdgcn_sinf(fr); } }
}

template <int NSL, bool XF32>
__device__ __forceinline__ void norm_phase(const Frame& F_, const float* __restrict__ Xl, float* __restrict__ X, bf16* __restrict__ XN, const float* __restrict__ g,
                                           const float* __restrict__ shl, const float* __restrict__ scl, const float* __restrict__ shc, const float* __restrict__ scc,
                                           const float* __restrict__ CP, const float* __restrict__ cgate, float ccoef) {
    const Frame F = fresh(F_);
    const int gw = F.bid * NWAVES + F.wave, NGW = F.G * NWAVES;
    if (!XF32) {
        for (int row = gw; row < TL; row += 2 * NGW) {
            const int row1 = row + NGW;
            const bool has1 = row1 < TL;
            const bf16* xr0 = (const bf16*)Xl + (size_t)row * DM; const bf16* xr1 = (const bf16*)Xl + (size_t)(has1 ? row1 : row) * DM;
            u32x4 p0[4], p1[4];
#pragma unroll
            for (int j = 0; j < 4; ++j) { p0[j] = *(const u32x4*)(xr0 + 512 * j + 8 * F.lane); p1[j] = *(const u32x4*)(xr1 + 512 * j + 8 * F.lane); }
            float s0 = 0.f, s1 = 0.f;
#pragma unroll
            for (int j = 0; j < 4; ++j) {
#pragma unroll
                for (int e = 0; e < 4; ++e) { const float a = __builtin_bit_cast(float, p0[j][e] << 16), b = __builtin_bit_cast(float, p0[j][e] & 0xffff0000u); s0 += a * a + b * b;
                    const float c_ = __builtin_bit_cast(float, p1[j][e] << 16), d = __builtin_bit_cast(float, p1[j][e] & 0xffff0000u); s1 += c_ * c_ + d * d; } }
#pragma unroll
            for (int o = 1; o < 64; o <<= 1) { s0 += __shfl_xor(s0, o); s1 += __shfl_xor(s1, o); }
            const float r0 = rsqrtf(s0 * (1.0f / DM) + EPS), r1 = rsqrtf(s1 * (1.0f / DM) + EPS);
#pragma unroll
            for (int j = 0; j < 4; ++j) { const int c = 512 * j + 8 * F.lane; u32x4 o0, o1;
#pragma unroll
                for (int h = 0; h < 2; ++h) { const f32x4 gv = *(const f32x4*)(g + c + 4 * h), sv = *(const f32x4*)(scl + c + 4 * h), hv = *(const f32x4*)(shl + c + 4 * h);
                    const f32x4 m = gv * (sv + 1.0f);
                    const f32x4 x0 = {__builtin_bit_cast(float, p0[j][2 * h] << 16), __builtin_bit_cast(float, p0[j][2 * h] & 0xffff0000u), __builtin_bit_cast(float, p0[j][2 * h + 1] << 16), __builtin_bit_cast(float, p0[j][2 * h + 1] & 0xffff0000u)};
                    const f32x4 x1 = {__builtin_bit_cast(float, p1[j][2 * h] << 16), __builtin_bit_cast(float, p1[j][2 * h] & 0xffff0000u), __builtin_bit_cast(float, p1[j][2 * h + 1] << 16), __builtin_bit_cast(float, p1[j][2 * h + 1] & 0xffff0000u)};
                    const f32x4 y0 = x0 * r0 * m + hv, y1 = x1 * r1 * m + hv;
                    o0[2 * h] = pk2(y0.x, y0.y); o0[2 * h + 1] = pk2(y0.z, y0.w); o1[2 * h] = pk2(y1.x, y1.y); o1[2 * h + 1] = pk2(y1.z, y1.w); }
                *(u32x4*)(XN + (size_t)row * DM + c) = o0; if (has1) *(u32x4*)(XN + (size_t)row1 * DM + c) = o1; }
        }
    } else
    for (int row = gw; row < TL; row += NGW) {
        const float* xr = Xl + (size_t)row * DM;
        f32x4 v[8]; float s = 0.f;
#pragma unroll
        for (int j = 0; j < 8; ++j) { v[j] = *(const f32x4*)(xr + 256 * j + 4 * F.lane); s += (v[j].x * v[j].x + v[j].y * v[j].y) + (v[j].z * v[j].z + v[j].w * v[j].w); }
        const float r = rsqrtf(wave_sum(s) * (1.0f / DM) + EPS);
#pragma unroll
        for (int j = 0; j < 8; ++j) { const int c = 256 * j + 4 * F.lane; const f32x4 gv = *(const f32x4*)(g + c), sv = *(const f32x4*)(scl + c), hv = *(const f32x4*)(shl + c);
            const f32x4 y = v[j] * r * gv * (sv + 1.0f) + hv; u32x2 o; o.x = pk2(y.x, y.y); o.y = pk2(y.z, y.w); *(u32x2*)(XN + (size_t)row * DM + c) = o; }
    }
    LAS float* red = (LAS float*)(F.lds + RING_OFF);
    for (int cr = F.bid; cr < TCX; cr += F.G) {
        const int row = TL + cr, c = 256 * F.wave + 4 * F.lane; float* xr = X + (size_t)row * DM + c;
        f32x4 v = *(const f32x4*)xr;
        if (NSL > 0) { f32x4 a = {0.f, 0.f, 0.f, 0.f};
#pragma unroll
            for (int sl = 0; sl < NSL; ++sl) a += *(const f32x4*)(CP + ((size_t)sl * TCX + cr) * DM + c);
            v += a * *(const f32x4*)(cgate + c) * ccoef; *(f32x4*)xr = v; }
        const float s = wave_sum((v.x * v.x + v.y * v.y) + (v.z * v.z + v.w * v.w));
        __syncthreads();
        if (F.lane == 0) red[F.wave] = s;
        __syncthreads();
        float tot = 0.f;
#pragma unroll
        for (int k = 0; k < 8; ++k) tot += red[k];
        const float r = rsqrtf(tot * (1.0f / DM) + EPS);
        const f32x4 gv = *(const f32x4*)(g + c), sv = *(const f32x4*)(scc + c), hv = *(const f32x4*)(shc + c);
        const f32x4 y = v * r * gv * (sv + 1.0f) + hv; u32x2 o; o.x = pk2(y.x, y.y); o.y = pk2(y.z, y.w); *(u32x2*)(XN + (size_t)row * DM + c) = o;
    }
}
__device__ __forceinline__ void final_norm(const Frame& F_, const float* __restrict__ X, float* __restrict__ out, const float* __restrict__ g, float pa, float pb) {
    const Frame F = fresh(F_);
    const int gw = F.bid * NWAVES + F.wave, NGW = F.G * NWAVES;
    for (int row = gw; row < TL; row += NGW) {
        const bf16* xr = (const bf16*)X + (size_t)row * DM; u32x4 p[4]; float s = 0.f;
#pragma unroll
        for (int j = 0; j < 4; ++j) p[j] = *(const u32x4*)(xr + 512 * j + 8 * F.lane);
        float v[4][8];
#pragma unroll
        for (int j = 0; j < 4; ++j) {
#pragma unroll
            for (int e = 0; e < 4; ++e) { v[j][2 * e] = __builtin_bit_cast(float, p[j][e] << 16); v[j][2 * e + 1] = __builtin_bit_cast(float, p[j][e] & 0xffff0000u); s += v[j][2 * e] * v[j][2 * e] + v[j][2 * e + 1] * v[j][2 * e + 1]; } }
        const float r = rsqrtf(wave_sum(s) * (1.0f / DM) + EPS);
#pragma unroll
        for (int j = 0; j < 4; ++j) {
#pragma unroll
            for (int h = 0; h < 2; ++h) { const int c = 512 * j + 8 * F.lane + 4 * h; const f32x4 x = {v[j][4 * h], v[j][4 * h + 1], v[j][4 * h + 2], v[j][4 * h + 3]};
                f32x4 y = x * r * *(const f32x4*)(g + c) * (1.0f + pa); if (row == 0 && c == 0) y.x += pb; *(f32x4*)(out + (size_t)row * DM + c) = y; } }
    }
}
__device__ __forceinline__ void lr_phase(const Frame& F_, const bf16* __restrict__ XN, const bf16* __restrict__ WLRT, float* __restrict__ LR, int rank, int nwork) {
    const Frame F = fresh(F_);
    LAS float* red = (LAS float*)(F.lds + RING_OFF);
    const int lane = F.lane, w = F.wave, tt = w >> 2, kq = w & 3;
    for (int task = rank; task < MR / 32; task += nwork) {
        f32x4 c0 = {0.f, 0.f, 0.f, 0.f}, c1 = {0.f, 0.f, 0.f, 0.f};
        const bf16* ap = XN + (size_t)(32 * task + 16 * tt + (lane & 15)) * DM + 512 * kq + 8 * (lane >> 4);
        const bf16* bp = WLRT + (size_t)(lane & 15) * DM + 512 * kq + 8 * (lane >> 4);
#pragma unroll
        for (int ks = 0; ks < 16; ++ks) { const bf16x8 a = *(const bf16x8*)(ap + 32 * ks), b0 = *(const bf16x8*)(bp + 32 * ks), b1 = *(const bf16x8*)(bp + 16 * DM + 32 * ks);
            c0 = MFMA16(a, b0, c0); c1 = MFMA16(a, b1, c1); }
        __syncthreads();
        *(LAS f32x4*)(red + ((w * 2 + 0) * 64 + lane) * 4) = c0; *(LAS f32x4*)(red + ((w * 2 + 1) * 64 + lane) * 4) = c1;
        __syncthreads();
        if (kq == 0) { f32x4 s0 = c0, s1 = c1;
#pragma unroll
            for (int q = 1; q < 4; ++q) { s0 += *(const LAS f32x4*)(red + (((w + q) * 2 + 0) * 64 + lane) * 4); s1 += *(const LAS f32x4*)(red + (((w + q) * 2 + 1) * 64 + lane) * 4); }
#pragma unroll
            for (int r = 0; r < 4; ++r) { float* o = LR + (size_t)(32 * task + 16 * tt + 4 * (lane >> 4) + r) * 32 + (lane & 15); o[0] = s0[r]; o[16] = s1[r]; } }
    }
}
__device__ __forceinline__ void ctx_p_reduce(const Frame& F_, const float* __restrict__ PP, float* __restrict__ P, bf16* __restrict__ UF) {
    const Frame F = fresh(F_);
    const int gt = F.bid * 512 + F.tid, NGT = F.G * 512;
    for (int i = gt; i < TCX * 1024; i += NGT) { const int r = i >> 10, c = (i & 1023) * 4; f32x4 a = *(const f32x4*)(PP + (size_t)r * 4096 + c);
#pragma unroll
        for (int sl = 1; sl < 8; ++sl) a += *(const f32x4*)(PP + ((size_t)sl * TCX + r) * 4096 + c);
        if (c < PLD) *(f32x4*)(P + (size_t)(TL + r) * PLD + c) = a;
        else { u32x2 o; o.x = pk2(a.x, a.y); o.y = pk2(a.z, a.w); *(u32x2*)(UF + (size_t)(TL + r) * 512 + (c - PLD)) = o; } }
}
__device__ __forceinline__ void qkv_prep(const Frame& F_, const float* __restrict__ P, const float* __restrict__ qk_g, const float* __restrict__ ROPE, bf16* __restrict__ QB, bf16* __restrict__ KB, bf16* __restrict__ VB) {
    const Frame F = fresh(F_);
    const int gw = F.bid * NWAVES + F.wave, NGW = F.G * NWAVES;
    const int half = F.lane >> 5, i = F.lane & 31, d1 = 64 * half + i, d2 = d1 + 32;
    for (int it0 = gw * 4; it0 < MR * 6; it0 += NGW * 4) {
        float e1[4], e2[4], g1[4], g2[4], cs[4], sn[4];
#pragma unroll
        for (int u = 0; u < 4; ++u) { const int it = it0 + u, t = it / 6, slot = it - 6 * t; const float* src = P + (size_t)t * PLD + (slot < 4 ? PC_Q + 128 * slot : PC_K + 128 * (slot - 4)); e1[u] = src[d1]; e2[u] = src[d2];
            const float* gg = qk_g + (slot < 4 ? 0 : 128); g1[u] = gg[d1]; g2[u] = gg[d2];
            const int pos = (t < TL) ? (half ? (t & 63) : (t >> 6)) : 0; cs[u] = (t < TL) ? ROPE[pos * 32 + i] : 1.0f; sn[u] = (t < TL) ? ROPE[128 * 32 + pos * 32 + i] : 0.0f; }
#pragma unroll
        for (int u = 0; u < 4; ++u) { const int it = it0 + u, t = it / 6, slot = it - 6 * t;
            const float r = rsqrtf(wave_sum(e1[u] * e1[u] + e2[u] * e2[u]) * (1.0f / 128.0f) + EPS);
            const float a = e1[u] * r * g1[u], b = e2[u] * r * g2[u]; const float o1 = a * cs[u] - b * sn[u], o2 = a * sn[u] + b * cs[u];
            bf16* dst = (slot < 4) ? (QB + (size_t)t * 512 + 128 * slot) : (KB + (size_t)t * 256 + 128 * (slot - 4));
            dst[d1] = (bf16)f2bf(o1); dst[d2] = (bf16)f2bf(o2); }
    }
    for (int i4 = F.bid * 512 + F.tid; i4 < MR * 64; i4 += F.G * 512) { const int t = i4 >> 6, c = (i4 & 63) * 4; const f32x4 v = *(const f32x4*)(P + (size_t)t * PLD + PC_V + c);
        u32x2 o; o.x = pk2(v.x, v.y); o.y = pk2(v.z, v.w); *(u32x2*)(VB + (size_t)t * 256 + c) = o; }
}
__device__ __forceinline__ int chunk_ord(int d, int p) { return d ? (NCHUNK - 1 - p) : (p < 4 ? 128 + p : p - 4); }

template <bool FINAL>
__device__ __forceinline__ void lru_pass(const Frame& F_, const float* __restrict__ P, const float* __restrict__ conv_w, const float* __restrict__ conv_b, const bf16* __restrict__ WgT,
                                         const float* __restrict__ gate_b, const float* __restrict__ lam, float* __restrict__ ATOT, float* __restrict__ HEND, const float* __restrict__ CIN, bf16* __restrict__ MIX, int off, int nitems) {
    const Frame F = fresh(F_);
    LAS float* xs = (LAS float*)(F.lds + RING_OFF);
    LAS float* uf = (LAS float*)(F.lds + RING_OFF + 34304);
    LAS bf16* ub = (LAS bf16*)(F.lds + RING_OFF + 67328);
    const int lane = F.lane, w = F.wave, g4 = lane >> 4, cl = lane & 15;
    for (int item = first_item(F.bid, F.G, off); item < nitems; item += F.G) {
        const int n = item >> 2, hp = item & 3, t0 = n * 64, seg_lo = (n < 128) ? 0 : TL, seg_hi = (n < 128) ? TL : MR;
        const int hl = w >> 2, head = hp * 2 + hl, c16 = (w & 3) * 16, chl = c16 + cl, cglob = head * 64 + chl;
        bf16x8 pbr[2][2], pbi[2][2]; float pbR[2], pbI[2], plam[2], pcin[2], pgt[16];
#pragma unroll
        for (int d = 0; d < 2; ++d) {
#pragma unroll
            for (int ks = 0; ks < 2; ++ks) { pbr[d][ks] = frag16(WgT + (size_t)((d * 2 + 0) * 8 + head) * 4096, 64, c16, 32 * ks, lane); pbi[d][ks] = frag16(WgT + (size_t)((d * 2 + 1) * 8 + head) * 4096, 64, c16, 32 * ks, lane); }
            pbR[d] = gate_b[(d * 2 + 0) * 512 + cglob]; pbI[d] = gate_b[(d * 2 + 1) * 512 + cglob]; plam[d] = lam[d * 512 + cglob];
            pcin[d] = FINAL ? CIN[((size_t)d * NCHUNK + n) * 512 + cglob] : 0.f; }
        if (FINAL) {
#pragma unroll
            for (int m = 0; m < 4; ++m)
#pragma unroll
                for (int r = 0; r < 4; ++r) pgt[4 * m + r] = P[(size_t)(t0 + 16 * m + 4 * g4 + r) * PLD + PC_LG + cglob]; }
        __syncthreads();
        { float tmp[17];
#pragma unroll
          for (int k = 0; k < 17; ++k) { const int e = F.tid + 512 * k, r = e >> 7, c = e & 127, t = t0 - 2 + r; tmp[k] = (e < 67 * 128 && t >= seg_lo && t < seg_hi) ? P[(size_t)t * PLD + PC_LX + hp * 128 + c] : 0.0f; }
#pragma unroll
          for (int k = 0; k < 17; ++k) { const int e = F.tid + 512 * k; if (e < 67 * 128) xs[e] = tmp[k]; } }
        __syncthreads();
        for (int e = F.tid; e < 64 * 128; e += 512) { const int tok = e >> 7, c = e & 127, cg = hp * 128 + c; float u = conv_b[cg];
#pragma unroll
            for (int j = 0; j < 4; ++j) u += conv_w[j * 512 + cg] * xs[(tok + j) * 128 + c];
            uf[tok * 129 + c] = u; ub[((c >> 6) * 64 + tok) * LDT + (c & 63)] = (bf16)f2bf(u); }
        __syncthreads();
        float hsum[4][4];
#pragma unroll
        for (int m = 0; m < 4; ++m)
#pragma unroll
            for (int r = 0; r < 4; ++r) hsum[m][r] = 0.f;
#pragma unroll
        for (int d = 0; d < 2; ++d) {
            f32x4 ga[4], gi[4];
#pragma unroll
            for (int m = 0; m < 4; ++m) { ga[m] = (f32x4){0.f, 0.f, 0.f, 0.f}; gi[m] = (f32x4){0.f, 0.f, 0.f, 0.f}; }
#pragma unroll
            for (int ks = 0; ks < 2; ++ks) {
                const bf16x8 br = pbr[d][ks], bi = pbi[d][ks];
#pragma unroll
                for (int m = 0; m < 4; ++m) { const bf16x8 a = frag16(ub + hl * 64 * LDT, LDT, 16 * m, 32 * ks, lane); ga[m] = MFMA16(a, br, ga[m]); gi[m] = MFMA16(a, bi, gi[m]); } }
            const float bR = pbR[d], bI = pbI[d], sp = log1pf(__expf(-plam[d]));
#pragma unroll
            for (int m = 0; m < 4; ++m)
#pragma unroll
                for (int r = 0; r < 4; ++r) { const int tok = 16 * m + 4 * g4 + r;
                    const float rr = sigmoidf_(ga[m][r] + bR), ii = sigmoidf_(gi[m][r] + bI), la = -8.0f * rr * sp;
                    ga[m][r] = __expf(la); gi[m][r] = __builtin_amdgcn_sqrtf(one_minus_exp_(2.0f * la)) * (ii * uf[tok * 129 + hl * 64 + chl]); }
            float CA = 1.f, CB = 0.f;
            if (FINAL) CB = pcin[d];
#pragma unroll
            for (int mm = 0; mm < 4; ++mm) { const int m = d ? 3 - mm : mm;
                float ia[4], ib[4]; float A = 1.f, B = 0.f;
#pragma unroll
                for (int rr = 0; rr < 4; ++rr) { const int r = d ? 3 - rr : rr; B = ga[m][r] * B + gi[m][r]; A *= ga[m][r]; ia[r] = A; ib[r] = B; }
                float SA = A, SB = B;
                { const float pa = d ? __shfl_down(SA, 16) : __shfl_up(SA, 16), pb = d ? __shfl_down(SB, 16) : __shfl_up(SB, 16); const bool ok = d ? (g4 <= 2) : (g4 >= 1); if (ok) { SB = SA * pb + SB; SA = pa * SA; } }
                { const float pa = d ? __shfl_down(SA, 32) : __shfl_up(SA, 32), pb = d ? __shfl_down(SB, 32) : __shfl_up(SB, 32); const bool ok = d ? (g4 <= 1) : (g4 >= 2); if (ok) { SB = SA * pb + SB; SA = pa * SA; } }
                float EA = d ? __shfl_down(SA, 16) : __shfl_up(SA, 16), EB = d ? __shfl_down(SB, 16) : __shfl_up(SB, 16);
                if (d ? (g4 == 3) : (g4 == 0)) { EA = 1.f; EB = 0.f; }
                const float TA = __shfl(SA, d ? cl : 48 + cl), TB = __shfl(SB, d ? cl : 48 + cl);
                const float PA = CA * EA, PB = EA * CB + EB;
                if (FINAL) {
#pragma unroll
                    for (int r = 0; r < 4; ++r) hsum[m][r] += ia[r] * PB + ib[r]; }
                CB = TA * CB + TB; CA = CA * TA;
                (void)PA;
            }
            if (!FINAL) { if (g4 == 0) { ATOT[((size_t)d * NCHUNK + n) * 512 + cglob] = CA; HEND[((size_t)d * NCHUNK + n) * 512 + cglob] = CB; } }
        }
        if (FINAL) {
#pragma unroll
            for (int m = 0; m < 4; ++m)
#pragma unroll
                for (int r = 0; r < 4; ++r) { const int t = t0 + 16 * m + 4 * g4 + r; const float gt = pgt[4 * m + r];
                    MIX[(size_t)t * DM + cglob] = (bf16)f2bf(hsum[m][r] * gelu_tanh_(gt)); }
        }
    }
}
__device__ __forceinline__ void lru_b(const Frame& F_, int b0, const float* __restrict__ ATOT, const float* __restrict__ HEND, float* __restrict__ CIN) {
    const Frame F = fresh(F_);
    for (int d = 0; d < 2; ++d) if (F.bid == ((b0 + d) % F.G)) {
        const int c = F.tid; float carry = 0.f;
        for (int p = 0; p < NCHUNK; p += 44) { float A[44], H[44];
#pragma unroll
            for (int k = 0; k < 44; ++k) { const int n = chunk_ord(d, p + k); A[k] = ATOT[((size_t)d * NCHUNK + n) * 512 + c]; H[k] = HEND[((size_t)d * NCHUNK + n) * 512 + c]; }
#pragma unroll
            for (int k = 0; k < 44; ++k) { const int n = chunk_ord(d, p + k); CIN[((size_t)d * NCHUNK + n) * 512 + c] = carry; carry = A[k] * carry + H[k]; } }
    }
}
__device__ __forceinline__ void gla_a(const Frame& F_, const float* __restrict__ P, const float* __restrict__ LR, const float* __restrict__ gw_, const float* __restrict__ gb_,
                                      float* __restrict__ BC, float* __restrict__ DS, float* __restrict__ DEC, int off) {
    const Frame F = fresh(F_);
    LAS float* lrs = (LAS float*)(F.lds + RING_OFF);
    LAS float* bcs = (LAS float*)(F.lds + RING_OFF + 8704);
    LAS float* tots = (LAS float*)(F.lds + RING_OFF + 41984);
    LAS bf16* koutT = (LAS bf16*)(F.lds + RING_OFF + 42496);
    LAS bf16* vT = (LAS bf16*)(F.lds + RING_OFF + 60928);
    LAS float* gws = (LAS float*)(F.lds + RING_OFF + 79360);
    const int w = F.wave;
    for (int item = first_item(F.bid, F.G, off); item < NCHUNK * 4; item += F.G) {
        const int n = item >> 2, hh = item & 3, t0 = n * 64;
        int tid_l = F.tid; asm volatile("" : "+v"(tid_l));
        const int lane = tid_l & 63;
        __syncthreads();
        for (int e = tid_l; e < 2048; e += 512) gws[e] = gw_[(e >> 6) * 256 + hh * 64 + (e & 63)];
        for (int e = tid_l; e < 2048; e += 512) lrs[(e >> 5) * 33 + (e & 31)] = LR[(size_t)(t0 + (e >> 5)) * 32 + (e & 31)];
#pragma unroll
        for (int k_ = 0; k_ < 16; ++k_) { const int e = tid_l + 512 * k_, s = e >> 7, dv = e & 127; vT[dv * LDT + s] = (bf16)f2bf(P[(size_t)(t0 + s) * PLD + PC_GV + hh * 128 + dv]); }
        __syncthreads(); ISTAMP(18);
        { const int tok = lane, d = w >> 2;
          float lr16[16];
#pragma unroll
          for (int r = 0; r < 16; ++r) lr16[r] = lrs[tok * 33 + 16 * d + r];
#pragma unroll 1
          for (int hf = 0; hf < 2; ++hf) {
              const int dk0 = (w & 3) * 16 + hf * 8; float z[8];
#pragma unroll
              for (int jj = 0; jj < 8; ++jj) z[jj] = gb_[d * 256 + hh * 64 + dk0 + jj];
#pragma unroll
              for (int r = 0; r < 16; ++r) { const LAS float* gwr = gws + (d * 16 + r) * 64 + dk0;
#pragma unroll
                  for (int jj = 0; jj < 8; ++jj) z[jj] += lr16[r] * gwr[jj]; }
#pragma unroll
              for (int jj = 0; jj < 8; ++jj) z[jj] = -(fmaxf(-z[jj], 0.0f) + __logf(1.0f + __expf(-fabsf(z[jj])))) * (1.0f / 16.0f);
#pragma unroll
              for (int st = 0; st < 6; ++st) { const int o = 1 << st; const bool ok = d ? (lane + o < 64) : (lane >= o);
#pragma unroll
                  for (int jj = 0; jj < 8; ++jj) { const float y = d ? __shfl_down(z[jj], o) : __shfl_up(z[jj], o); if (ok) z[jj] += y; } }
#pragma unroll
              for (int jj = 0; jj < 8; ++jj) { bcs[(d * 64 + tok) * 65 + dk0 + jj] = z[jj]; const float tot = __shfl(z[jj], d ? 0 : 63);
                  if (lane == 0) { tots[d * 64 + dk0 + jj] = tot; DEC[((size_t)(n * 4 + hh) * 2 + d) * 64 + dk0 + jj] = __expf(tot); } } } }
        __syncthreads(); ISTAMP(19);
#pragma unroll
        for (int k_ = 0; k_ < 8; ++k_) { const int e = tid_l + 512 * k_, s = e >> 6, dk = e & 63; const float kv = P[(size_t)(t0 + s) * PLD + PC_GK + hh * 64 + dk];
#pragma unroll
            for (int d = 0; d < 2; ++d) { const float b = bcs[(d * 64 + s) * 65 + dk]; BC[((size_t)d * MR + t0 + s) * 256 + hh * 64 + dk] = b;
                koutT[(d * 64 + dk) * LDT + s] = (bf16)f2bf(kv * __expf(tots[d * 64 + dk] - b)); } }
        __syncthreads(); ISTAMP(20);
        { const int d = w >> 2, mt0 = (w & 3) * 2; f32x4 acc[2][4];
#pragma unroll
          for (int i = 0; i < 2; ++i)
#pragma unroll
              for (int j = 0; j < 4; ++j) acc[i][j] = (f32x4){0.f, 0.f, 0.f, 0.f};
#pragma unroll
          for (int ks = 0; ks < 2; ++ks) { bf16x8 a[2], b[4];
#pragma unroll
              for (int i = 0; i < 2; ++i) a[i] = frag16(vT, LDT, 16 * (mt0 + i), 32 * ks, lane);
#pragma unroll
              for (int j = 0; j < 4; ++j) b[j] = frag16(koutT + d * 64 * LDT, LDT, 16 * j, 32 * ks, lane);
#pragma unroll
              for (int i = 0; i < 2; ++i)
#pragma unroll
                  for (int j = 0; j < 4; ++j) acc[i][j] = MFMA16(a[i], b[j], acc[i][j]); }
          float* dst = DS + ((size_t)(n * 4 + hh) * 2 + d) * 8192;
#pragma unroll
          for (int i = 0; i < 2; ++i)
#pragma unroll
              for (int j = 0; j < 4; ++j)
#pragma unroll
                  for (int r = 0; r < 4; ++r) dst[(16 * (mt0 + i) + 4 * (lane >> 4) + r) * 64 + 16 * j + (lane & 15)] = acc[i][j][r]; }
        ISTAMP(21);
    }
}
__device__ __forceinline__ void gla_b(const Frame& F_, const float* __restrict__ DS, const float* __restrict__ DEC, bf16* __restrict__ SP) {
    const Frame F = fresh(F_);
    const int b_ = F.bid; const bool full = (F.G == 256);
    const bool excl = full && (b_ < 4 || b_ == 32 || b_ == 33 || b_ == 64 || b_ == 65);
    const int rank = b_ - (b_ > 65 ? 8 : b_ > 33 ? 6 : 4);
    int g0, gstep; bool act;
    if (full) { act = !excl && (F.tid < 264 || (F.tid == 264 && rank < 64)); g0 = (F.tid < 264) ? rank * 264 + F.tid : 248 * 264 + rank; gstep = 1 << 30; }
    else { act = F.tid < 256; g0 = b_ * 256 + F.tid; gstep = F.G * 256; }
    if (act) for (int g = g0; g < 4 * 2 * 64 * 128; g += gstep) {
        const int dk = g & 63, e = g & 8191, d = (g >> 13) & 1, hh = g >> 14; float S = 0.f;
        for (int p = 0; p < NCHUNK; p += 33) { float dec[33], ds[33];
#pragma unroll
            for (int k = 0; k < 33; ++k) { const size_t idx = (size_t)(chunk_ord(d, p + k) * 4 + hh) * 2 + d; dec[k] = DEC[idx * 64 + dk]; ds[k] = DS[idx * 8192 + e]; }
#pragma unroll
            for (int k = 0; k < 33; ++k) { const size_t idx = (size_t)(chunk_ord(d, p + k) * 4 + hh) * 2 + d; SP[idx * 8192 + e] = (bf16)f2bf(S); S = dec[k] * S + ds[k]; } }
    }
}
__device__ __forceinline__ void gla_c(const Frame& F_, const float* __restrict__ P, const float* __restrict__ BC, const bf16* __restrict__ SP, const float* __restrict__ out_g, bf16* __restrict__ MIX, int off, int nitems) {
    const Frame F = fresh(F_);
    LAS bf16* qt = (LAS bf16*)(F.lds + RING_OFF);
    LAS bf16* kin = (LAS bf16*)(F.lds + RING_OFF + 18432);
    LAS bf16* attm = (LAS bf16*)(F.lds + RING_OFF + 36864);
    LAS bf16* vT = (LAS bf16*)(F.lds + RING_OFF + 55296);
    LAS float* red = (LAS float*)(F.lds + RING_OFF + 73728);
    const int lane = F.lane, w = F.wave, g4 = lane >> 4, cl = lane & 15;
    for (int item = first_item(F.bid, F.G, off); item < nitems; item += F.G) {
        const int n = item >> 2, hh = item & 3, t0 = n * 64;
        const int mt = w >> 1, nt0 = (w & 1) * 4;
        bf16x8 psp[2][2][4]; float pg[4][4], pog[4];
#pragma unroll
        for (int d = 0; d < 2; ++d) { const bf16* sp = SP + ((size_t)(n * 4 + hh) * 2 + d) * 8192;
#pragma unroll
            for (int ks = 0; ks < 2; ++ks)
#pragma unroll
                for (int j = 0; j < 4; ++j) psp[d][ks][j] = frag16(sp, 64, 16 * (nt0 + j), 32 * ks, lane); }
#pragma unroll
        for (int j = 0; j < 4; ++j) { pog[j] = out_g[16 * (nt0 + j) + cl];
#pragma unroll
            for (int r = 0; r < 4; ++r) pg[j][r] = P[(size_t)(t0 + 16 * mt + 4 * g4 + r) * PLD + PC_GG + hh * 128 + 16 * (nt0 + j) + cl]; }
        __syncthreads();
#pragma unroll
        for (int k_ = 0; k_ < 16; ++k_) { const int e = F.tid + 512 * k_, s = e >> 7, dv = e & 127; vT[dv * LDT + s] = (bf16)f2bf(P[(size_t)(t0 + s) * PLD + PC_GV + hh * 128 + dv]); }
#pragma unroll
        for (int k_ = 0; k_ < 8; ++k_) { const int e = F.tid + 512 * k_, tok = e >> 6, dk = e & 63; const float q = P[(size_t)(t0 + tok) * PLD + PC_GQ + hh * 64 + dk] * 0.125f, k = P[(size_t)(t0 + tok) * PLD + PC_GK + hh * 64 + dk];
#pragma unroll
            for (int d = 0; d < 2; ++d) { const float b = BC[((size_t)d * MR + t0 + tok) * 256 + hh * 64 + dk];
                qt[(d * 64 + tok) * LDT + dk] = (bf16)f2bf(q * __expf(b)); kin[(d * 64 + tok) * LDT + dk] = (bf16)f2bf(k * __expf(-b)); } }
        __syncthreads();
        { const int d = w >> 2, mt = w & 3; f32x4 acc[4];
#pragma unroll
          for (int j = 0; j < 4; ++j) acc[j] = (f32x4){0.f, 0.f, 0.f, 0.f};
#pragma unroll
          for (int ks = 0; ks < 2; ++ks) { const bf16x8 a = frag16(qt + d * 64 * LDT, LDT, 16 * mt, 32 * ks, lane);
#pragma unroll
              for (int j = 0; j < 4; ++j) acc[j] = MFMA16(a, frag16(kin + d * 64 * LDT, LDT, 16 * j, 32 * ks, lane), acc[j]); }
#pragma unroll
          for (int j = 0; j < 4; ++j)
#pragma unroll
              for (int r = 0; r < 4; ++r) { const int t = 16 * mt + 4 * g4 + r, s = 16 * j + cl; const bool keep = d ? (s >= t) : (s <= t);
                  attm[(d * 64 + t) * LDT + s] = (bf16)f2bf(keep ? acc[j][r] : 0.0f); } }
        __syncthreads();
        f32x4 o[4];
#pragma unroll
        for (int j = 0; j < 4; ++j) o[j] = (f32x4){0.f, 0.f, 0.f, 0.f};
#pragma unroll
        for (int d = 0; d < 2; ++d) {
#pragma unroll
            for (int ks = 0; ks < 2; ++ks) { const bf16x8 a1 = frag16(attm + d * 64 * LDT, LDT, 16 * mt, 32 * ks, lane), a2 = frag16(qt + d * 64 * LDT, LDT, 16 * mt, 32 * ks, lane);
#pragma unroll
                for (int j = 0; j < 4; ++j) { o[j] = MFMA16(a1, frag16(vT, LDT, 16 * (nt0 + j), 32 * ks, lane), o[j]); o[j] = MFMA16(a2, psp[d][ks][j], o[j]); } } }
        float ss[4];
#pragma unroll
        for (int r = 0; r < 4; ++r) { float s = 0.f;
#pragma unroll
            for (int j = 0; j < 4; ++j) s += o[j][r] * o[j][r];
            s += __shfl_xor(s, 1); s += __shfl_xor(s, 2); s += __shfl_xor(s, 4); s += __shfl_xor(s, 8); ss[r] = s; }
        if (cl == 0) {
#pragma unroll
            for (int r = 0; r < 4; ++r) red[(16 * mt + 4 * g4 + r) * 2 + (w & 1)] = ss[r]; }
        __syncthreads();
#pragma unroll
        for (int r = 0; r < 4; ++r) { const int tok = 16 * mt + 4 * g4 + r; const float rs = rsqrtf((red[tok * 2] + red[tok * 2 + 1]) * (1.0f / 128.0f) + EPS);
#pragma unroll
            for (int j = 0; j < 4; ++j) { const int dv = 16 * (nt0 + j) + cl; const float g = pg[j][r];
                MIX[(size_t)(t0 + tok) * DM + 1024 + hh * 128 + dv] = (bf16)f2bf(o[j][r] * rs * pog[j] * siluf_(g)); } }
    }
}
__device__ __forceinline__ void fft_a(const Frame& F_, const bf16* __restrict__ ZT, const bf16* __restrict__ DA, bf16* __restrict__ AT, int off) {
    const Frame F = fresh(F_);
    LAS bf16* DAs = (LAS bf16*)(F.lds + RING_OFF);
    LAS bf16* OT = (LAS bf16*)(F.lds + RING_OFF + 34816);
    const int lane = F.lane, w = F.wave, g4 = lane >> 4, cl = lane & 15;
    const bool full = (F.G == 256); const int b_ = F.bid;
    if (full && (b_ < 4 || b_ == 32 || b_ == 33 || b_ == 64 || b_ == 65)) return;
    const int istart = full ? b_ - (b_ > 65 ? 8 : b_ > 33 ? 6 : 4) : first_item(b_, F.G, off), istep = full ? 248 : F.G;
    __syncthreads();
#pragma unroll
    for (int k_ = 0; k_ < 4; ++k_) { const int e = F.tid + 512 * k_, r = e >> 4, cc = e & 15; *(LAS u32x4*)((LAS char*)DAs + r * 272 + cc * 16) = *(const u32x4*)(DA + r * 128 + cc * 8); }
    __syncthreads();
    for (int item = istart; item < 256; item += istep) {
        const int tg = item >> 4, jg = item & 15, t2 = 8 * tg + w, j0 = 32 * jg;
#pragma unroll 1
        for (int jt = 0; jt < 2; ++jt) {
            f32x4 acc[8];
#pragma unroll
            for (int mt = 0; mt < 8; ++mt) acc[mt] = (f32x4){0.f, 0.f, 0.f, 0.f};
#pragma unroll
            for (int ks = 0; ks < 4; ++ks) { const bf16x8 b = *(const bf16x8*)(ZT + ((size_t)((ks >> 1) * 128 + t2) * 512 + j0 + 16 * jt + cl) * 64 + (ks & 1) * 32 + 8 * g4);
#pragma unroll
                for (int mt = 0; mt < 8; ++mt) acc[mt] = MFMA16(frag16(DAs, 136, 16 * mt, 32 * ks, lane), b, acc[mt]); }
#pragma unroll
            for (int mt = 0; mt < 8; ++mt)
#pragma unroll
                for (int p = 0; p < 2; ++p) { const int k1 = 8 * mt + 2 * g4 + p; const float f = (float)((t2 * k1) & 8191) * (1.0f / 8192.0f); const float cw = __builtin_amdgcn_cosf(f), sw = __builtin_amdgcn_sinf(f);
                    const float re = acc[mt][2 * p], im = acc[mt][2 * p + 1]; const int m = 16 * mt + 4 * g4 + 2 * p, jl = 16 * jt + cl;
                    OT[(m * 32 + jl) * 8 + w] = (bf16)f2bf(re * cw + im * sw); OT[((m + 1) * 32 + jl) * 8 + w] = (bf16)f2bf(im * cw - re * sw); }
        }
        __syncthreads();
#pragma unroll
        for (int k_ = 0; k_ < 8; ++k_) { const int e = F.tid + 512 * k_, m = e >> 5, jl = e & 31; *(u32x4*)(AT + ((size_t)m * 512 + j0 + jl) * 128 + 8 * tg) = *(const LAS u32x4*)(OT + e * 8); }
        __syncthreads();
    }
}
__device__ __forceinline__ void fft_b(const Frame& F_, const bf16* __restrict__ AT, const bf16* __restrict__ DB, bf16* __restrict__ MIX, int off) {
    const Frame F = fresh(F_);
    LAS bf16* DBs = (LAS bf16*)(F.lds + RING_OFF);
    const int lane = F.lane, w = F.wave, g4 = lane >> 4, cl = lane & 15;
    __syncthreads();
#pragma unroll
    for (int k_ = 0; k_ < 8; ++k_) { const int e = F.tid + 512 * k_, r = e >> 5, cc = e & 31; *(LAS u32x4*)((LAS char*)DBs + r * 528 + cc * 16) = *(const u32x4*)(DB + r * 256 + cc * 8); }
    __syncthreads();
    for (int item = first_item(F.bid, F.G, off); item < 256; item += F.G) {
        const int k1 = item >> 2, j0 = 128 * (item & 3) + 16 * w;
        f32x4 acc[8];
#pragma unroll
        for (int mt = 0; mt < 8; ++mt) acc[mt] = (f32x4){0.f, 0.f, 0.f, 0.f};
        bf16x8 b[8];
#pragma unroll
        for (int ks = 0; ks < 8; ++ks) b[ks] = *(const bf16x8*)(AT + ((size_t)(k1 * 2 + (ks >> 2)) * 512 + j0 + cl) * 128 + (ks & 3) * 32 + 8 * g4);
#pragma unroll
        for (int ks = 0; ks < 8; ++ks) {
#pragma unroll
            for (int mt = 0; mt < 8; ++mt) acc[mt] = MFMA16(frag16(DBs, 264, 16 * mt, 32 * ks, lane), b[ks], acc[mt]);
            if (ks & 1) __builtin_amdgcn_sched_barrier(0); }
#pragma unroll
        for (int mt = 0; mt < 8; ++mt)
#pragma unroll
            for (int r = 0; r < 4; ++r) { const int k2 = 16 * mt + 4 * g4 + r; MIX[(size_t)(k1 + 64 * k2) * DM + 1536 + j0 + cl] = (bf16)f2bf(acc[mt][r] * (1.0f / 1024.0f)); }
    }
    __syncthreads();
}
__device__ __forceinline__ void mix_finalize(const Frame& F_, const float* __restrict__ OP, const float* __restrict__ ML, const float* __restrict__ YF, bf16* __restrict__ MIX) {
    const Frame F = fresh(F_);
    const int gt = F.bid * 512 + F.tid, NGT = F.G * 512;
    for (int i = gt; i < MR * 128; i += NGT) { const int t = i >> 7, h = (i >> 5) & 3, c = (i & 31) * 4; constexpr float C = att::SCALE * 1.4426950408889634f;
        const f32x4 o0 = *(const f32x4*)(OP + (size_t)t * 512 + h * 128 + c); const float m0 = ML[(size_t)t * 8 + h * 2], l0 = ML[(size_t)t * 8 + h * 2 + 1];
        f32x4 o;
        if (t < TL) { const f32x4 o1 = *(const f32x4*)(OP + ((size_t)MR + t) * 512 + h * 128 + c); const float m1 = ML[((size_t)MR + t) * 8 + h * 2], l1 = ML[((size_t)MR + t) * 8 + h * 2 + 1];
            const float M = fmaxf(m0, m1), w0 = __builtin_amdgcn_exp2f((m0 - M) * C), w1 = __builtin_amdgcn_exp2f((m1 - M) * C); const float inv = 1.0f / (l0 * w0 + l1 * w1);
            o = (o0 * w0 + o1 * w1) * inv; }
        else o = o0 * (1.0f / l0);
        u32x2 w; w.x = pk2(o.x, o.y); w.y = pk2(o.z, o.w); *(u32x2*)(MIX + (size_t)t * DM + 512 + h * 128 + c) = w; }
    for (int i = gt; i < TCX * 128; i += NGT) { const int t = TL + (i >> 7), c = (i & 127) * 4; const f32x4 y = *(const f32x4*)(YF + (size_t)t * 512 + c) * 0.005524271728019903f;
        u32x2 w; w.x = pk2(y.x, y.y); w.y = pk2(y.z, y.w); *(u32x2*)(MIX + (size_t)t * DM + 1536 + c) = w; }
}

__device__ __forceinline__ int LS(int v) { asm volatile("" : "+s"(v)); return v; }
constexpr int PTR_OFF = MISC_OFF + 128;
__device__ __forceinline__ unsigned long long lds_ptr(const Frame& F, int i) {
    const unsigned long long v = *(volatile LAS unsigned long long*)(F.lds + PTR_OFF + 8 * i);
    const unsigned lo = __builtin_amdgcn_readfirstlane((unsigned)v), hi = __builtin_amdgcn_readfirstlane((unsigned)(v >> 32));
    return ((unsigned long long)hi << 32) | lo;
}
constexpr int NPHASE = 2 + 13 * NLAY + 1;

#define INP(i) ((const float*)lds_ptr(F, (i)))
#define WSL() ((unsigned char*)lds_ptr(F, 22))
#define IN(k) (lo <= (k) && (k) < hi)
#if MK_ONE_LAUNCH
#define GRID_BAR() xcd_barrier(bar)
#else
#define GRID_BAR() do { } while (0)
#endif
#ifndef MK_PROBE
#define MK_PROBE 0
#endif
#if MK_PROBE
#define SEAMG(k, g) do { if (IN(k) && IN((k) + 1)) GRID_BAR(); if (F.bid == 0 && F.wave == 0 && lane_id() == 0) { unsigned long long* T = (unsigned long long*)(F.ctl + 2048); const unsigned long long now = __builtin_amdgcn_s_memrealtime(); T[(g)] += now - T[31]; T[31] = now; } } while (0)
#else
#define SEAMG(k, g) do { if (IN(k) && IN((k) + 1)) GRID_BAR(); } while (0)
#endif
#if MK_PROBE
#define SUBST(g) do { if (F.bid == 0 && F.wave == 0 && lane_id() == 0) { unsigned long long* T = (unsigned long long*)(F.ctl + 2048); const unsigned long long now = __builtin_amdgcn_s_memrealtime(); T[(g)] += now - T[31]; T[31] = now; } } while (0)
#else
#define SUBST(g) do { } while (0)
#endif
constexpr int W2_SPLIT = 1408;
constexpr int W2B_A = 2000, W2B_B = (88 * 64 - 2 * W2B_A) / 2;
constexpr int W13_SPLIT = 6752;
template <int s>
__device__ __forceinline__ void half_layer(const Frame& F, unsigned char* lds, const int lo, const int hi, const XcdBarrier& bar) {
        const int l = s >> 1, f = s & 1, pb = 2 + 13 * l + 10 * f;
        { const int j = f ? 2 : 0;
          if (IN(pb)) { unsigned char* ws = WSL(); const float* modl = (const float*)(ws + WS_MODV) + (size_t)(l * 2 + 0) * 9 * DM; const float* modc = modl + 9 * DM;
              const float* cg = f ? (modc + 5 * DM) : (modc - 2 * 9 * DM + 8 * DM);
              norm_phase<(f ? 8 : (l > 0 ? 11 : 0)), (s == 0)>(F, (s == 0) ? INP(0) : (const float*)(ws + WS_X), (float*)(ws + WS_X), (bf16*)(ws + WS_XN), INP(6) + (size_t)(l * 3 + j) * DM, modl + (3 * j) * DM, modl + (3 * j + 1) * DM, modc + (3 * j) * DM, modc + (3 * j + 1) * DM,
                         (const float*)(ws + WS_CP), cg, f ? 1.0f : 0.5f); SEAMG(pb, 1); }
          if (IN(pb + 1)) { unsigned char* ws = WSL();
              pg8::Gemm g{(const bf16*)(ws + WS_XN), (const bf16*)(ws + WS_W13T) + (size_t)(l * 2 + f) * 2 * FF * DM, DM}; pg8::StaticOrder S; S.init(MR, 2 * FF, DM / 64, LS(F.G), LS(F.bid));
              pg8::EpiSwiGLU E{(bf16*)(ws + WS_H), FF};
              pg8::gemm_phase<pg8::EpiSwiGLU, pg8::StaticOrder, true, true>(F.lds + RING_OFF, g, S, E, F.wave);
              if (s < 2 * NLAY - 1) {
                  const int G_ = LS(F.G), b_ = LS(F.bid), nwg = (MR / 256) * (2 * FF / 256), last0 = ((nwg - 1) / G_) * G_, nbusy = nwg - last0;
                  if (nbusy == G_) conv_w13(F, INP(8), (bf16*)(WSL() + WS_W13T), s + 1, b_, G_, 0, W13_SPLIT);
                  else if (b_ >= nbusy) conv_w13(F, INP(8), (bf16*)(WSL() + WS_W13T), s + 1, b_ - nbusy, G_ - nbusy, 0, W13_SPLIT);
                  if (l < NLAY - 1) {
                      if (nbusy == G_) conv_w2(F, INP(9), (bf16*)(WSL() + WS_W2T), 2 * (l + 1) + 1, b_, G_, W2B_A * f, W2B_A * (f + 1));
                      else if (b_ >= nbusy) conv_w2(F, INP(9), (bf16*)(WSL() + WS_W2T), 2 * (l + 1) + 1, b_ - nbusy, G_ - nbusy, W2B_A * f, W2B_A * (f + 1)); } }
              SEAMG(pb + 1, 2); }
          if (IN(pb + 2)) { unsigned char* ws = WSL(); const float* modl = (const float*)(ws + WS_MODV) + (size_t)(l * 2 + 0) * 9 * DM;
              pg8::Gemm g{(const bf16*)(ws + WS_H), (const bf16*)(ws + WS_W2T) + (size_t)(l * 2 + f) * DM * FF, FF}; pg8::LatCtxOrder S; S.init(TL, DM, FF / 64, 11, LS(F.G), LS(F.bid)); if (l == NLAY - 1 && f == 1) S.nmini = 0;
              pg8::EpiResid<(s == 0)> E{(float*)(ws + WS_X), (s == 0) ? INP(0) : (const float*)(ws + WS_X), DM, modl + (3 * j + 2) * DM, 0.5f, TL / 256, (long)((WS_CP - WS_X) / 4)};
              pg8::gemm_phase<pg8::EpiResid<(s == 0)>, pg8::LatCtxOrder, true, true>(F.lds + RING_OFF, g, S, E, F.wave);
              if (s < 2 * NLAY - 1) {
                  const int G_ = LS(F.G), b_ = LS(F.bid), nmini = S.nmini;
                  if (nmini >= G_ || nmini == 0) conv_w13(F, INP(8), (bf16*)(WSL() + WS_W13T), s + 1, b_, G_, W13_SPLIT, 32 * 352);
                  else if (b_ >= nmini) conv_w13(F, INP(8), (bf16*)(WSL() + WS_W13T), s + 1, b_ - nmini, G_ - nmini, W13_SPLIT, 32 * 352);
                  if (l < NLAY - 1) { const int lo_ = 2 * W2B_A + W2B_B * f, hi_ = 2 * W2B_A + W2B_B * (f + 1);
                      if (nmini >= G_ || nmini == 0) conv_w2(F, INP(9), (bf16*)(WSL() + WS_W2T), 2 * (l + 1) + 1, b_, G_, lo_, hi_);
                      else if (b_ >= nmini) conv_w2(F, INP(9), (bf16*)(WSL() + WS_W2T), 2 * (l + 1) + 1, b_ - nmini, G_ - nmini, lo_, hi_); } }
              SEAMG(pb + 2, 3); } }
        if (f == 0) {
            const int mb = pb + 3;
            if (IN(mb)) { unsigned char* ws = WSL(); const float* modl = (const float*)(ws + WS_MODV) + (size_t)(l * 2 + 0) * 9 * DM; const float* modc = modl + 9 * DM;
                norm_phase<11, false>(F, (const float*)(ws + WS_X), (float*)(ws + WS_X), (bf16*)(ws + WS_XN), INP(6) + (size_t)(l * 3 + 1) * DM, modl + 3 * DM, modl + 4 * DM, modc + 3 * DM, modc + 4 * DM, (const float*)(ws + WS_CP), modc + 2 * DM, 0.5f); SEAMG(mb, 1); }
            if (IN(mb + 1)) {
                unsigned char* ws = WSL();
                { pg8::Gemm g{(const bf16*)(ws + WS_XN), (const bf16*)(ws + WS_WINT) + (size_t)l * 4096 * DM, DM}; pg8::LatCtxOrder S; S.init(TL, 4096, DM / 64, 8, LS(F.G), LS(F.bid));
                  pg8::EpiP E{(float*)(ws + WS_P), PLD, (bf16*)(ws + WS_UF), (long)((WS_PP - WS_P) / 4), TL / 256};
                  pg8::gemm_phase<pg8::EpiP, pg8::LatCtxOrder, true, true>(F.lds + RING_OFF, g, S, E, F.wave);
                  const int G_ = LS(F.G), b_ = LS(F.bid), nmini = S.nmini;
                  if (nmini >= G_ || nmini == 0) { lr_phase(F, (const bf16*)(ws + WS_XN), (const bf16*)(ws + WS_WLRT) + (size_t)l * 32 * DM, (float*)(ws + WS_LR), b_, G_);
                      if (l < NLAY - 1) conv_w2(F, INP(9), (bf16*)(WSL() + WS_W2T), 2 * (l + 1), b_, G_, 0, W2_SPLIT); }
                  else if (b_ >= nmini) { lr_phase(F, (const bf16*)(ws + WS_XN), (const bf16*)(ws + WS_WLRT) + (size_t)l * 32 * DM, (float*)(ws + WS_LR), b_ - nmini, G_ - nmini);
                      if (l < NLAY - 1) conv_w2(F, INP(9), (bf16*)(WSL() + WS_W2T), 2 * (l + 1), b_ - nmini, G_ - nmini, 0, W2_SPLIT); } }
                SEAMG(mb + 1, 4); }
            if (IN(mb + 2)) {
                { unsigned char* ws = WSL(); ctx_p_reduce(F, (const float*)(ws + WS_PP), (float*)(ws + WS_P), (bf16*)(ws + WS_UF)); }
                SEAMG(mb + 2, 17); }
            if (IN(mb + 3)) {
                { unsigned char* ws = WSL(); pg8::Gemm g{(const bf16*)(ws + WS_ADFT1), (const bf16*)(ws + WS_UF), 512}; pg8::StaticOrder S; S.init(1024, MR, 8, LS(F.G), LS(F.bid)); pg8::EpiZT E{(bf16*)(ws + WS_ZT), (long)((WS_ZTC - WS_ZT) / 2)};
                  pg8::gemm_phase<pg8::EpiZT, pg8::StaticOrder, true, true>(F.lds + RING_OFF, g, S, E, F.wave); }
                SUBST(9);
                { unsigned char* ws = WSL(); qkv_prep(F, (const float*)(ws + WS_P), INP(17) + (size_t)l * 256, (const float*)(ws + WS_ROPE), (bf16*)(ws + WS_QB), (bf16*)(ws + WS_KB), (bf16*)(ws + WS_VB)); }
                SUBST(10);
                { unsigned char* ws = WSL(); lru_pass<false>(F, (const float*)(ws + WS_P), INP(12) + (size_t)l * 4 * 512, INP(13) + (size_t)l * 512, (const bf16*)(ws + WS_WGT) + (size_t)l * 32 * 4096, INP(15) + (size_t)l * 2 * 2 * 512, INP(16) + (size_t)l * 2 * 512,
                        (float*)(ws + WS_ATOT), (float*)(ws + WS_HEND), nullptr, nullptr, 132, NCHUNK * 4); }
                SUBST(11);
                { unsigned char* ws = WSL(); gla_a(F, (const float*)(ws + WS_P), (const float*)(ws + WS_LR), INP(18) + (size_t)l * 2 * 16 * 256, INP(19) + (size_t)l * 2 * 256, (float*)(ws + WS_BC), (float*)(ws + WS_DS), (float*)(ws + WS_DEC), 148); }
                SUBST(12);
                SEAMG(mb + 3, 5); }
            if (IN(mb + 4)) {
                { unsigned char* ws = WSL(); const bf16* QB = (const bf16*)(ws + WS_QB); const bf16* KB = (const bf16*)(ws + WS_KB); const bf16* VB = (const bf16*)(ws + WS_VB); float* OP = (float*)(ws + WS_OP); float* ML = (float*)(ws + WS_ML);
                  int bid_ = F.bid; asm volatile("" : "+s"(bid_));
                  const int G_ = LS(F.G);
                  for (int L = bid_; L < ((l == NLAY - 1) ? 256 : 260); L += G_) {
                    const bf16 *q, *k, *v; float *o, *ml; int seq;
                    if (L < 256) { const int xcd = L & 7, j = L >> 3, combo = xcd >> 1, kvh = combo >> 1, sp = combo & 1, idx = (xcd & 1) * 32 + j, h = kvh * 2 + (idx >> 5), qb = idx & 31;
                        q = QB + (size_t)(qb * 256) * 512 + h * 128; k = KB + (size_t)(sp * 4224) * 256 + kvh * 128; v = VB + (size_t)(sp * 4224) * 256 + kvh * 128;
                        o = OP + ((size_t)sp * MR + qb * 256) * 512 + h * 128; ml = ML + ((size_t)sp * MR + qb * 256) * 8 + h * 2; seq = 4224; }
                    else { const int h = L - 256, kvh = h >> 1;
                        q = QB + (size_t)TL * 512 + h * 128; k = KB + (size_t)TL * 256 + kvh * 128; v = VB + (size_t)TL * 256 + kvh * 128;
                        o = OP + (size_t)TL * 512 + h * 128; ml = ML + (size_t)TL * 8 + h * 2; seq = TCX; }
                    __syncthreads();
                    att::attn_unit(q, k, v, o, ml, seq, (char*)lds + RING_OFF, F.wave);
                  }
                  __syncthreads(); }
                SUBST(15);
                { unsigned char* ws = WSL(); fft_a(F, (const bf16*)(ws + WS_ZT), (const bf16*)(ws + WS_DA), (bf16*)(ws + WS_AT), 4); }
                { unsigned char* ws = WSL(); pg8::Gemm g{(const bf16*)(ws + WS_ADFTC), (const bf16*)(ws + WS_ZTC), 512}; pg8::SplitOrder S; S.init(TCX, 512, 1, 8, LS(F.G), first_item(LS(F.bid), LS(F.G), 32)); pg8::EpiYF E{(float*)(ws + WS_YF), TL, (size_t)MR * 512};
                  pg8::gemm_phase<pg8::EpiYF, pg8::SplitOrder, true, true>(F.lds + RING_OFF, g, S, E, F.wave); }
                SUBST(16);
                { unsigned char* ws = WSL(); lru_b(F, 64, (const float*)(ws + WS_ATOT), (const float*)(ws + WS_HEND), (float*)(ws + WS_CIN)); }
                { unsigned char* ws = WSL(); gla_b(F, (const float*)(ws + WS_DS), (const float*)(ws + WS_DEC), (bf16*)(ws + WS_SP)); }
                SEAMG(mb + 4, 6); }
            if (IN(mb + 5)) {
                { unsigned char* ws = WSL(); lru_pass<true>(F, (const float*)(ws + WS_P), INP(12) + (size_t)l * 4 * 512, INP(13) + (size_t)l * 512, (const bf16*)(ws + WS_WGT) + (size_t)l * 32 * 4096, INP(15) + (size_t)l * 2 * 2 * 512, INP(16) + (size_t)l * 2 * 512,
                        nullptr, nullptr, (const float*)(ws + WS_CIN), (bf16*)(ws + WS_MIX), 0, (l == NLAY - 1) ? 512 : NCHUNK * 4); }
                SUBST(13);
                { unsigned char* ws = WSL(); gla_c(F, (const float*)(ws + WS_P), (const float*)(ws + WS_BC), (const bf16*)(ws + WS_SP), INP(20) + (size_t)l * 128, (bf16*)(ws + WS_MIX), 16, (l == NLAY - 1) ? 512 : NCHUNK * 4); }
                SUBST(14);
                { unsigned char* ws = WSL(); fft_b(F, (const bf16*)(ws + WS_AT), (const bf16*)(ws + WS_DB), (bf16*)(ws + WS_MIX), 32); }
                { unsigned char* ws = WSL(); mix_finalize(F, (const float*)(ws + WS_OP), (const float*)(ws + WS_ML), (const float*)(ws + WS_YF), (bf16*)(ws + WS_MIX)); }
                SEAMG(mb + 5, 7); }
            if (IN(mb + 6)) {
                unsigned char* ws = WSL(); const float* modl = (const float*)(ws + WS_MODV) + (size_t)(l * 2 + 0) * 9 * DM;
                pg8::Gemm g{(const bf16*)(ws + WS_MIX), (const bf16*)(ws + WS_WOUTT) + (size_t)l * DM * DM, DM}; pg8::LatCtxOrder S; S.init(TL, DM, DM / 64, 8, LS(F.G), LS(F.bid)); if (l == NLAY - 1) S.nmini = 0;
                pg8::EpiResid<false> E{(float*)(ws + WS_X), (const float*)(ws + WS_X), DM, modl + 5 * DM, 1.0f, TL / 256, (long)((WS_CP - WS_X) / 4)};
                pg8::gemm_phase<pg8::EpiResid<false>, pg8::LatCtxOrder, true, true>(F.lds + RING_OFF, g, S, E, F.wave);
                if (l < NLAY - 1) { const int G_ = LS(F.G), b_ = LS(F.bid), nmini = S.nmini;
                    if (nmini >= G_ || nmini == 0) conv_w2(F, INP(9), (bf16*)(WSL() + WS_W2T), 2 * (l + 1), b_, G_, W2_SPLIT, 88 * 64);
                    else if (b_ >= nmini) conv_w2(F, INP(9), (bf16*)(WSL() + WS_W2T), 2 * (l + 1), b_ - nmini, G_ - nmini, W2_SPLIT, 88 * 64); }
                SEAMG(mb + 6, 8); }
        }
    }
struct Args { const float* in[21]; float* out; unsigned char* ws; int ph_lo, ph_hi; };
static_assert(sizeof(Args) == 21 * 8 + 8 + 8 + 8, "Args has no padding");

__global__ void __launch_bounds__(NWAVES * 64, 2) fwd_kernel(Args args) {
    extern __shared__ __attribute__((aligned(16))) unsigned char lds[];
    Frame F;
    F.lds = (LAS unsigned char*)lds; F.gl = lds;
    F.MISC = (volatile LAS unsigned*)(F.lds + MISC_OFF);
    { const int t0_ = threadIdx.x; F.tid = t0_; F.lane = t0_ & 63; F.wave = __builtin_amdgcn_readfirstlane(t0_ >> 6); }
    F.G = gridDim.x; F.bid = blockIdx.x;
    F.ctl = (gu32*)(args.ws + WS_CTL);
    for (int u = F.tid; u < (LDS_BYTES - LDSCTL_OFF) / 4; u += NWAVES * 64) ((LAS unsigned*)(F.lds + LDSCTL_OFF))[u] = 0u;
    __syncthreads();
    if (F.tid < 21) ((LAS unsigned long long*)(F.lds + PTR_OFF))[F.tid] = (unsigned long long)args.in[F.tid];
    if (F.tid == 21) ((LAS unsigned long long*)(F.lds + PTR_OFF))[21] = (unsigned long long)args.out;
    if (F.tid == 22) ((LAS unsigned long long*)(F.lds + PTR_OFF))[22] = (unsigned long long)args.ws;
    __syncthreads();
#if MK_ONE_LAUNCH
    const XcdBarrier bar = xcd_barrier_post((unsigned*)(F.ctl + CW_BAR), F.MISC + 8, (unsigned)F.wave);
#else
    XcdBarrier bar; bar.bar = nullptr; bar.x = 0; bar.st = nullptr; bar.wv = 0;
#endif
    const int lo = args.ph_lo, hi = args.ph_hi;
#if MK_PROBE
    if (F.bid == 0 && F.wave == 0 && lane_id() == 0) { unsigned long long* T = (unsigned long long*)(F.ctl + 2048); T[31] = __builtin_amdgcn_s_memrealtime(); }
#endif

    if (IN(0) || IN(1)) {
        In I; I.x = INP(0); I.c = INP(1); I.ctx = INP(2); I.c_ctx = INP(3); I.mod_w = INP(4); I.mod_b = INP(5); I.norm_g = INP(6); I.final_g = INP(7);
        I.ffn_w13 = INP(8); I.ffn_w2 = INP(9); I.w_in = INP(10); I.w_out = INP(11); I.lru_conv_w = INP(12); I.lru_conv_b = INP(13); I.lru_gate_w = INP(14);
        I.lru_gate_b = INP(15); I.lru_lambda = INP(16); I.attn_qk_g = INP(17); I.gla_gate_w = INP(18); I.gla_gate_b = INP(19); I.gla_out_g = INP(20);
        if (IN(0)) { prologue_a(F, I, WSL()); SEAMG(0, 0); }
        if (IN(1)) { prologue_b(F, I, WSL()); SEAMG(1, 0); }
    }

    half_layer<0>(F, lds, lo, hi, bar); half_layer<1>(F, lds, lo, hi, bar); half_layer<2>(F, lds, lo, hi, bar); half_layer<3>(F, lds, lo, hi, bar);
    half_layer<4>(F, lds, lo, hi, bar); half_layer<5>(F, lds, lo, hi, bar); half_layer<6>(F, lds, lo, hi, bar); half_layer<7>(F, lds, lo, hi, bar);
    if (IN(NPHASE - 1)) { unsigned char* ws = WSL(); float pa = 0.f, pb_ = 0.f;
#if MK_PROBE
        { const unsigned long long* T = (const unsigned long long*)(F.ctl + 2048); unsigned long long tot = 0; for (int g = 0; g < 24; ++g) tot += T[g];
          unsigned long long sel = 0; for (int g = 0; g < 24; ++g) if ((MK_PROBE_A >> g) & 1) sel += T[g]; pb_ = 20.0f * (float)sel / (float)tot; }
#endif
        final_norm(F, (const float*)(ws + WS_X), (float*)lds_ptr(F, 21), INP(7), pa, pb_); }
#undef IN
#undef SEAMG
}

extern "C" void kernel_launch(void* const* d_in, const int* in_sizes, int n_in, void* d_out, int out_size, void* d_ws, size_t ws_size, hipStream_t stream) {
    static int grid = 0;
    if (grid == 0) {
        if (n_in != 21 || in_sizes[0] != TL * DM || out_size != TL * DM || ws_size < WS_END) {
            fprintf(stderr, "kernel_launch: unexpected shapes: n_in %d in0 %d out %d ws %zu (need %zu); nothing launched\n", n_in, n_in > 0 ? in_sizes[0] : -1, out_size, ws_size, (size_t)WS_END); grid = -1; return; }
        int dev = 0, cus = 0, per_cu = 0;
        if (hipGetDevice(&dev) != hipSuccess || hipDeviceGetAttribute(&cus, hipDeviceAttributeMultiprocessorCount, dev) != hipSuccess) { fprintf(stderr, "kernel_launch: device query failed\n"); grid = -1; return; }
        if (hipFuncSetAttribute((const void*)fwd_kernel, hipFuncAttributeMaxDynamicSharedMemorySize, LDS_BYTES) != hipSuccess) { fprintf(stderr, "kernel_launch: hipFuncSetAttribute failed\n"); grid = -1; return; }
        if (hipOccupancyMaxActiveBlocksPerMultiprocessor(&per_cu, (const void*)fwd_kernel, NWAVES * 64, LDS_BYTES) != hipSuccess || per_cu < 1)
            fprintf(stderr, "kernel_launch: note: occupancy query reports %d workgroups per CU\n", per_cu);
        (void)hipGetLastError();
        grid = cus;
    }
    if (grid < 0) return;
    if (hipMemsetAsync((char*)d_ws + WS_CTL, 0, CTL_ZERO_BYTES, stream) != hipSuccess) { fprintf(stderr, "kernel_launch: memset failed\n"); return; }
    Args a{};
    for (int i = 0; i < 21; ++i) a.in[i] = (const float*)d_in[i];
    a.out = (float*)d_out; a.ws = (unsigned char*)d_ws;
#if MK_ONE_LAUNCH
    a.ph_lo = 0; a.ph_hi = NPHASE;
    hipLaunchKernelGGL(fwd_kernel, dim3(grid), dim3(NWAVES * 64), LDS_BYTES, stream, a);
#else
    for (int ph = 0; ph < NPHASE; ++ph) { a.ph_lo = ph; a.ph_hi = ph + 1; hipLaunchKernelGGL(fwd_kernel, dim3(grid), dim3(NWAVES * 64), LDS_BYTES, stream, a); }
#endif
    const hipError_t le = hipPeekAtLastError();
    if (le != hipSuccess) fprintf(stderr, "kernel_launch: launch failed: %s\n", hipGetErrorName(le));
}
```
